# Optimizing an MI355X kernel written in HIP

```python
import math
import jax, jax.numpy as jnp
from jax import lax
import numpy as np

D_MODEL = 1024
BATCH = 1
SEQ = 16384
DEPTH = 1

PLE_DIM = 256
D_FF = 2816
CONV_CH = 512
CONV_WIDTH = 31
N_HEADS = 8
HEAD_DIM = 64
ATTN_W = N_HEADS * HEAD_DIM
IDX_HEADS = 4
IDX_DIM = 64
TOPK_MAX = 256
Q_BLOCK = 128
NUM_BUCKETS = 32
MAX_DISTANCE = 128
N_BRANCH = 2
EPS = 1e-6
MIX_COLS = (CONV_CH, CONV_CH, ATTN_W, ATTN_W, ATTN_W, IDX_HEADS * IDX_DIM, IDX_DIM, IDX_HEADS, D_MODEL, D_MODEL)
MIX_IN = 2 * CONV_CH + 3 * ATTN_W + IDX_HEADS * IDX_DIM + IDX_DIM + IDX_HEADS + N_BRANCH * D_MODEL

kernel_name = "hybrid_conformer_conv_dsa_macaron_layer"


def rms_norm(x, g):
    xf = x.astype(jnp.float32)
    y = xf * lax.rsqrt(jnp.mean(xf * xf, axis=-1, keepdims=True) + EPS)
    return (y * g.astype(jnp.float32)).astype(x.dtype)


def layer_norm(x, g, b):
    xf = x.astype(jnp.float32)
    mu = jnp.mean(xf, axis=-1, keepdims=True)
    xc = xf - mu
    y = xc * lax.rsqrt(jnp.mean(xc * xc, axis=-1, keepdims=True) + EPS)
    return (y * g.astype(jnp.float32) + b.astype(jnp.float32)).astype(x.dtype)


def swiglu(x, w_in, w_out):
    a, b = jnp.split(x @ w_in, 2, axis=-1)
    return (jax.nn.silu(a) * b) @ w_out


def split_cols(z, sizes):
    outs, start = [], 0
    for n in sizes:
        outs.append(z[..., start:start + n])
        start += n
    return outs


def conv_module(a, gate, dw_w, dw_b, ln_g, ln_b, w_out):
    z = a * jax.nn.sigmoid(gate)
    z = lax.conv_general_dilated(
        z, dw_w[:, None, :].astype(z.dtype), window_strides=(1,),
        padding=[(CONV_WIDTH - 1, 0)], dimension_numbers=('NWC', 'WIO', 'NWC'),
        feature_group_count=CONV_CH) + dw_b
    z = jax.nn.silu(layer_norm(z, ln_g, ln_b))
    return z @ w_out


def t5_bucket(dist):
    n = jnp.maximum(dist, 0)
    max_exact = NUM_BUCKETS // 2
    is_small = n < max_exact
    nf = jnp.maximum(n, 1).astype(jnp.float32)
    large = max_exact + (jnp.log(nf / max_exact) / math.log(MAX_DISTANCE / max_exact)
                         * (NUM_BUCKETS - max_exact)).astype(jnp.int32)
    large = jnp.minimum(large, NUM_BUCKETS - 1)
    return jnp.where(is_small, n, large)


def dsa_attention(q, k, v, qi, ki, wi, rel_bias, k_top):
    B, S = q.shape[0], q.shape[1]
    nb = S // Q_BLOCK
    key_pos = jnp.arange(S, dtype=jnp.int32)
    scale = HEAD_DIM ** -0.5

    def blockify(a):
        return jnp.moveaxis(a.reshape((B, nb, Q_BLOCK) + a.shape[2:]), 1, 0)

    def one_block(args):
        qb, qib, wib, start = args
        q_pos = start + jnp.arange(Q_BLOCK, dtype=jnp.int32)
        s_idx = jax.nn.relu(jnp.einsum('bqhd,bsd->bqhs', qib, ki))
        idx_score = jnp.einsum('bqh,bqhs->bqs', wib, s_idx).astype(jnp.float32)
        causal = key_pos[None, :] <= q_pos[:, None]
        idx_score = jnp.where(causal[None], idx_score, -jnp.inf)
        _, sel = lax.top_k(idx_score, k_top)
        valid = sel <= q_pos[None, :, None]
        k_sel = jax.vmap(lambda kk, ii: kk[ii])(k, sel)
        v_sel = jax.vmap(lambda vv, ii: vv[ii])(v, sel)
        logits = jnp.einsum('bqhd,bqkhd->bqhk', qb, k_sel).astype(jnp.float32) * scale
        bucket = t5_bucket(q_pos[None, :, None] - sel)
        bias = jnp.transpose(rel_bias[bucket].astype(jnp.float32), (0, 1, 3, 2))
        logits = jnp.where(valid[:, :, None, :], logits + bias, -jnp.inf)
        probs = jax.nn.softmax(logits, axis=-1)
        return jnp.einsum('bqhk,bqkhd->bqhd', probs.astype(v.dtype), v_sel)

    starts = jnp.arange(nb, dtype=jnp.int32) * Q_BLOCK
    out = lax.map(one_block, (blockify(q), blockify(qi), blockify(wi), starts))
    return jnp.moveaxis(out, 0, 1).reshape(B, S, N_HEADS, HEAD_DIM)


def setup_inputs(seed: int = 0) -> dict:
    key = jax.random.key(seed)
    ks = jax.random.split(key, 24)

    def nrm(k, shape, scale):
        return jax.random.normal(k, shape, jnp.float32) * scale

    def gain(k, shape):
        return 1.0 + 0.02 * jax.random.normal(k, shape, jnp.float32)

    L = DEPTH
    return {
        "x": nrm(ks[0], (BATCH, SEQ, D_MODEL), 1.0),
        "p": nrm(ks[1], (DEPTH, BATCH, SEQ, PLE_DIM), 1.0),
        "ffn1_norm": gain(ks[2], (L, D_MODEL)),
        "ffn1_w_in": nrm(ks[3], (L, D_MODEL, 2 * D_FF), D_MODEL ** -0.5),
        "ffn1_w_out": nrm(ks[4], (L, D_FF, D_MODEL), D_FF ** -0.5),
        "mix_norm": gain(ks[5], (L, D_MODEL)),
        "mix_w_in": nrm(ks[6], (L, D_MODEL, MIX_IN), D_MODEL ** -0.5),
        "conv_dw_w": nrm(ks[7], (L, CONV_WIDTH, CONV_CH), CONV_WIDTH ** -0.5),
        "conv_dw_b": nrm(ks[8], (L, CONV_CH), 0.02),
        "conv_ln_g": gain(ks[9], (L, CONV_CH)),
        "conv_ln_b": nrm(ks[10], (L, CONV_CH), 0.02),
        "conv_w_out": nrm(ks[11], (L, CONV_CH, D_MODEL), CONV_CH ** -0.5),
        "q_norm": gain(ks[12], (L, HEAD_DIM)),
        "k_norm": gain(ks[13], (L, HEAD_DIM)),
        "attn_w_out": nrm(ks[14], (L, ATTN_W, D_MODEL), ATTN_W ** -0.5),
        "mix_w_out": nrm(ks[15], (L, D_MODEL, D_MODEL), D_MODEL ** -0.5),
        "ffn2_norm": gain(ks[16], (L, D_MODEL)),
        "ffn2_w_in": nrm(ks[17], (L, D_MODEL, 2 * D_FF), D_MODEL ** -0.5),
        "ffn2_w_out": nrm(ks[18], (L, D_FF, D_MODEL), D_FF ** -0.5),
        "ple_norm": gain(ks[19], (L, D_MODEL)),
        "ple_w_gate": nrm(ks[20], (L, D_MODEL, D_MODEL), D_MODEL ** -0.5),
        "ple_w_proj": nrm(ks[21], (L, PLE_DIM, D_MODEL), PLE_DIM ** -0.5),
        "rel_bias": nrm(ks[22], (NUM_BUCKETS, N_HEADS), 0.5),
    }


def reference(x, p, ffn1_norm, ffn1_w_in, ffn1_w_out, mix_norm, mix_w_in, conv_dw_w, conv_dw_b,
              conv_ln_g, conv_ln_b, conv_w_out, q_norm, k_norm, attn_w_out, mix_w_out,
              ffn2_norm, ffn2_w_in, ffn2_w_out, ple_norm, ple_w_gate, ple_w_proj, rel_bias):
    B, S, _ = x.shape
    k_top = min(TOPK_MAX, S // 4)
    idx_w_scale = (IDX_HEADS ** -0.5) * (IDX_DIM ** -0.5)
    h = x
    for i in range(DEPTH):
        h = h + 0.5 * swiglu(rms_norm(h, ffn1_norm[i]), ffn1_w_in[i], ffn1_w_out[i])
        u = rms_norm(h, mix_norm[i])
        z = u @ mix_w_in[i]
        c_a, c_g, q, k, v, qi, ki, wi, g_conv, g_attn = split_cols(z, MIX_COLS)
        conv_out = conv_module(c_a, c_g, conv_dw_w[i], conv_dw_b[i], conv_ln_g[i], conv_ln_b[i], conv_w_out[i])
        q = rms_norm(q.reshape(B, S, N_HEADS, HEAD_DIM), q_norm[i])
        k = rms_norm(k.reshape(B, S, N_HEADS, HEAD_DIM), k_norm[i])
        v = v.reshape(B, S, N_HEADS, HEAD_DIM)
        qi = qi.reshape(B, S, IDX_HEADS, IDX_DIM)
        attn = dsa_attention(q, k, v, qi, ki, wi * idx_w_scale, rel_bias, k_top)
        attn_out = attn.reshape(B, S, ATTN_W) @ attn_w_out[i]
        merged = jax.nn.sigmoid(g_conv) * conv_out + jax.nn.sigmoid(g_attn) * attn_out
        h = h + merged @ mix_w_out[i]
        h = h + 0.5 * swiglu(rms_norm(h, ffn2_norm[i]), ffn2_w_in[i], ffn2_w_out[i])
        gate = jax.nn.sigmoid(rms_norm(h, ple_norm[i]) @ ple_w_gate[i])
        h = h + gate * (p[i] @ ple_w_proj[i])
    return h
```

```cpp
#include <hip/hip_runtime.h>
#include <cstdio>
#include <cstdint>
namespace pg8 {
#define PG8_LAS __attribute__((address_space(3)))
typedef unsigned short bf16_t;
typedef short bf16x8 __attribute__((ext_vector_type(8)));
typedef float f32x4 __attribute__((ext_vector_type(4)));
typedef unsigned u32x4 __attribute__((ext_vector_type(4)));
constexpr int BM = 256, BK = 64, HALF = 128, HTB = HALF * BK * 2  , STAGE_BYTES = 8 * HTB, NXCD = 8, WGM = 8;

__host__ __device__ __forceinline__ int lds_byte(int r, int c) { const int st = (r >> 4) * 2 + (c >> 5), rr = r & 15, cc = c & 31, ob = rr * 64 + cc * 2; return st * 1024 + (ob ^ (((ob >> 9) & 1) << 5)); }
__host__ __device__ __forceinline__ void stage_rc(int b, int& R, int& C) { const int st = b / 1024, sb = b % 1024, swz = sb ^ (((sb >> 9) & 1) << 5); R = (st >> 1) * 16 + swz / 64; C = (st & 1) * 32 + (swz % 64) / 2; }
__host__ __device__ __forceinline__ int perm32(int rho) { const int n = rho >> 4, i = rho & 15; return 8 * (i >> 2) + 4 * n + (i & 3); }

struct Unit { int pm, pn; };
struct Gemm { const bf16_t* A; const bf16_t* Bt; int M, N, K; };

struct StaticOrder {
    int nM, nN, nwg, G, c;
    __host__ __device__ void init(int M, int N, int G_, int c_) { nM = M / BM; nN = N / BM; nwg = nM * nN; G = G_; c = c_; }
    __host__ __device__ bool next(int i, Unit& u) const {
        const long L = (long)i * G + c; if (L >= nwg) return false;
        int wgid = (int)L; { const int q = nwg / NXCD, r = nwg % NXCD, xcd = wgid % NXCD, off = wgid / NXCD; wgid = (xcd < r ? xcd * (q + 1) : r * (q + 1) + (xcd - r) * q) + off; }
        const int nig = WGM * nN, gid = wgid / nig, fm = gid * WGM, gsz = (nM - fm) < WGM ? (nM - fm) : WGM;
        u.pm = fm + ((wgid % nig) % gsz); u.pn = (wgid % nig) / gsz; return true;
    }
    __device__ __forceinline__ void a_ready(const Unit&) const {}
    __device__ __forceinline__ void done(const Unit&) const {}
};

__device__ __forceinline__ unsigned cvt_pk_bf16(float lo, float hi) { unsigned r; asm volatile("v_cvt_pk_bf16_f32 %0, %1, %2" : "=v"(r) : "v"(lo), "v"(hi)); return r; }
typedef float f32x2 __attribute__((ext_vector_type(2)));
typedef _Float16 f16x2 __attribute__((ext_vector_type(2)));
constexpr float NORM_EPS = 1e-6f;
constexpr float Q_C2 = 0.125f * 1.4426950408889634f;
__device__ __forceinline__ float bf_lo(unsigned w) { return __uint_as_float(w << 16); }
__device__ __forceinline__ float bf_hi(unsigned w) { return __uint_as_float(w & 0xffff0000u); }
__device__ __forceinline__ float sigm(float x) { return __builtin_amdgcn_rcpf(1.f + __builtin_amdgcn_exp2f(-1.4426950408889634f * x)); }
__device__ __forceinline__ u32x4 pack8(f32x4 a, f32x4 b) { u32x4 w; w.x = cvt_pk_bf16(a[0], a[1]); w.y = cvt_pk_bf16(a[2], a[3]); w.z = cvt_pk_bf16(b[0], b[1]); w.w = cvt_pk_bf16(b[2], b[3]); return w; }
__device__ __forceinline__ unsigned pkh(float lo, float hi) { f16x2 v = __builtin_convertvector((f32x2){lo, hi}, f16x2); return __builtin_bit_cast(unsigned, v); }
__device__ __forceinline__ u32x4 pack8h(f32x4 a, f32x4 b) { u32x4 w; w.x = pkh(a[0], a[1]); w.y = pkh(a[2], a[3]); w.z = pkh(b[0], b[1]); w.w = pkh(b[2], b[3]); return w; }
__device__ __forceinline__ float row_rs(const float* ss, int row) { return __builtin_amdgcn_rsqf(ss[row] * (1.0f / 1024.0f) + NORM_EPS); }
__device__ __forceinline__ f32x4 unpk_lo(u32x4 g) { return (f32x4){bf_lo(g.x), bf_hi(g.x), bf_lo(g.y), bf_hi(g.y)}; }
__device__ __forceinline__ f32x4 unpk_hi(u32x4 g) { return (f32x4){bf_lo(g.z), bf_hi(g.z), bf_lo(g.w), bf_hi(g.w)}; }

struct EpiSwiglu {
    static constexpr bool PERM = true, AFTER_DRAIN = false;
    bf16_t* O; const float* ss;
    __device__ __forceinline__ void operator()(const f32x4 (&acc)[2][2][4][2], const Unit& u, int wr, int wc, int fr, int fq) const {
        const int row0 = u.pm * BM + wr * 64 + fr, col0 = u.pn * HALF + wc * 32 + 8 * fq;
#pragma unroll
        for (int ai = 0; ai < 2; ++ai)
#pragma unroll
            for (int m = 0; m < 4; ++m) { const int row = row0 + ai * HALF + m * 16; const float rs = row_rs(ss, row); f32x4 o[2];
#pragma unroll
                for (int n = 0; n < 2; ++n) { const f32x4 a = acc[ai][0][m][n] * rs, b = acc[ai][1][m][n] * rs;
#pragma unroll
                    for (int e = 0; e < 4; ++e) o[n][e] = a[e] * sigm(a[e]) * b[e]; }
                *(u32x4*)(O + (size_t)row * 2816 + col0) = pack8(o[0], o[1]); }
    }
};
struct EpiRes {
    static constexpr bool PERM = true, AFTER_DRAIN = false;
    const float* base; float* out; bf16_t* hb; float* ssq; float alpha;
    __device__ __forceinline__ void operator()(const f32x4 (&acc)[2][2][4][2], const Unit& u, int wr, int wc, int fr, int fq) const {
        const int row0 = u.pm * BM + wr * 64 + fr, col0 = u.pn * BM + wc * 32 + 8 * fq;
#pragma unroll
        for (int ai = 0; ai < 2; ++ai)
#pragma unroll
            for (int m = 0; m < 4; ++m) { const int row = row0 + ai * HALF + m * 16; float q = 0.f;
#pragma unroll
                for (int bj = 0; bj < 2; ++bj) { const size_t off = (size_t)row * 1024 + col0 + bj * HALF;
                    const f32x4 x0 = *(const f32x4*)(base + off), x1 = *(const f32x4*)(base + off + 4);
                    const f32x4 h0 = x0 + acc[ai][bj][m][0] * alpha, h1 = x1 + acc[ai][bj][m][1] * alpha;
                    *(f32x4*)(out + off) = h0; *(f32x4*)(out + off + 4) = h1; *(u32x4*)(hb + off) = pack8(h0, h1);
                    q += (h0[0] * h0[0] + h0[1] * h0[1]) + (h0[2] * h0[2] + h0[3] * h0[3]) + (h1[0] * h1[0] + h1[1] * h1[1]) + (h1[2] * h1[2] + h1[3] * h1[3]); }
                q += __shfl_xor(q, 16); q += __shfl_xor(q, 32);
                if (fq == 0) atomicAdd(ssq + row, q); }
    }
};
struct EpiMix {
    static constexpr bool PERM = true, AFTER_DRAIN = false;
    const float* ss; bf16_t *GLU, *Q, *K, *V, *QI, *KI; float* WI; bf16_t *GC, *GA; const float *qn, *kn;
    __device__ __forceinline__ void operator()(const f32x4 (&acc)[2][2][4][2], const Unit& u, int wr, int wc, int fr, int fq) const {
        const int row0 = u.pm * BM + wr * 64 + fr, cw = wc * 32 + 8 * fq, pn = u.pn;
        if (pn < 4) {
#pragma unroll
            for (int ai = 0; ai < 2; ++ai)
#pragma unroll
                for (int m = 0; m < 4; ++m) { const int row = row0 + ai * HALF + m * 16; const float rs = row_rs(ss, row); f32x4 o[2];
#pragma unroll
                    for (int n = 0; n < 2; ++n) { const f32x4 a = acc[ai][0][m][n] * rs, g = acc[ai][1][m][n] * rs;
#pragma unroll
                        for (int e = 0; e < 4; ++e) o[n][e] = a[e] * sigm(g[e]); }
                    *(u32x4*)(GLU + (size_t)row * 512 + pn * HALF + cw) = pack8(o[0], o[1]); }
        } else if (pn < 8) {
            const bool isq = pn < 6; const int head = 4 * ((pn - 4) & 1) + wc; const float* gn = isq ? qn : kn; bf16_t* dst = isq ? Q : K; const float post = isq ? Q_C2 : 1.0f;
            f32x4 g[2][2];
#pragma unroll
            for (int bj = 0; bj < 2; ++bj)
#pragma unroll
                for (int n = 0; n < 2; ++n) g[bj][n] = *(const f32x4*)(gn + 32 * bj + 8 * fq + 4 * n);
#pragma unroll
            for (int ai = 0; ai < 2; ++ai)
#pragma unroll
                for (int m = 0; m < 4; ++m) { const int row = row0 + ai * HALF + m * 16; const float rs = row_rs(ss, row); f32x4 v[2][2]; float s = 0.f;
#pragma unroll
                    for (int bj = 0; bj < 2; ++bj)
#pragma unroll
                        for (int n = 0; n < 2; ++n) { v[bj][n] = acc[ai][bj][m][n] * rs; const f32x4 t = v[bj][n]; s += (t[0] * t[0] + t[1] * t[1]) + (t[2] * t[2] + t[3] * t[3]); }
                    s += __shfl_xor(s, 16); s += __shfl_xor(s, 32);
                    const float rn = __builtin_amdgcn_rsqf(s * (1.0f / 64.0f) + NORM_EPS) * post;
#pragma unroll
                    for (int bj = 0; bj < 2; ++bj) *(u32x4*)(dst + (size_t)row * 512 + 64 * head + 32 * bj + 8 * fq) = pack8(v[bj][0] * rn * g[bj][0], v[bj][1] * rn * g[bj][1]); }
        } else if (pn < 10) {
#pragma unroll
            for (int ai = 0; ai < 2; ++ai)
#pragma unroll
                for (int m = 0; m < 4; ++m) { const int row = row0 + ai * HALF + m * 16; const float rs = row_rs(ss, row);
#pragma unroll
                    for (int bj = 0; bj < 2; ++bj) *(u32x4*)(V + (size_t)row * 512 + (pn - 8) * BM + bj * HALF + cw) = pack8(acc[ai][bj][m][0] * rs, acc[ai][bj][m][1] * rs); }
        } else if (pn == 10) {
#pragma unroll
            for (int ai = 0; ai < 2; ++ai)
#pragma unroll
                for (int m = 0; m < 4; ++m) { const int row = row0 + ai * HALF + m * 16; const float rs = row_rs(ss, row);
#pragma unroll
                    for (int bj = 0; bj < 2; ++bj) *(u32x4*)(QI + (size_t)row * 256 + bj * HALF + cw) = pack8h(acc[ai][bj][m][0] * rs, acc[ai][bj][m][1] * rs); }
        } else if (pn == 11) {
#pragma unroll
            for (int ai = 0; ai < 2; ++ai)
#pragma unroll
                for (int m = 0; m < 4; ++m) { const int row = row0 + ai * HALF + m * 16; const float rs = row_rs(ss, row);
                    if (wc < 2) *(u32x4*)(KI + (size_t)row * 64 + cw) = pack8h(acc[ai][0][m][0] * rs, acc[ai][0][m][1] * rs);
                    else if (wc == 2 && fq == 0) *(f32x4*)(WI + (size_t)row * 4) = acc[ai][0][m][0] * (rs * 0.0625f); }
        } else {
            bf16_t* dst = pn < 16 ? GC : GA; const int ct = (pn < 16 ? pn - 12 : pn - 16) * BM;
#pragma unroll
            for (int ai = 0; ai < 2; ++ai)
#pragma unroll
                for (int m = 0; m < 4; ++m) { const int row = row0 + ai * HALF + m * 16; const float rs = row_rs(ss, row);
#pragma unroll
                    for (int bj = 0; bj < 2; ++bj) { f32x4 o[2];
#pragma unroll
                        for (int n = 0; n < 2; ++n)
#pragma unroll
                            for (int e = 0; e < 4; ++e) o[n][e] = sigm(acc[ai][bj][m][n][e] * rs);
                        *(u32x4*)(dst + (size_t)row * 1024 + ct + bj * HALF + cw) = pack8(o[0], o[1]); } }
        }
    }
};
template <int MODE> struct EpiGate {
    static constexpr bool PERM = true, AFTER_DRAIN = false;
    bf16_t* T; const bf16_t* GA;
    __device__ __forceinline__ void operator()(const f32x4 (&acc)[2][2][4][2], const Unit& u, int wr, int wc, int fr, int fq) const {
        const int row0 = u.pm * BM + wr * 64 + fr, col0 = u.pn * BM + wc * 32 + 8 * fq;
#pragma unroll
        for (int ai = 0; ai < 2; ++ai)
#pragma unroll
            for (int m = 0; m < 4; ++m) { const int row = row0 + ai * HALF + m * 16;
#pragma unroll
                for (int bj = 0; bj < 2; ++bj) { const size_t off = (size_t)row * 1024 + col0 + bj * HALF; f32x4 o0, o1;
                    if (MODE == 0) { const u32x4 g = *(const u32x4*)(T + off); o0 = unpk_lo(g) * acc[ai][bj][m][0]; o1 = unpk_hi(g) * acc[ai][bj][m][1]; }
                    else if (MODE == 1) { const u32x4 t = *(const u32x4*)(T + off); const u32x4 g = *(const u32x4*)(GA + off); o0 = unpk_lo(t) + unpk_lo(g) * acc[ai][bj][m][0]; o1 = unpk_hi(t) + unpk_hi(g) * acc[ai][bj][m][1]; }
                    else { o0 = acc[ai][bj][m][0]; o1 = acc[ai][bj][m][1]; }
                    *(u32x4*)(T + off) = pack8(o0, o1); } }
    }
};
struct EpiPle {
    static constexpr bool PERM = true, AFTER_DRAIN = false;
    float* out; const bf16_t* P; const float* ss;
    __device__ __forceinline__ void operator()(const f32x4 (&acc)[2][2][4][2], const Unit& u, int wr, int wc, int fr, int fq) const {
        const int row0 = u.pm * BM + wr * 64 + fr, col0 = u.pn * BM + wc * 32 + 8 * fq;
#pragma unroll
        for (int ai = 0; ai < 2; ++ai)
#pragma unroll
            for (int m = 0; m < 4; ++m) { const int row = row0 + ai * HALF + m * 16; const float rs = row_rs(ss, row);
#pragma unroll
                for (int bj = 0; bj < 2; ++bj) { const size_t off = (size_t)row * 1024 + col0 + bj * HALF;
                    const u32x4 pr = *(const u32x4*)(P + off); const f32x4 p0 = unpk_lo(pr), p1 = unpk_hi(pr);
                    f32x4 h0 = *(const f32x4*)(out + off), h1 = *(const f32x4*)(out + off + 4);
#pragma unroll
                    for (int e = 0; e < 4; ++e) { h0[e] += sigm(acc[ai][bj][m][0][e] * rs) * p0[e]; h1[e] += sigm(acc[ai][bj][m][1][e] * rs) * p1[e]; }
                    *(f32x4*)(out + off) = h0; *(f32x4*)(out + off + 4) = h1; }
                asm volatile("" ::: "memory"); }
    }
};

template <class Epi, class Sched, bool ALIGN_EPI = false, bool SP2 = false>
__device__ __forceinline__ void gemm_phase(PG8_LAS unsigned char* lds, const Gemm g, const Sched& S, const Epi& E) {
    const int tid = threadIdx.x, wid = __builtin_amdgcn_readfirstlane(tid >> 6), lane = tid & 63, wr = wid >> 2, wc = wid & 3, fr = lane & 15, fq = lane >> 4;
    const int K = g.K, nt = K / BK;
    unsigned voffA[2], voffB[2];
#pragma unroll
    for (int i = 0; i < 2; ++i) { int R, C; stage_rc(tid * 16 + i * 8192, R, C); const int Rb = Epi::PERM ? ((R & ~31) + perm32(R & 31)) : R;
        voffA[i] = (unsigned)(R * K + C) * 2u; voffB[i] = (unsigned)(Rb * K + C) * 2u; }
    const size_t kstep = (size_t)(BK * 2);
    const size_t hstep = (size_t)HALF * K * 2;
    const size_t tstep = 2 * hstep;
    const unsigned ldsw = (unsigned)wid * 1024u;
    const int aoff = lds_byte(wr * 64 + fr, fq * 8), boff = lds_byte(wc * 32 + fr, fq * 8);
#define PG8_SA(b, h) (((b) * 2 + (h)) * HTB)
#define PG8_SB(b, h) ((4 + (b) * 2 + (h)) * HTB)
#define PG8_STAGE(bufoff, gbase, voff) do { _Pragma("unroll") for (int _i = 0; _i < 2; ++_i) \
        __builtin_amdgcn_global_load_lds((const unsigned*)((const char*)(gbase) + (voff)[_i]), (PG8_LAS unsigned*)(lds + (bufoff) + ldsw + _i * 8192), 16, 0, 0); } while (0)
#define PG8_LDA(dst, b, h) do { _Pragma("unroll") for (int m = 0; m < 4; ++m) _Pragma("unroll") for (int k = 0; k < 2; ++k) dst[m][k] = *(const PG8_LAS bf16x8*)(lds + PG8_SA(b, h) + aoff + m * 2048 + k * 1024); } while (0)
#define PG8_LDB(dst, b, h) do { _Pragma("unroll") for (int n = 0; n < 2; ++n) _Pragma("unroll") for (int k = 0; k < 2; ++k) dst[n][k] = *(const PG8_LAS bf16x8*)(lds + PG8_SB(b, h) + boff + n * 2048 + k * 1024); } while (0)
#define PG8_MMA(ai, bj, At, Bt) do { __builtin_amdgcn_s_setprio(1); _Pragma("unroll") for (int m = 0; m < 4; ++m) _Pragma("unroll") for (int n = 0; n < 2; ++n) _Pragma("unroll") for (int k = 0; k < 2; ++k) \
        acc[ai][bj][m][n] = __builtin_amdgcn_mfma_f32_16x16x32_bf16(Bt[n][k], At[m][k], acc[ai][bj][m][n], 0, 0, 0); __builtin_amdgcn_s_setprio(0); } while (0)
#define PG8_WAIT_V(n) asm volatile("s_waitcnt vmcnt(" #n ")" ::: "memory")
#define PG8_WAIT_L(n) asm volatile("s_waitcnt lgkmcnt(" #n ")" ::: "memory")
#define PG8_BAR __builtin_amdgcn_s_barrier()
#define PG8_SCHED __builtin_amdgcn_sched_barrier(0)
    Unit cur, nxt; int ui = 0;
    if (!S.next(0, cur)) return;
    f32x4 acc[2][2][4][2];
#pragma unroll
    for (int a = 0; a < 2; ++a)
#pragma unroll
        for (int b = 0; b < 2; ++b)
#pragma unroll
            for (int m = 0; m < 4; ++m)
#pragma unroll
                for (int n = 0; n < 2; ++n) acc[a][b][m][n] = (f32x4){0.f, 0.f, 0.f, 0.f};
    bf16x8 At[4][2], B0[2][2], B1[2][2];
    const char* cA = (const char*)g.A + (size_t)cur.pm * tstep; const char* cB = (const char*)g.Bt + (size_t)cur.pn * tstep;
    S.a_ready(cur);
    if constexpr (SP2) {
        PG8_STAGE(PG8_SB(0, 0), cB, voffB); PG8_STAGE(PG8_SB(0, 1), cB + hstep, voffB); PG8_STAGE(PG8_SA(0, 0), cA, voffA); PG8_STAGE(PG8_SA(0, 1), cA + hstep, voffA);
        if (wr == 1) PG8_BAR;
        PG8_WAIT_V(2); PG8_BAR;
        PG8_STAGE(PG8_SB(1, 0), cB + kstep, voffB); PG8_STAGE(PG8_SA(1, 0), cA + kstep, voffA); PG8_STAGE(PG8_SB(1, 1), cB + hstep + kstep, voffB);
        PG8_WAIT_V(6); PG8_BAR;
    } else {
        PG8_STAGE(PG8_SB(0, 0), cB, voffB); PG8_STAGE(PG8_SA(0, 0), cA, voffA); PG8_STAGE(PG8_SB(0, 1), cB + hstep, voffB); PG8_STAGE(PG8_SA(0, 1), cA + hstep, voffA);
        if (wr == 1) PG8_BAR;
        PG8_WAIT_V(4); PG8_BAR;
        PG8_STAGE(PG8_SB(1, 0), cB + kstep, voffB); PG8_STAGE(PG8_SA(1, 0), cA + kstep, voffA); PG8_STAGE(PG8_SB(1, 1), cB + hstep + kstep, voffB);
        PG8_WAIT_V(6); PG8_BAR;
    }
    for (;;) {
        const bool has_next = S.next(ui + 1, nxt);
        const char* nA = has_next ? (const char*)g.A + (size_t)nxt.pm * tstep : cA; const char* nB = has_next ? (const char*)g.Bt + (size_t)nxt.pn * tstep : cB;
        for (int t = 0; t < nt; t += 2) {
            const bool last = (t == nt - 2);
            const char* a1 = cA + (size_t)(t + 1) * kstep;
            const char* a2 = last ? nA : cA + (size_t)(t + 2) * kstep; const char* b2 = last ? nB : cB + (size_t)(t + 2) * kstep;
            const char* a3 = a2 + kstep; const char* b3 = b2 + kstep;
            if (last && has_next) S.a_ready(nxt);
            if constexpr (SP2) {
            PG8_LDB(B0, 0, 0); PG8_LDB(B1, 0, 1); PG8_SCHED; PG8_LDA(At, 0, 0); PG8_STAGE(PG8_SA(1, 1), a1 + hstep, voffA);
            PG8_WAIT_V(8); PG8_WAIT_L(0); PG8_BAR; PG8_MMA(0, 0, At, B0); PG8_MMA(0, 1, At, B1); PG8_BAR; PG8_SCHED;
            PG8_LDA(At, 0, 1); PG8_STAGE(PG8_SB(0, 0), b2, voffB); PG8_STAGE(PG8_SB(0, 1), b2 + hstep, voffB); PG8_STAGE(PG8_SA(0, 0), a2, voffA);
            PG8_WAIT_V(8); PG8_WAIT_L(0); PG8_BAR; PG8_MMA(1, 0, At, B0); PG8_MMA(1, 1, At, B1); PG8_BAR; PG8_SCHED;
            PG8_LDB(B0, 1, 0); PG8_LDB(B1, 1, 1); PG8_SCHED; PG8_LDA(At, 1, 0); PG8_STAGE(PG8_SA(0, 1), a2 + hstep, voffA);
            PG8_WAIT_V(8); PG8_WAIT_L(0); PG8_BAR; PG8_MMA(0, 0, At, B0); PG8_MMA(0, 1, At, B1); PG8_BAR; PG8_SCHED;
            PG8_LDA(At, 1, 1); PG8_STAGE(PG8_SB(1, 0), b3, voffB); PG8_STAGE(PG8_SB(1, 1), b3 + hstep, voffB); PG8_STAGE(PG8_SA(1, 0), a3, voffA);
            PG8_WAIT_V(8); PG8_WAIT_L(0); PG8_BAR; PG8_MMA(1, 0, At, B0); PG8_MMA(1, 1, At, B1); PG8_BAR; PG8_SCHED;
            } else {
            PG8_LDB(B0, 0, 0); PG8_SCHED; PG8_LDA(At, 0, 0); PG8_STAGE(PG8_SA(1, 1), a1 + hstep, voffA);
            PG8_WAIT_L(8); PG8_BAR; PG8_WAIT_L(0); PG8_MMA(0, 0, At, B0); PG8_BAR; PG8_SCHED;
            PG8_LDB(B1, 0, 1); PG8_STAGE(PG8_SB(0, 0), b2, voffB);
            PG8_BAR; PG8_WAIT_L(0); PG8_MMA(0, 1, At, B1); PG8_BAR;
            PG8_LDA(At, 0, 1); PG8_STAGE(PG8_SA(0, 0), a2, voffA);
            PG8_BAR; PG8_WAIT_L(0); PG8_MMA(1, 0, At, B0); PG8_BAR; PG8_SCHED;
            PG8_STAGE(PG8_SB(0, 1), b2 + hstep, voffB);
            PG8_WAIT_V(6); PG8_BAR; PG8_MMA(1, 1, At, B1); PG8_BAR;
            PG8_LDB(B0, 1, 0); PG8_SCHED; PG8_LDA(At, 1, 0); PG8_STAGE(PG8_SA(0, 1), a2 + hstep, voffA);
            PG8_WAIT_L(8); PG8_BAR; PG8_WAIT_L(0); PG8_MMA(0, 0, At, B0); PG8_BAR; PG8_SCHED;
            PG8_LDB(B1, 1, 1); PG8_STAGE(PG8_SB(1, 0), b3, voffB);
            PG8_BAR; PG8_WAIT_L(0); PG8_MMA(0, 1, At, B1); PG8_BAR;
            PG8_LDA(At, 1, 1); PG8_STAGE(PG8_SA(1, 0), a3, voffA);
            PG8_BAR; PG8_WAIT_L(0); PG8_MMA(1, 0, At, B0); PG8_BAR; PG8_SCHED;
            PG8_STAGE(PG8_SB(1, 1), b3 + hstep, voffB);
            PG8_WAIT_V(6); PG8_BAR; PG8_MMA(1, 1, At, B1); PG8_BAR;
            }
        }
        if constexpr (ALIGN_EPI) { if (wr == 0) PG8_BAR; }
        if constexpr (!Epi::AFTER_DRAIN) { E(acc, cur, wr, wc, fr, fq); S.done(cur); }
        if (!has_next) break;
#pragma unroll
        for (int a = 0; a < 2; ++a)
#pragma unroll
            for (int b = 0; b < 2; ++b)
#pragma unroll
                for (int m = 0; m < 4; ++m)
#pragma unroll
                    for (int n = 0; n < 2; ++n) acc[a][b][m][n] = (f32x4){0.f, 0.f, 0.f, 0.f};
        cur = nxt; cA = nA; cB = nB; ++ui;
        if constexpr (ALIGN_EPI) { if (wr == 1) PG8_BAR; }
    }
    PG8_WAIT_V(0);
    if constexpr (!ALIGN_EPI) { if (wr == 0) PG8_BAR; }
    PG8_BAR;
    if constexpr (Epi::AFTER_DRAIN) { E.fused(acc, cur, wr, wc, fr, fq, lds, wid, lane); S.done(cur); }
#undef PG8_SA
#undef PG8_SB
#undef PG8_STAGE
#undef PG8_LDA
#undef PG8_LDB
#undef PG8_MMA
#undef PG8_WAIT_V
#undef PG8_WAIT_L
#undef PG8_BAR
#undef PG8_SCHED
}
}
constexpr int NWAVES = 8;
constexpr int NPHASE = 11;
#ifndef MK_N_LAUNCHES
#define MK_N_LAUNCHES 11
#endif
constexpr int N_LAUNCHES = MK_N_LAUNCHES;

constexpr int M = 16384, D = 1024, DFF = 2816, NMIXP = 5120, CCH = 512, AW = 512, NH = 8, HD = 64, PLE = 256, CONVW = 31;
constexpr float EPS = 1e-6f;
constexpr float LOG2E = 1.4426950408889634f;

constexpr size_t MiB = 1u << 20;
constexpr size_t WS_CTL = 0, CTL_ZERO_BYTES = 1 * MiB;
constexpr size_t WS_W1IN = 1 * MiB;
constexpr size_t WS_W1OUT = 12 * MiB;
constexpr size_t WS_WMIX = 18 * MiB;
constexpr size_t WS_WCO = 28 * MiB;
constexpr size_t WS_WAO = 29 * MiB;
constexpr size_t WS_WMO = 30 * MiB;
constexpr size_t WS_W2IN = 32 * MiB;
constexpr size_t WS_W2OUT = 43 * MiB;
constexpr size_t WS_WPG = 49 * MiB;
constexpr size_t WS_WPP = 51 * MiB;
constexpr size_t WS_HB = 52 * MiB;
constexpr size_t WS_MASK = WS_HB;
constexpr size_t WS_ACT = 84 * MiB;
constexpr size_t WS_GLU = WS_ACT;
constexpr size_t WS_ATT = WS_ACT;
constexpr size_t WS_Q = WS_ACT + 16 * MiB, WS_K = WS_ACT + 32 * MiB, WS_V = WS_ACT + 48 * MiB;
constexpr size_t WS_QI = WS_ACT + 64 * MiB;
constexpr size_t WS_KI = WS_ACT + 72 * MiB;
constexpr size_t WS_WI = WS_ACT + 74 * MiB;
constexpr size_t WS_GC = 172 * MiB;
constexpr size_t WS_GA = 204 * MiB;
constexpr size_t WS_PB = WS_GC;
constexpr size_t WS_PROJ = WS_GA;
constexpr size_t WS_ZC = 236 * MiB;
constexpr size_t WS_END = 252 * MiB;
constexpr int CW_TMO = 0, CW_CODE = 1;
constexpr int CW_BAR = 4096;
constexpr size_t CTL_SS1 = 64 * 1024, CTL_SS2 = 128 * 1024, CTL_SS3 = 192 * 1024, CTL_SS4 = 256 * 1024;

constexpr int RING_OFF = 0, RING_BYTES = 131072;
constexpr int LDSCTL_OFF = RING_BYTES, MISC_OFF = LDSCTL_OFF + 320;
constexpr int LDS_BYTES = 147456;

#define GAS __attribute__((address_space(1)))
#define LAS __attribute__((address_space(3)))
typedef unsigned short bf16;
typedef unsigned v4u __attribute__((ext_vector_type(4)));
typedef float f32x4 __attribute__((ext_vector_type(4)));
typedef short bf16x8 __attribute__((ext_vector_type(8)));
typedef GAS unsigned gu32;
typedef GAS unsigned long long gu64;
#define RLX_AGENT __ATOMIC_RELAXED, __HIP_MEMORY_SCOPE_AGENT
#define LDS_WAIT() asm volatile("s_waitcnt lgkmcnt(0)" ::: "memory")
#define VM_WAIT() asm volatile("s_waitcnt vmcnt(0)" ::: "memory")
__device__ __forceinline__ unsigned long long rt() { return __builtin_amdgcn_s_memrealtime(); }
__device__ __forceinline__ unsigned f2bf(float f) { unsigned u = __builtin_bit_cast(unsigned, f); return (u + 0x7fffu + ((u >> 16) & 1u)) >> 16; }
__device__ __forceinline__ unsigned pk2(float lo, float hi) { return f2bf(lo) | (f2bf(hi) << 16); }

#define XB_TMO      128
#define XB_XCNT(j)  (256  + 64 * (j))
#define XB_XSUB(j)  (1280 + 64 * (j))
#define XB_XGEN(j)  (2304 + 64 * (j))
#define XB_TOP      3328
#define XB_TOPGEN   3392
#define XCD_BAR_WORDS 3456
#define XB_SPIN_CAP (1u << 18)

__device__ __forceinline__ unsigned xb_ld(unsigned* p)              { return __hip_atomic_load(p, __ATOMIC_RELAXED, __HIP_MEMORY_SCOPE_AGENT); }
__device__ __forceinline__ unsigned xb_add(unsigned* p, unsigned v) { return __hip_atomic_fetch_add(p, v, __ATOMIC_RELAXED, __HIP_MEMORY_SCOPE_AGENT); }
__device__ __forceinline__ unsigned xb_xcc_id() { return (unsigned)__builtin_amdgcn_s_getreg((3 << 11) | 20) & 0xFu; }
#define XB_SPIN(cond, bar) do { unsigned _sp = 0; while (cond) { __builtin_amdgcn_s_sleep(1); \
    if ((++_sp & 255u) == 0u) { if (xb_ld(&(bar)[XB_TMO])) break; if (_sp > XB_SPIN_CAP) { atomicAdd(&(bar)[XB_TMO], 1u); break; } } } } while (0)

struct XcdBarrier {
    unsigned* bar; unsigned x;
    volatile LAS unsigned* st;
};

__device__ __forceinline__ XcdBarrier xcd_barrier_post(unsigned* bar, volatile LAS unsigned* st) {
    XcdBarrier b; b.bar = bar; b.x = xb_xcc_id(); b.st = st;
    if (threadIdx.x == 0) (void)xb_add(&bar[XB_XCNT(b.x)], 1u);
    return b;
}
__device__ __forceinline__ void xcd_barrier_complete(unsigned* bar, unsigned x, unsigned& nloc, unsigned& nx) {
    const unsigned G = gridDim.x * gridDim.y * gridDim.z;
    unsigned sum, cnt, mine, sp = 0u;
    for (;;) {
        sum = 0u; cnt = 0u; mine = 0u;
#pragma unroll
        for (unsigned j = 0; j < 16; ++j) { const unsigned c = xb_ld(&bar[XB_XCNT(j)]); sum += c; cnt += (c > 0u) ? 1u : 0u; mine = (j == x) ? c : mine; }
        if (sum == G) break;
        __builtin_amdgcn_s_sleep(1);
        if ((++sp & 255u) == 0u) { if (xb_ld(&bar[XB_TMO])) break; if (sp > XB_SPIN_CAP) { atomicAdd(&bar[XB_TMO], 1u); break; } }
    }
    nloc = mine > 0u ? mine : 1u; nx = cnt > 0u ? cnt : 1u;
}

__device__ __forceinline__ void xcd_barrier(const XcdBarrier& b) {
    asm volatile("s_waitcnt vmcnt(0)" ::: "memory");
    __syncthreads();
    if (threadIdx.x == 0) {
        unsigned* bar = b.bar;
        __builtin_amdgcn_s_waitcnt(0);
        unsigned nloc = b.st[0], nx = b.st[1];
        if (nloc == 0u) { xcd_barrier_complete(bar, b.x, nloc, nx); b.st[0] = nloc; b.st[1] = nx; }
        const unsigned old = xb_add(&bar[XB_XSUB(b.x)], 1u);
        const unsigned gen = old / nloc;
        if (old + 1u == (gen + 1u) * nloc) {
            __builtin_amdgcn_fence(__ATOMIC_RELEASE, "agent");
            asm volatile("s_waitcnt vmcnt(0)" ::: "memory");
            const unsigned og = xb_add(&bar[XB_TOP], 1u);
            const unsigned tg = og / nx;
            if (og + 1u == (tg + 1u) * nx) xb_add(&bar[XB_TOPGEN], 1u);
            else XB_SPIN(xb_ld(&bar[XB_TOPGEN]) == tg, bar);
            __builtin_amdgcn_fence(__ATOMIC_ACQUIRE, "agent");
            xb_add(&bar[XB_XGEN(b.x)], 1u);
            asm volatile("s_waitcnt vmcnt(0)" ::: "memory");
        } else {
            XB_SPIN(xb_ld(&bar[XB_XGEN(b.x)]) == gen, bar);
            __builtin_amdgcn_fence(__ATOMIC_ACQUIRE, "agent");
            asm volatile("s_waitcnt vmcnt(0)" ::: "memory");
        }
    }
    __syncthreads();
}

struct Frame {
    LAS unsigned char* lds;
    volatile LAS unsigned* MISC;
    gu32* ctl;
    int tid, lane, wave;
    int vcu, G;
};
__device__ __forceinline__ float wave_sum(float v) {
#pragma unroll
    for (int o = 1; o < 64; o <<= 1) v += __shfl_xor(v, o);
    return v;
}
__device__ __forceinline__ float wave_max(float v) {
#pragma unroll
    for (int o = 1; o < 64; o <<= 1) v = fmaxf(v, __shfl_xor(v, o));
    return v;
}
__device__ __forceinline__ float bflo(unsigned w) { return __uint_as_float(w << 16); }
__device__ __forceinline__ float bfhi(unsigned w) { return __uint_as_float(w & 0xffff0000u); }
__device__ __forceinline__ float sigm_f(float x) { return __builtin_amdgcn_rcpf(1.f + __builtin_amdgcn_exp2f(-LOG2E * x)); }

__device__ __forceinline__ int wmap(int kind, int n0, int& nv) {
    nv = 32;
    if (kind == 0) return n0;
    const int T = n0 >> 8, rem = n0 & 255;
    if (kind == 1) return (rem >> 7) * DFF + 128 * T + (rem & 127);
    if (T < 4) return (rem >> 7) * 512 + 128 * T + (rem & 127);
    if (T < 8) { const int base = T < 6 ? 1024 : 1536, Tq = (T - 4) & 1, bj = rem >> 7, wc = (rem & 127) >> 5; return base + 64 * (4 * Tq + wc) + 32 * bj; }
    if (T < 10) return 2048 + 256 * (T - 8) + rem;
    if (T == 10) return 2560 + rem;
    if (T == 11) { if (rem < 64) return 2816 + rem; if (rem == 64) { nv = 4; return 2880; } nv = 0; return 0; }
    return 2884 + 256 * (T - 12) + rem;
}
__device__ __forceinline__ void p0_transpose_item(const float* W, int K, int Nsrc, bf16* WT, int ng, int kind, const float* gain, LAS float* scr, int item, int lane) {
    const int kb = item / ng, nb = item % ng, k0 = 64 * kb, n0 = 32 * nb;
    int nv; const int sc = wmap(kind, n0, nv);
    const bool ok = (lane & 31) < nv;
#pragma unroll 8
    for (int i = 0; i < 32; ++i) { const int kk = 2 * i + (lane >> 5);
        float v = ok ? W[(size_t)(k0 + kk) * Nsrc + sc + (lane & 31)] : 0.f;
        if (gain) v *= gain[k0 + kk];
        scr[kk * 33 + (lane & 31)] = v; }
    LDS_WAIT(); asm volatile("" ::: "memory");
    const int c = lane & 7;
#pragma unroll
    for (int j = 0; j < 4; ++j) { const int n = (lane >> 3) + 8 * j; const LAS float* s = scr + (8 * c) * 33 + n;
        v4u o; o.x = pk2(s[0 * 33], s[1 * 33]); o.y = pk2(s[2 * 33], s[3 * 33]); o.z = pk2(s[4 * 33], s[5 * 33]); o.w = pk2(s[6 * 33], s[7 * 33]);
        *(GAS v4u*)(WT + (size_t)(n0 + n) * K + k0 + 8 * c) = o; }
    LDS_WAIT(); asm volatile("" ::: "memory");
}
struct Args { const float* in[23]; float* out; unsigned char* ws; int ph_lo, ph_hi, li, pad; };
typedef const __attribute__((address_space(4))) Args* KArgs;
__device__ __forceinline__ KArgs kargs() { KArgs p = (KArgs)__builtin_amdgcn_kernarg_segment_ptr(); asm volatile("" : "+s"(p)); return p; }

__device__ __forceinline__ void p0_prologue(Frame& F, KArgs A) {
    LAS float* scr = (LAS float*)(F.lds + RING_OFF + F.wave * 16384);
    const int gw = F.vcu * NWAVES + F.wave, NGW = F.G * NWAVES;
    unsigned char* ws = A->ws;
    constexpr int I0 = 16 * 176, I1 = 44 * 32, I2 = 16 * 160, I3 = 8 * 32, I4 = 8 * 32, I5 = 16 * 32, I6 = 16 * 176, I7 = 44 * 32, I8 = 16 * 32, I9 = 4 * 32;
    constexpr int NITEMS = I0 + I1 + I2 + I3 + I4 + I5 + I6 + I7 + I8 + I9;
    for (int it = gw; it < NITEMS; it += NGW) {
        int r = it;
        if (r < I0) { p0_transpose_item(A->in[3], 1024, 5632, (bf16*)(ws + WS_W1IN), 176, 1, A->in[2], scr, r, F.lane); continue; } r -= I0;
        if (r < I1) { p0_transpose_item(A->in[4], 2816, 1024, (bf16*)(ws + WS_W1OUT), 32, 0, nullptr, scr, r, F.lane); continue; } r -= I1;
        if (r < I2) { p0_transpose_item(A->in[6], 1024, 4932, (bf16*)(ws + WS_WMIX), 160, 2, A->in[5], scr, r, F.lane); continue; } r -= I2;
        if (r < I3) { p0_transpose_item(A->in[11], 512, 1024, (bf16*)(ws + WS_WCO), 32, 0, nullptr, scr, r, F.lane); continue; } r -= I3;
        if (r < I4) { p0_transpose_item(A->in[14], 512, 1024, (bf16*)(ws + WS_WAO), 32, 0, nullptr, scr, r, F.lane); continue; } r -= I4;
        if (r < I5) { p0_transpose_item(A->in[15], 1024, 1024, (bf16*)(ws + WS_WMO), 32, 0, nullptr, scr, r, F.lane); continue; } r -= I5;
        if (r < I6) { p0_transpose_item(A->in[17], 1024, 5632, (bf16*)(ws + WS_W2IN), 176, 1, A->in[16], scr, r, F.lane); continue; } r -= I6;
        if (r < I7) { p0_transpose_item(A->in[18], 2816, 1024, (bf16*)(ws + WS_W2OUT), 32, 0, nullptr, scr, r, F.lane); continue; } r -= I7;
        if (r < I8) { p0_transpose_item(A->in[20], 1024, 1024, (bf16*)(ws + WS_WPG), 32, 0, A->in[19], scr, r, F.lane); continue; } r -= I8;
        p0_transpose_item(A->in[21], 256, 1024, (bf16*)(ws + WS_WPP), 32, 0, nullptr, scr, r, F.lane);
    }
    const float* x = A->in[0]; bf16* xb = (bf16*)(ws + WS_HB); float* ss1 = (float*)(ws + WS_CTL + CTL_SS1);
    for (int m = gw; m < M; m += NGW) {
        const GAS f32x4* xr = (const GAS f32x4*)(x + (size_t)m * D) + F.lane;
        f32x4 v[4]; float s = 0.f;
#pragma unroll
        for (int j = 0; j < 4; ++j) { v[j] = xr[64 * j]; s += (v[j].x * v[j].x + v[j].y * v[j].y) + (v[j].z * v[j].z + v[j].w * v[j].w); }
        s = wave_sum(s);
        if (F.lane == 0) ss1[m] = s;
        GAS unsigned long long* o8 = (GAS unsigned long long*)(xb + (size_t)m * D) + F.lane;
#pragma unroll
        for (int j = 0; j < 4; ++j) o8[64 * j] = (unsigned long long)pk2(v[j].x, v[j].y) | ((unsigned long long)pk2(v[j].z, v[j].w) << 32);
    }
}
__device__ __forceinline__ void convert_p(Frame& F, KArgs A) {
    const float* p = A->in[1]; bf16* pb = (bf16*)(A->ws + WS_PB);
    const int gt = F.vcu * (NWAVES * 64) + F.tid, NGT = F.G * NWAVES * 64;
    for (int i = gt; i < M * PLE / 8; i += NGT) {
        const f32x4 a = *(const GAS f32x4*)(p + (size_t)i * 8), b = *(const GAS f32x4*)(p + (size_t)i * 8 + 4);
        v4u o; o.x = pk2(a.x, a.y); o.y = pk2(a.z, a.w); o.z = pk2(b.x, b.y); o.w = pk2(b.z, b.w);
        *(GAS v4u*)(pb + (size_t)i * 8) = o;
    }
}

__device__ __forceinline__ void conv_phase(Frame& F, KArgs A) {
    const bf16* glu = (const bf16*)(A->ws + WS_GLU); bf16* zc = (bf16*)(A->ws + WS_ZC);
    const float* dw = A->in[7]; const float* db = A->in[8]; const float* lg = A->in[9]; const float* lb = A->in[10];
    const int gw = F.vcu * NWAVES + F.wave, NGW = F.G * NWAVES, c0 = 8 * F.lane;
    const f32x4 b0 = *(const GAS f32x4*)(db + c0), b1 = *(const GAS f32x4*)(db + c0 + 4);
    const f32x4 g0 = *(const GAS f32x4*)(lg + c0), g1 = *(const GAS f32x4*)(lg + c0 + 4);
    const f32x4 e0 = *(const GAS f32x4*)(lb + c0), e1 = *(const GAS f32x4*)(lb + c0 + 4);
    for (int t = gw; t < M; t += NGW) {
        f32x4 a0 = b0, a1 = b1;
        for (int w = 0; w < CONVW; ++w) { const int tt = t - (CONVW - 1) + w;
            if (tt >= 0) {
                const v4u z = *(const GAS v4u*)(glu + (size_t)tt * CCH + c0);
                const f32x4 w0 = *(const GAS f32x4*)(dw + w * CCH + c0), w1 = *(const GAS f32x4*)(dw + w * CCH + c0 + 4);
                a0 += (f32x4){bflo(z.x), bfhi(z.x), bflo(z.y), bfhi(z.y)} * w0; a1 += (f32x4){bflo(z.z), bfhi(z.z), bflo(z.w), bfhi(z.w)} * w1; } }
        const float mean = wave_sum((a0.x + a0.y) + (a0.z + a0.w) + (a1.x + a1.y) + (a1.z + a1.w)) * (1.0f / CCH);
        a0 = a0 - mean; a1 = a1 - mean;
        const float var = wave_sum((a0.x * a0.x + a0.y * a0.y) + (a0.z * a0.z + a0.w * a0.w) + (a1.x * a1.x + a1.y * a1.y) + (a1.z * a1.z + a1.w * a1.w)) * (1.0f / CCH);
        const float rstd = __builtin_amdgcn_rsqf(var + EPS);
        f32x4 y0 = a0 * rstd * g0 + e0, y1 = a1 * rstd * g1 + e1;
#pragma unroll
        for (int e = 0; e < 4; ++e) { y0[e] = y0[e] * sigm_f(y0[e]); y1[e] = y1[e] * sigm_f(y1[e]); }
        v4u o; o.x = pk2(y0.x, y0.y); o.y = pk2(y0.z, y0.w); o.z = pk2(y1.x, y1.y); o.w = pk2(y1.z, y1.w);
        *(GAS v4u*)(zc + (size_t)t * CCH + c0) = o;
    }
}

__device__ __forceinline__ unsigned ordkey(float s) { unsigned u = __float_as_uint(s); if (s == 0.f) u = 0u; return (u & 0x80000000u) ? ~u : (u | 0x80000000u); }
__device__ __forceinline__ float h2f(unsigned short h) { return (float)__builtin_bit_cast(_Float16, h); }

__device__ __forceinline__ void indexer_simple(Frame& F, KArgs A) {
    const unsigned short* QI = (const unsigned short*)(A->ws + WS_QI); const unsigned short* KI = (const unsigned short*)(A->ws + WS_KI); const float* WI = (const float*)(A->ws + WS_WI);
    unsigned* mask32 = (unsigned*)(A->ws + WS_MASK);
    LAS unsigned* skey = (LAS unsigned*)(F.lds);
    LAS float* qif = (LAS float*)(F.lds + 65536);
    LAS unsigned* hist = (LAS unsigned*)(F.lds + 65536 + 1024);
    LAS unsigned* cnt = (LAS unsigned*)(F.lds + 65536 + 2048);
    LAS unsigned* wtot = (LAS unsigned*)(F.lds + 65536 + 4096);
    LAS unsigned* res = (LAS unsigned*)(F.lds + 65536 + 4160);
    const int tid = F.tid, lane = F.lane, wv = F.wave, w = (int)blockIdx.x;
    for (int jj = 0; jj < 64; ++jj) {
        const int j = jj >> 1; const int t = 512 * j + ((jj & 1) ? (511 - w) : w);
        const int n = t + 1;
        __syncthreads();
        if (tid < 256) qif[tid] = h2f(QI[(size_t)t * 256 + tid]);
        const f32x4 w4 = *(const GAS f32x4*)(WI + (size_t)t * 4);
        __syncthreads();
        for (int s = tid; s < n; s += 512) {
            float dot[4] = {0.f, 0.f, 0.f, 0.f};
#pragma unroll 1
            for (int c = 0; c < 8; ++c) { asm volatile("" ::: "memory"); const v4u kv = *(const GAS v4u*)(KI + (size_t)s * 64 + 8 * c);
                const unsigned kw[4] = {kv.x, kv.y, kv.z, kv.w};
#pragma unroll
                for (int e = 0; e < 4; ++e) { const float k0 = h2f((unsigned short)(kw[e] & 0xffffu)), k1 = h2f((unsigned short)(kw[e] >> 16));
#pragma unroll
                    for (int h = 0; h < 4; ++h) { dot[h] += k0 * qif[64 * h + 8 * c + 2 * e]; dot[h] += k1 * qif[64 * h + 8 * c + 2 * e + 1]; } } }
            float sc = w4.x * fmaxf(dot[0], 0.f); sc += w4.y * fmaxf(dot[1], 0.f); sc += w4.z * fmaxf(dot[2], 0.f); sc += w4.w * fmaxf(dot[3], 0.f);
            skey[s] = ordkey(sc);
        }
        __syncthreads();
        unsigned T = 0u, r = 0u;
        if (n > 256) {
            unsigned prefix = 0u, pmask = 0u, remaining = 256u;
            for (int pass = 0; pass < 4; ++pass) { const int shift = 24 - 8 * pass;
                if (tid < 256) hist[tid] = 0u;
                __syncthreads();
                for (int s = tid; s < n; s += 512) { const unsigned k = skey[s]; if ((k & pmask) == prefix) __hip_atomic_fetch_add(&hist[(k >> shift) & 255u], 1u, __ATOMIC_RELAXED, __HIP_MEMORY_SCOPE_WORKGROUP); }
                __syncthreads();
                if (wv == 0) {
                    const unsigned c0 = hist[4 * lane], c1 = hist[4 * lane + 1], c2 = hist[4 * lane + 2], c3 = hist[4 * lane + 3];
                    const unsigned tl = c0 + c1 + c2 + c3; unsigned suf = tl;
#pragma unroll
                    for (int o = 1; o < 64; o <<= 1) { const unsigned v = __shfl_down(suf, o); if (lane + o < 64) suf += v; }
                    const unsigned above = suf - tl;
                    if (above < remaining && remaining <= suf) {
                        unsigned a = above; int d;
                        if (a + c3 >= remaining) d = 3; else { a += c3; if (a + c2 >= remaining) d = 2; else { a += c2; if (a + c1 >= remaining) d = 1; else { a += c1; d = 0; } } }
                        res[0] = (unsigned)(4 * lane + d); res[1] = remaining - a; }
                }
                __syncthreads();
                prefix |= res[0] << shift; pmask |= 255u << shift; remaining = res[1];
                __syncthreads();
            }
            T = prefix; r = remaining;
        }
        const int s0 = 32 * tid; unsigned eqc = 0u;
        for (int i = 0; i < 32; ++i) { const int s = s0 + i; if (s < n && skey[s] == T) ++eqc; }
        unsigned inc = eqc;
#pragma unroll
        for (int o = 1; o < 64; o <<= 1) { const unsigned v = __shfl_up(inc, o); if (lane >= o) inc += v; }
        if (lane == 63) wtot[wv] = inc;
        __syncthreads();
        unsigned run = inc - eqc;
        for (int v = 0; v < wv; ++v) run += wtot[v];
        unsigned word = 0u;
        for (int i = 0; i < 32; ++i) { const int s = s0 + i; if (s < n) { const unsigned k = skey[s]; if (k > T) word |= 1u << i; else if (k == T) { if (run < r) word |= 1u << i; ++run; } } }
        const int nchunk = 8 * ((t >> 8) + 1);
        if (tid < nchunk) mask32[((size_t)(tid >> 1) * M + t) * 2 + (tid & 1)] = word;
    }
}

__device__ __forceinline__ int t5_bucket(int d) {
    if (d < 16) return d;
    int b = 16;
    b += d >= 19; b += d >= 21; b += d >= 24; b += d >= 27; b += d >= 31; b += d >= 35; b += d >= 40; b += d >= 46;
    b += d >= 52; b += d >= 59; b += d >= 67; b += d >= 77; b += d >= 87; b += d >= 99; b += d >= 113;
    return b;
}
__device__ __forceinline__ void attn_simple(Frame& F, KArgs A) {
    const bf16* Q = (const bf16*)(A->ws + WS_Q); const bf16* K = (const bf16*)(A->ws + WS_K); const bf16* V = (const bf16*)(A->ws + WS_V); bf16* O = (bf16*)(A->ws + WS_ATT);
    const unsigned long long* mask = (const unsigned long long*)(A->ws + WS_MASK); const float* relb = A->in[22];
    LAS unsigned char* base = F.lds + F.wave * 4096;
    LAS unsigned short* list = (LAS unsigned short*)base;
    LAS float* pbuf = (LAS float*)(base + 512);
    LAS float* qf = (LAS float*)(base + 1536);
    const int lane = F.lane, gw = (int)blockIdx.x * NWAVES + F.wave;
    for (int j = 0; j < 8; ++j) {
        const int t = 2048 * j + ((j & 1) ? (2047 - gw) : gw);
        { const v4u qv = *(const GAS v4u*)(Q + (size_t)t * AW + 8 * lane);
          qf[8 * lane + 0] = bflo(qv.x); qf[8 * lane + 1] = bfhi(qv.x); qf[8 * lane + 2] = bflo(qv.y); qf[8 * lane + 3] = bfhi(qv.y);
          qf[8 * lane + 4] = bflo(qv.z); qf[8 * lane + 5] = bfhi(qv.z); qf[8 * lane + 6] = bflo(qv.w); qf[8 * lane + 7] = bfhi(qv.w); }
        const int NT = 4 * ((t >> 8) + 1);
        unsigned long long wd[4]; unsigned pc = 0u;
#pragma unroll
        for (int i = 0; i < 4; ++i) { const int kt = lane + 64 * i; wd[i] = (kt < NT) ? mask[(size_t)kt * M + t] : 0ull; pc += (unsigned)__popcll(wd[i]); }
        unsigned inc = pc;
#pragma unroll
        for (int o = 1; o < 64; o <<= 1) { const unsigned v = __shfl_up(inc, o); if (lane >= o) inc += v; }
        const int cnt = (int)__shfl(inc, 63);
        unsigned pos = inc - pc;
#pragma unroll
        for (int i = 0; i < 4; ++i) { unsigned long long wv = wd[i]; const int kt = lane + 64 * i;
            while (wv) { const int b = __builtin_ctzll(wv); wv &= wv - 1ull; if (pos < 256u) list[pos] = (unsigned short)(64 * kt + b); ++pos; } }
        LDS_WAIT(); asm volatile("" ::: "memory");
        const int ncl = cnt < 256 ? cnt : 256;
        for (int h = 0; h < NH; ++h) {
            float lg[4]; float mx = -INFINITY;
#pragma unroll
            for (int i = 0; i < 4; ++i) { const int e = lane + 64 * i; lg[i] = -INFINITY;
                if (e < ncl) { const int key = list[e]; const bf16* kr = K + (size_t)key * AW + 64 * h; float dot = 0.f;
#pragma unroll
                    for (int c = 0; c < 8; ++c) { const v4u kv = *(const GAS v4u*)(kr + 8 * c); const LAS float* qq = qf + 64 * h + 8 * c;
                        dot += bflo(kv.x) * qq[0]; dot += bfhi(kv.x) * qq[1]; dot += bflo(kv.y) * qq[2]; dot += bfhi(kv.y) * qq[3];
                        dot += bflo(kv.z) * qq[4]; dot += bfhi(kv.z) * qq[5]; dot += bflo(kv.w) * qq[6]; dot += bfhi(kv.w) * qq[7]; }
                    lg[i] = dot + relb[t5_bucket(t - key) * NH + h] * LOG2E; }
                mx = fmaxf(mx, lg[i]); }
            mx = wave_max(mx);
            float sm = 0.f;
#pragma unroll
            for (int i = 0; i < 4; ++i) { const int e = lane + 64 * i; const float p = (e < ncl) ? __builtin_amdgcn_exp2f(lg[i] - mx) : 0.f; sm += p; if (e < ncl) pbuf[e] = p; }
            sm = wave_sum(sm);
            LDS_WAIT(); asm volatile("" ::: "memory");
            float acc = 0.f;
            for (int e = 0; e < ncl; ++e) { const int key = list[e]; acc += pbuf[e] * __uint_as_float((unsigned)V[(size_t)key * AW + 64 * h + lane] << 16); }
            O[(size_t)t * AW + 64 * h + lane] = (bf16)f2bf(acc / sm);
            LDS_WAIT(); asm volatile("" ::: "memory");
        }
    }
}


__global__ void __launch_bounds__(NWAVES * 64, 2) mega_fwd(Args args) {
    extern __shared__ __attribute__((aligned(16))) unsigned char lds[];
    Frame F;
    F.lds = (LAS unsigned char*)lds;
    F.MISC = (volatile LAS unsigned*)(F.lds + MISC_OFF);
    F.tid = threadIdx.x; F.lane = F.tid & 63; F.wave = __builtin_amdgcn_readfirstlane(F.tid >> 6);
    F.G = gridDim.x; { const int bx = blockIdx.x; F.vcu = (F.G % 8 == 0) ? (bx % 8) * (F.G / 8) + bx / 8 : bx; }
    F.ctl = (gu32*)(kargs()->ws + WS_CTL);
    for (int u = F.tid; u < (LDS_BYTES - LDSCTL_OFF) / 4; u += NWAVES * 64) ((LAS unsigned*)(F.lds + LDSCTL_OFF))[u] = 0u;
    __syncthreads();
    const int lo = kargs()->ph_lo, hi = kargs()->ph_hi;
    const bool multi = (hi - lo) > 1;
    XcdBarrier bar; bar.bar = (unsigned*)(F.ctl + CW_BAR); bar.x = 0; bar.st = nullptr;
    if (multi) bar = xcd_barrier_post((unsigned*)(F.ctl + CW_BAR), F.MISC + 8);
#ifndef PHMASK
#define PHMASK 0x7ff
#endif
#define IN(k) (((PHMASK >> (k)) & 1) && lo <= (k) && (k) < hi)
#define SEAM(k) do { if (IN(k) && IN((k) + 1)) xcd_barrier(bar); } while (0)
#define WSP unsigned char* ws = kargs()->ws
#define BFP(off) ((pg8::bf16_t*)(ws + (off)))
#define CBFP(off) ((const pg8::bf16_t*)(ws + (off)))
#define SSP(off) ((float*)(ws + WS_CTL + (off)))
    const int cidx = (int)blockIdx.x;

    if (IN(0)) { p0_prologue(F, kargs()); } SEAM(0);
    if (IN(1)) { WSP; pg8::Gemm g{CBFP(WS_HB), CBFP(WS_W1IN), M, 2 * DFF, D}; pg8::StaticOrder S; S.init(M, 2 * DFF, F.G, cidx);
        pg8::EpiSwiglu E{BFP(WS_ACT), SSP(CTL_SS1)}; pg8::gemm_phase<pg8::EpiSwiglu, pg8::StaticOrder, true, true>(F.lds + RING_OFF, g, S, E); } SEAM(1);
    if (IN(2)) { WSP; pg8::Gemm g{CBFP(WS_ACT), CBFP(WS_W1OUT), M, D, DFF}; pg8::StaticOrder S; S.init(M, D, F.G, cidx);
        pg8::EpiRes E{kargs()->in[0], kargs()->out, BFP(WS_HB), SSP(CTL_SS2), 0.5f}; pg8::gemm_phase<pg8::EpiRes, pg8::StaticOrder, true, true>(F.lds + RING_OFF, g, S, E); } SEAM(2);
    if (IN(3)) { WSP; pg8::Gemm g{CBFP(WS_HB), CBFP(WS_WMIX), M, NMIXP, D}; pg8::StaticOrder S; S.init(M, NMIXP, F.G, cidx);
        pg8::EpiMix E{SSP(CTL_SS2), (pg8::bf16_t*)(ws + WS_GLU), (pg8::bf16_t*)(ws + WS_Q), (pg8::bf16_t*)(ws + WS_K), (pg8::bf16_t*)(ws + WS_V), (pg8::bf16_t*)(ws + WS_QI), (pg8::bf16_t*)(ws + WS_KI),
                      (float*)(ws + WS_WI), (pg8::bf16_t*)(ws + WS_GC), (pg8::bf16_t*)(ws + WS_GA), kargs()->in[12], kargs()->in[13]};
        pg8::gemm_phase<pg8::EpiMix, pg8::StaticOrder, true, true>(F.lds + RING_OFF, g, S, E); } SEAM(3);
    if (IN(4)) { conv_phase(F, kargs()); indexer_simple(F, kargs()); } SEAM(4);
    if (IN(5)) { attn_simple(F, kargs()); __syncthreads();
        WSP; pg8::Gemm g{CBFP(WS_ZC), CBFP(WS_WCO), M, D, CCH}; pg8::StaticOrder S; S.init(M, D, F.G, cidx);
        pg8::EpiGate<0> E{(pg8::bf16_t*)(ws + WS_GC), nullptr}; pg8::gemm_phase<pg8::EpiGate<0>, pg8::StaticOrder, true, true>(F.lds + RING_OFF, g, S, E); } SEAM(5);
    if (IN(6)) { WSP; pg8::Gemm g{CBFP(WS_ATT), CBFP(WS_WAO), M, D, AW}; pg8::StaticOrder S; S.init(M, D, F.G, cidx);
        pg8::EpiGate<1> E{(pg8::bf16_t*)(ws + WS_GC), (const pg8::bf16_t*)(ws + WS_GA)}; pg8::gemm_phase<pg8::EpiGate<1>, pg8::StaticOrder, true, true>(F.lds + RING_OFF, g, S, E); } SEAM(6);
    if (IN(7)) { WSP; pg8::Gemm g{CBFP(WS_GC), CBFP(WS_WMO), M, D, D}; pg8::StaticOrder S; S.init(M, D, F.G, cidx);
        pg8::EpiRes E{kargs()->out, kargs()->out, BFP(WS_HB), SSP(CTL_SS3), 1.0f}; pg8::gemm_phase<pg8::EpiRes, pg8::StaticOrder, true, true>(F.lds + RING_OFF, g, S, E); } SEAM(7);
    if (IN(8)) { convert_p(F, kargs());
        WSP; pg8::Gemm g{CBFP(WS_HB), CBFP(WS_W2IN), M, 2 * DFF, D}; pg8::StaticOrder S; S.init(M, 2 * DFF, F.G, cidx);
        pg8::EpiSwiglu E{BFP(WS_ACT), SSP(CTL_SS3)}; pg8::gemm_phase<pg8::EpiSwiglu, pg8::StaticOrder, true, true>(F.lds + RING_OFF, g, S, E); } SEAM(8);
    if (IN(9)) { WSP; pg8::Gemm g{CBFP(WS_ACT), CBFP(WS_W2OUT), M, D, DFF}; pg8::StaticOrder S; S.init(M, D, F.G, cidx);
        pg8::EpiRes E{kargs()->out, kargs()->out, BFP(WS_HB), SSP(CTL_SS4), 0.5f}; pg8::gemm_phase<pg8::EpiRes, pg8::StaticOrder, true, true>(F.lds + RING_OFF, g, S, E); }
    if (IN(9)) {
        { WSP; pg8::Gemm g{CBFP(WS_PB), CBFP(WS_WPP), M, D, PLE}; pg8::StaticOrder S; S.init(M, D, F.G, cidx);
          pg8::EpiGate<2> E{(pg8::bf16_t*)(ws + WS_PROJ), nullptr}; pg8::gemm_phase<pg8::EpiGate<2>, pg8::StaticOrder, true, true>(F.lds + RING_OFF, g, S, E); }
    } SEAM(9);
    if (IN(10)) {
        { WSP; pg8::Gemm g{CBFP(WS_HB), CBFP(WS_WPG), M, D, D}; pg8::StaticOrder S; S.init(M, D, F.G, cidx);
          pg8::EpiPle E{kargs()->out, CBFP(WS_PROJ), SSP(CTL_SS4)}; pg8::gemm_phase<pg8::EpiPle, pg8::StaticOrder, true, true>(F.lds + RING_OFF, g, S, E); }
    }
#undef IN
#undef SEAM
}

extern "C" void kernel_launch(void* const* d_in, const int* in_sizes, int n_in, void* d_out, int out_size, void* d_ws, size_t ws_size, hipStream_t stream) {
    static int grid = 0;
    if (grid == 0) {
        if (n_in != 23 || out_size != M * D || ws_size < WS_END) { fprintf(stderr, "kernel_launch: unexpected shapes n_in %d out %d ws %zu\n", n_in, out_size, ws_size); grid = -1; return; }
        int dev = 0, cus = 0;
        if (hipGetDevice(&dev) != hipSuccess || hipDeviceGetAttribute(&cus, hipDeviceAttributeMultiprocessorCount, dev) != hipSuccess) { grid = -1; return; }
        if (hipFuncSetAttribute((const void*)mega_fwd, hipFuncAttributeMaxDynamicSharedMemorySize, LDS_BYTES) != hipSuccess) { fprintf(stderr, "kernel_launch: hipFuncSetAttribute failed\n"); grid = -1; return; }
        int per_cu = 0;
        if (hipOccupancyMaxActiveBlocksPerMultiprocessor(&per_cu, (const void*)mega_fwd, NWAVES * 64, LDS_BYTES) != hipSuccess || per_cu < 1) fprintf(stderr, "kernel_launch: occupancy query says %d\n", per_cu);
        (void)hipGetLastError();
        grid = cus;
        if (grid != 256) fprintf(stderr, "kernel_launch: %d CUs (built for 256)\n", grid);
    }
    if (grid < 0) return;
    (void)hipMemsetAsync((char*)d_ws + WS_CTL, 0, CTL_ZERO_BYTES, stream);
    Args a{};
    for (int i = 0; i < 23; ++i) a.in[i] = (const float*)d_in[i];
    a.out = (float*)d_out; a.ws = (unsigned char*)d_ws;
    if (N_LAUNCHES == 1) {
        a.ph_lo = 0; a.ph_hi = NPHASE; a.li = 0;
        hipLaunchKernelGGL(mega_fwd, dim3(grid), dim3(NWAVES * 64), LDS_BYTES, stream, a);
    } else {
        for (int li = 0; li < NPHASE; ++li) { a.ph_lo = li; a.ph_hi = li + 1; a.li = li;
            hipLaunchKernelGGL(mega_fwd, dim3(grid), dim3(NWAVES * 64), LDS_BYTES, stream, a); }
    }
}
```

```cpp
#include <hip/hip_runtime.h>
#include <cstdio>
#include <cstdint>
__device__ __forceinline__ void mk_syncthreads() { __builtin_amdgcn_fence(__ATOMIC_RELEASE, "workgroup"); __builtin_amdgcn_s_barrier(); __builtin_amdgcn_fence(__ATOMIC_ACQUIRE, "workgroup"); }
#define __syncthreads() mk_syncthreads()
__device__ __forceinline__ int lane_now() { int l = (int)__builtin_amdgcn_mbcnt_hi(~0u, __builtin_amdgcn_mbcnt_lo(~0u, 0u)); asm volatile("" : "+v"(l)); return l; }
namespace pg8 {
#define PG8_LAS __attribute__((address_space(3)))
typedef unsigned short bf16_t;
typedef short bf16x8 __attribute__((ext_vector_type(8)));
typedef float f32x4 __attribute__((ext_vector_type(4)));
typedef unsigned u32x4 __attribute__((ext_vector_type(4)));
constexpr int BM = 256, BK = 64, HALF = 128, HTB = HALF * BK * 2  , STAGE_BYTES = 8 * HTB, NXCD = 8, WGM = 8;

__host__ __device__ __forceinline__ int lds_byte(int r, int c) { const int st = (r >> 4) * 2 + (c >> 5), rr = r & 15, cc = c & 31, ob = rr * 64 + cc * 2; return st * 1024 + (ob ^ (((ob >> 9) & 1) << 5)); }
__host__ __device__ __forceinline__ void stage_rc(int b, int& R, int& C) { const int st = b / 1024, sb = b % 1024, swz = sb ^ (((sb >> 9) & 1) << 5); R = (st >> 1) * 16 + swz / 64; C = (st & 1) * 32 + (swz % 64) / 2; }
__host__ __device__ __forceinline__ int perm32(int rho) { const int n = rho >> 4, i = rho & 15; return 8 * (i >> 2) + 4 * n + (i & 3); }

struct Unit { int pm, pn; };
struct Gemm { const bf16_t* A; const bf16_t* Bt; int M, N, K; };

struct StaticOrder {
    int nM, nN, nwg, G, c;
    __host__ __device__ __forceinline__ void init(int M, int N, int G_, int c_) { nM = M / BM; nN = N / BM; nwg = nM * nN; G = G_; c = c_; }
    __host__ __device__ bool next(int i, Unit& u) const {
        const long L = (long)i * G + c; if (L >= nwg) return false;
        int wgid = (int)L; { const int q = nwg / NXCD, r = nwg % NXCD, xcd = wgid % NXCD, off = wgid / NXCD; wgid = (xcd < r ? xcd * (q + 1) : r * (q + 1) + (xcd - r) * q) + off; }
        const int nig = WGM * nN, gid = wgid / nig, fm = gid * WGM, gsz = (nM - fm) < WGM ? (nM - fm) : WGM;
        u.pm = fm + ((wgid % nig) % gsz); u.pn = (wgid % nig) / gsz; return true;
    }
    __device__ __forceinline__ void a_ready(const Unit&) const {}
    __device__ __forceinline__ void done(const Unit&) const {}
};

typedef float cvt_f32x2 __attribute__((ext_vector_type(2)));
typedef __bf16 cvt_bf16x2 __attribute__((ext_vector_type(2)));
__device__ __forceinline__ unsigned cvt_pk_bf16(float lo, float hi) { const cvt_bf16x2 v = __builtin_convertvector((cvt_f32x2){lo, hi}, cvt_bf16x2); return __builtin_bit_cast(unsigned, v); }
typedef float f32x2 __attribute__((ext_vector_type(2)));
typedef _Float16 f16x2 __attribute__((ext_vector_type(2)));
constexpr float NORM_EPS = 1e-6f;
constexpr float Q_C2 = 0.125f * 1.4426950408889634f;
__device__ __forceinline__ float bf_lo(unsigned w) { return __uint_as_float(w << 16); }
__device__ __forceinline__ float bf_hi(unsigned w) { return __uint_as_float(w & 0xffff0000u); }
__device__ __forceinline__ float sigm(float x) { return __builtin_amdgcn_rcpf(1.f + __builtin_amdgcn_exp2f(-1.4426950408889634f * x)); }
__device__ __forceinline__ u32x4 pack8(f32x4 a, f32x4 b) { u32x4 w; w.x = cvt_pk_bf16(a[0], a[1]); w.y = cvt_pk_bf16(a[2], a[3]); w.z = cvt_pk_bf16(b[0], b[1]); w.w = cvt_pk_bf16(b[2], b[3]); return w; }
__device__ __forceinline__ unsigned pkh(float lo, float hi) { f16x2 v = __builtin_convertvector((f32x2){lo, hi}, f16x2); return __builtin_bit_cast(unsigned, v); }
__device__ __forceinline__ u32x4 pack8h(f32x4 a, f32x4 b) { u32x4 w; w.x = pkh(a[0], a[1]); w.y = pkh(a[2], a[3]); w.z = pkh(b[0], b[1]); w.w = pkh(b[2], b[3]); return w; }
__device__ __forceinline__ float row_rs(const float* ss, int row) { return __builtin_amdgcn_rsqf((float)((const unsigned long long*)ss)[row] * (1.0f / (1024.0f * 1048576.0f)) + NORM_EPS); }
__device__ __forceinline__ f32x4 unpk_lo(u32x4 g) { return (f32x4){bf_lo(g.x), bf_hi(g.x), bf_lo(g.y), bf_hi(g.y)}; }
__device__ __forceinline__ f32x4 unpk_hi(u32x4 g) { return (f32x4){bf_lo(g.z), bf_hi(g.z), bf_lo(g.w), bf_hi(g.w)}; }

struct EpiSwiglu {
    static constexpr bool PERM = true, AFTER_DRAIN = false;
    bf16_t* O; const float* ss;
    __device__ __forceinline__ void operator()(const f32x4 (&acc)[2][2][4][2], const Unit& u, int wr, int wc, int fr, int fq) const {
        const int row0 = u.pm * BM + wr * 64 + fr, col0 = u.pn * HALF + wc * 32 + 8 * fq;
#pragma unroll
        for (int ai = 0; ai < 2; ++ai)
#pragma unroll
            for (int m = 0; m < 4; ++m) { const int row = row0 + ai * HALF + m * 16; const float rs = row_rs(ss, row); f32x4 o[2];
#pragma unroll
                for (int n = 0; n < 2; ++n) { const f32x4 a = acc[ai][0][m][n] * rs, b = acc[ai][1][m][n] * rs;
#pragma unroll
                    for (int e = 0; e < 4; ++e) o[n][e] = a[e] * sigm(a[e]) * b[e]; }
                *(u32x4*)(O + (size_t)row * 2816 + col0) = pack8(o[0], o[1]); }
    }
};
struct EpiRes {
    static constexpr bool PERM = true, AFTER_DRAIN = false;
    const float* base; float* out; bf16_t* hb; float* ssq; float alpha;
    __device__ __forceinline__ void operator()(const f32x4 (&acc)[2][2][4][2], const Unit& u, int wr, int wc, int fr, int fq) const {
        const int row0 = u.pm * BM + wr * 64 + fr, col0 = u.pn * BM + wc * 32 + 8 * fq;
#pragma unroll
        for (int ai = 0; ai < 2; ++ai)
#pragma unroll
            for (int m = 0; m < 4; ++m) { const int row = row0 + ai * HALF + m * 16; float q = 0.f;
#pragma unroll
                for (int bj = 0; bj < 2; ++bj) { const size_t off = (size_t)row * 1024 + col0 + bj * HALF;
                    const f32x4 x0 = *(const f32x4*)(base + off), x1 = *(const f32x4*)(base + off + 4);
                    const f32x4 h0 = x0 + acc[ai][bj][m][0] * alpha, h1 = x1 + acc[ai][bj][m][1] * alpha;
                    *(f32x4*)(out + off) = h0; *(f32x4*)(out + off + 4) = h1; *(u32x4*)(hb + off) = pack8(h0, h1);
                    q += (h0[0] * h0[0] + h0[1] * h0[1]) + (h0[2] * h0[2] + h0[3] * h0[3]) + (h1[0] * h1[0] + h1[1] * h1[1]) + (h1[2] * h1[2] + h1[3] * h1[3]); }
                q += __shfl_xor(q, 16); q += __shfl_xor(q, 32);
                if (fq == 0) atomicAdd((unsigned long long*)ssq + row, (unsigned long long)(q * 1048576.0f)); }
    }
};
struct EpiMix {
    static constexpr bool PERM = true, AFTER_DRAIN = false;
    const float* ss; bf16_t *GLU, *Q, *K, *V, *QI, *KI; float* WI; bf16_t *GC, *GA; const float *qn, *kn;
    static constexpr unsigned GUARD_LDS = 131072 + 320 + 44;
    static constexpr long GUARD_DELTA = (4096 + 6080) * 4 - 196608;
    __device__ __forceinline__ void operator()(const f32x4 (&acc)[2][2][4][2], const Unit& u, int wr, int wc, int fr, int fq) const {
        { volatile PG8_LAS unsigned* lflag = (volatile PG8_LAS unsigned*)GUARD_LDS;
          if (*lflag == 0u) {
              if (wr == 0 && wc == 0 && fr == 0 && fq == 0) { unsigned* gd = (unsigned*)((char*)ss + GUARD_DELTA); const unsigned need = lflag[-2]; unsigned sp = 0u;
                  while (__hip_atomic_load(gd, __ATOMIC_RELAXED, __HIP_MEMORY_SCOPE_AGENT) < need && ++sp < (1u << 22)) __builtin_amdgcn_s_sleep(1);
                  *lflag = 1u; }
              while (*lflag == 0u) __builtin_amdgcn_s_sleep(1); } }
        const int row0 = u.pm * BM + wr * 64 + fr, cw = wc * 32 + 8 * fq, pn = u.pn;
        if (pn < 4) {
#pragma unroll
            for (int ai = 0; ai < 2; ++ai)
#pragma unroll
                for (int m = 0; m < 4; ++m) { const int row = row0 + ai * HALF + m * 16; const float rs = row_rs(ss, row); f32x4 o[2];
#pragma unroll
                    for (int n = 0; n < 2; ++n) { const f32x4 a = acc[ai][0][m][n] * rs, g = acc[ai][1][m][n] * rs;
#pragma unroll
                        for (int e = 0; e < 4; ++e) o[n][e] = a[e] * sigm(g[e]); }
                    *(u32x4*)(GLU + (size_t)row * 512 + pn * HALF + cw) = pack8(o[0], o[1]); }
        } else if (pn < 8) {
            const bool isq = pn < 6; const int head = 4 * ((pn - 4) & 1) + wc; const float* gn = isq ? qn : kn; bf16_t* dst = isq ? Q : K; const float post = isq ? Q_C2 : 1.0f;
            f32x4 g[2][2];
#pragma unroll
            for (int bj = 0; bj < 2; ++bj)
#pragma unroll
                for (int n = 0; n < 2; ++n) g[bj][n] = *(const f32x4*)(gn + 32 * bj + 8 * fq + 4 * n);
#pragma unroll
            for (int ai = 0; ai < 2; ++ai)
#pragma unroll
                for (int m = 0; m < 4; ++m) { const int row = row0 + ai * HALF + m * 16; const float rs = row_rs(ss, row); f32x4 v[2][2]; float s = 0.f;
#pragma unroll
                    for (int bj = 0; bj < 2; ++bj)
#pragma unroll
                        for (int n = 0; n < 2; ++n) { v[bj][n] = acc[ai][bj][m][n] * rs; const f32x4 t = v[bj][n]; s += (t[0] * t[0] + t[1] * t[1]) + (t[2] * t[2] + t[3] * t[3]); }
                    s += __shfl_xor(s, 16); s += __shfl_xor(s, 32);
                    const float rn = __builtin_amdgcn_rsqf(s * (1.0f / 64.0f) + NORM_EPS) * post;
#pragma unroll
                    for (int bj = 0; bj < 2; ++bj) *(u32x4*)(dst + (size_t)row * 512 + 64 * head + 32 * bj + 8 * fq) = pack8(v[bj][0] * rn * g[bj][0], v[bj][1] * rn * g[bj][1]); }
        } else if (pn < 10) {
#pragma unroll
            for (int ai = 0; ai < 2; ++ai)
#pragma unroll
                for (int m = 0; m < 4; ++m) { const int row = row0 + ai * HALF + m * 16; const float rs = row_rs(ss, row);
#pragma unroll
                    for (int bj = 0; bj < 2; ++bj) *(u32x4*)(V + (size_t)row * 512 + (pn - 8) * BM + bj * HALF + cw) = pack8(acc[ai][bj][m][0] * rs, acc[ai][bj][m][1] * rs); }
        } else if (pn == 10) {
#pragma unroll
            for (int ai = 0; ai < 2; ++ai)
#pragma unroll
                for (int m = 0; m < 4; ++m) { const int row = row0 + ai * HALF + m * 16; const float rs = row_rs(ss, row);
#pragma unroll
                    for (int bj = 0; bj < 2; ++bj) *(u32x4*)(QI + (size_t)row * 256 + bj * HALF + cw) = pack8h(acc[ai][bj][m][0] * rs, acc[ai][bj][m][1] * rs); }
        } else if (pn == 11) {
#pragma unroll
            for (int ai = 0; ai < 2; ++ai)
#pragma unroll
                for (int m = 0; m < 4; ++m) { const int row = row0 + ai * HALF + m * 16; const float rs = row_rs(ss, row);
                    if (wc < 2) *(u32x4*)(KI + (size_t)row * 64 + cw) = pack8h(acc[ai][0][m][0] * rs, acc[ai][0][m][1] * rs);
                    else if (wc == 2 && fq == 0) *(f32x4*)(WI + (size_t)row * 4) = acc[ai][0][m][0] * (rs * 0.0625f); }
        } else {
            bf16_t* dst = pn < 16 ? GC : GA; const int ct = (pn < 16 ? pn - 12 : pn - 16) * BM;
#pragma unroll
            for (int ai = 0; ai < 2; ++ai)
#pragma unroll
                for (int m = 0; m < 4; ++m) { const int row = row0 + ai * HALF + m * 16; const float rs = row_rs(ss, row);
#pragma unroll
                    for (int bj = 0; bj < 2; ++bj) { f32x4 o[2];
#pragma unroll
                        for (int n = 0; n < 2; ++n)
#pragma unroll
                            for (int e = 0; e < 4; ++e) o[n][e] = sigm(acc[ai][bj][m][n][e] * rs);
                        *(u32x4*)(dst + (size_t)row * 1024 + ct + bj * HALF + cw) = pack8(o[0], o[1]); } }
        }
    }
};
template <int MODE> struct EpiGate {
    static constexpr bool PERM = true, AFTER_DRAIN = false;
    bf16_t* T; const bf16_t* GA;
    __device__ __forceinline__ void operator()(const f32x4 (&acc)[2][2][4][2], const Unit& u, int wr, int wc, int fr, int fq) const {
        const int row0 = u.pm * BM + wr * 64 + fr, col0 = u.pn * BM + wc * 32 + 8 * fq;
#pragma unroll
        for (int ai = 0; ai < 2; ++ai)
#pragma unroll
            for (int m = 0; m < 4; ++m) { const int row = row0 + ai * HALF + m * 16;
#pragma unroll
                for (int bj = 0; bj < 2; ++bj) { const size_t off = (size_t)row * 1024 + col0 + bj * HALF; f32x4 o0, o1;
                    if (MODE == 0) { const u32x4 g = *(const u32x4*)(T + off); o0 = unpk_lo(g) * acc[ai][bj][m][0]; o1 = unpk_hi(g) * acc[ai][bj][m][1]; }
                    else if (MODE == 1) { const u32x4 t = *(const u32x4*)(T + off); const u32x4 g = *(const u32x4*)(GA + off); o0 = unpk_lo(t) + unpk_lo(g) * acc[ai][bj][m][0]; o1 = unpk_hi(t) + unpk_hi(g) * acc[ai][bj][m][1]; }
                    else { o0 = acc[ai][bj][m][0]; o1 = acc[ai][bj][m][1]; }
                    *(u32x4*)(T + off) = pack8(o0, o1); } }
    }
};
struct EpiPle {
    static constexpr bool PERM = true, AFTER_DRAIN = false;
    float* out; const bf16_t* P; const float* ss;
    __device__ __forceinline__ void operator()(const f32x4 (&acc)[2][2][4][2], const Unit& u, int wr, int wc, int fr, int fq) const {
        const int row0 = u.pm * BM + wr * 64 + fr, col0 = u.pn * BM + wc * 32 + 8 * fq;
#pragma unroll
        for (int ai = 0; ai < 2; ++ai)
#pragma unroll
            for (int m = 0; m < 4; ++m) { const int row = row0 + ai * HALF + m * 16; const float rs = row_rs(ss, row);
#pragma unroll
                for (int bj = 0; bj < 2; ++bj) { const size_t off = (size_t)row * 1024 + col0 + bj * HALF;
                    const u32x4 pr = *(const u32x4*)(P + off); const f32x4 p0 = unpk_lo(pr), p1 = unpk_hi(pr);
                    f32x4 h0 = *(const f32x4*)(out + off), h1 = *(const f32x4*)(out + off + 4);
#pragma unroll
                    for (int e = 0; e < 4; ++e) { h0[e] += sigm(acc[ai][bj][m][0][e] * rs) * p0[e]; h1[e] += sigm(acc[ai][bj][m][1][e] * rs) * p1[e]; }
                    *(f32x4*)(out + off) = h0; *(f32x4*)(out + off + 4) = h1; }
                asm volatile("" ::: "memory"); }
    }
};

template <class Epi, class Sched, bool ALIGN_EPI = false, bool SP2 = false>
__device__ __forceinline__ void gemm_phase(PG8_LAS unsigned char* lds, const Gemm g, const Sched& S, const Epi& E, const int wid) {
    const int lane = lane_now(), tid = wid * 64 + lane, wr = wid >> 2, wc = wid & 3, fr = lane & 15, fq = lane >> 4;
    int K = g.K; asm volatile("" : "+s"(K));
    const int nt = K / BK;
    unsigned voffA[2], voffB[2];
#pragma unroll
    for (int i = 0; i < 2; ++i) { int R, C; stage_rc(tid * 16 + i * 8192, R, C); const int Rb = Epi::PERM ? ((R & ~31) + perm32(R & 31)) : R;
        voffA[i] = (unsigned)(R * K + C) * 2u; voffB[i] = (unsigned)(Rb * K + C) * 2u; }
    const size_t kstep = (size_t)(BK * 2);
    const size_t hstep = (size_t)HALF * K * 2;
    const size_t tstep = 2 * hstep;
    const unsigned ldsw = (unsigned)wid * 1024u;
    const int aoff = lds_byte(wr * 64 + fr, fq * 8), boff = lds_byte(wc * 32 + fr, fq * 8);
#define PG8_SA(b, h) (((b) * 2 + (h)) * HTB)
#define PG8_SB(b, h) ((4 + (b) * 2 + (h)) * HTB)
#define PG8_STAGE(bufoff, gbase, voff) do { _Pragma("unroll") for (int _i = 0; _i < 2; ++_i) \
        __builtin_amdgcn_global_load_lds((const unsigned*)((const char*)(gbase) + (voff)[_i]), (PG8_LAS unsigned*)(lds + (bufoff) + ldsw + _i * 8192), 16, 0, 0); } while (0)
#define PG8_LDA(dst, b, h) do { _Pragma("unroll") for (int m = 0; m < 4; ++m) _Pragma("unroll") for (int k = 0; k < 2; ++k) dst[m][k] = *(const PG8_LAS bf16x8*)(lds + PG8_SA(b, h) + aoff + m * 2048 + k * 1024); } while (0)
#define PG8_LDB(dst, b, h) do { _Pragma("unroll") for (int n = 0; n < 2; ++n) _Pragma("unroll") for (int k = 0; k < 2; ++k) dst[n][k] = *(const PG8_LAS bf16x8*)(lds + PG8_SB(b, h) + boff + n * 2048 + k * 1024); } while (0)
#define PG8_MMA(ai, bj, At, Bt) do { __builtin_amdgcn_s_setprio(1); _Pragma("unroll") for (int m = 0; m < 4; ++m) _Pragma("unroll") for (int n = 0; n < 2; ++n) _Pragma("unroll") for (int k = 0; k < 2; ++k) \
        acc[ai][bj][m][n] = __builtin_amdgcn_mfma_f32_16x16x32_bf16(Bt[n][k], At[m][k], acc[ai][bj][m][n], 0, 0, 0); __builtin_amdgcn_s_setprio(0); } while (0)
#define PG8_WAIT_V(n) asm volatile("s_waitcnt vmcnt(" #n ")" ::: "memory")
#define PG8_WAIT_L(n) asm volatile("s_waitcnt lgkmcnt(" #n ")" ::: "memory")
#define PG8_BAR __builtin_amdgcn_s_barrier()
#define PG8_SCHED __builtin_amdgcn_sched_barrier(0)
    Unit cur, nxt; int ui = 0;
    if (!S.next(0, cur)) return;
    f32x4 acc[2][2][4][2];
#pragma unroll
    for (int a = 0; a < 2; ++a)
#pragma unroll
        for (int b = 0; b < 2; ++b)
#pragma unroll
            for (int m = 0; m < 4; ++m)
#pragma unroll
                for (int n = 0; n < 2; ++n) acc[a][b][m][n] = (f32x4){0.f, 0.f, 0.f, 0.f};
    bf16x8 At[4][2], B0[2][2], B1[2][2];
    const char* cA = (const char*)g.A + (size_t)cur.pm * tstep; const char* cB = (const char*)g.Bt + (size_t)cur.pn * tstep;
    S.a_ready(cur);
    if constexpr (SP2) {
        PG8_STAGE(PG8_SB(0, 0), cB, voffB); PG8_STAGE(PG8_SB(0, 1), cB + hstep, voffB); PG8_STAGE(PG8_SA(0, 0), cA, voffA); PG8_STAGE(PG8_SA(0, 1), cA + hstep, voffA);
        if (wr == 1) PG8_BAR;
        PG8_WAIT_V(2); PG8_BAR;
        PG8_STAGE(PG8_SB(1, 0), cB + kstep, voffB); PG8_STAGE(PG8_SA(1, 0), cA + kstep, voffA); PG8_STAGE(PG8_SB(1, 1), cB + hstep + kstep, voffB);
        PG8_WAIT_V(6); PG8_BAR;
    } else {
        PG8_STAGE(PG8_SB(0, 0), cB, voffB); PG8_STAGE(PG8_SA(0, 0), cA, voffA); PG8_STAGE(PG8_SB(0, 1), cB + hstep, voffB); PG8_STAGE(PG8_SA(0, 1), cA + hstep, voffA);
        if (wr == 1) PG8_BAR;
        PG8_WAIT_V(4); PG8_BAR;
        PG8_STAGE(PG8_SB(1, 0), cB + kstep, voffB); PG8_STAGE(PG8_SA(1, 0), cA + kstep, voffA); PG8_STAGE(PG8_SB(1, 1), cB + hstep + kstep, voffB);
        PG8_WAIT_V(6); PG8_BAR;
    }
    for (;;) {
        const bool has_next = S.next(ui + 1, nxt);
        const char* nA = has_next ? (const char*)g.A + (size_t)nxt.pm * tstep : cA; const char* nB = has_next ? (const char*)g.Bt + (size_t)nxt.pn * tstep : cB;
        for (int t = 0; t < nt; t += 2) {
            const bool last = (t == nt - 2);
            const char* a1 = cA + (size_t)(t + 1) * kstep;
            const char* a2 = last ? nA : cA + (size_t)(t + 2) * kstep; const char* b2 = last ? nB : cB + (size_t)(t + 2) * kstep;
            const char* a3 = a2 + kstep; const char* b3 = b2 + kstep;
            if (last && has_next) S.a_ready(nxt);
            if constexpr (SP2) {
            PG8_LDB(B0, 0, 0); PG8_LDB(B1, 0, 1); PG8_SCHED; PG8_LDA(At, 0, 0); PG8_STAGE(PG8_SA(1, 1), a1 + hstep, voffA);
            PG8_WAIT_V(8); PG8_WAIT_L(0); PG8_BAR; PG8_MMA(0, 0, At, B0); PG8_MMA(0, 1, At, B1); PG8_BAR; PG8_SCHED;
            PG8_LDA(At, 0, 1); PG8_STAGE(PG8_SB(0, 0), b2, voffB); PG8_STAGE(PG8_SB(0, 1), b2 + hstep, voffB); PG8_STAGE(PG8_SA(0, 0), a2, voffA);
            PG8_WAIT_V(8); PG8_WAIT_L(0); PG8_BAR; PG8_MMA(1, 0, At, B0); PG8_MMA(1, 1, At, B1); PG8_BAR; PG8_SCHED;
            PG8_LDB(B0, 1, 0); PG8_LDB(B1, 1, 1); PG8_SCHED; PG8_LDA(At, 1, 0); PG8_STAGE(PG8_SA(0, 1), a2 + hstep, voffA);
            PG8_WAIT_V(8); PG8_WAIT_L(0); PG8_BAR; PG8_MMA(0, 0, At, B0); PG8_MMA(0, 1, At, B1); PG8_BAR; PG8_SCHED;
            PG8_LDA(At, 1, 1); PG8_STAGE(PG8_SB(1, 0), b3, voffB); PG8_STAGE(PG8_SB(1, 1), b3 + hstep, voffB); PG8_STAGE(PG8_SA(1, 0), a3, voffA);
            PG8_WAIT_V(8); PG8_WAIT_L(0); PG8_BAR; PG8_MMA(1, 0, At, B0); PG8_MMA(1, 1, At, B1); PG8_BAR; PG8_SCHED;
            } else {
            PG8_LDB(B0, 0, 0); PG8_SCHED; PG8_LDA(At, 0, 0); PG8_STAGE(PG8_SA(1, 1), a1 + hstep, voffA);
            PG8_WAIT_L(8); PG8_BAR; PG8_WAIT_L(0); PG8_MMA(0, 0, At, B0); PG8_BAR; PG8_SCHED;
            PG8_LDB(B1, 0, 1); PG8_STAGE(PG8_SB(0, 0), b2, voffB);
            PG8_BAR; PG8_WAIT_L(0); PG8_MMA(0, 1, At, B1); PG8_BAR;
            PG8_LDA(At, 0, 1); PG8_STAGE(PG8_SA(0, 0), a2, voffA);
            PG8_BAR; PG8_WAIT_L(0); PG8_MMA(1, 0, At, B0); PG8_BAR; PG8_SCHED;
            PG8_STAGE(PG8_SB(0, 1), b2 + hstep, voffB);
            PG8_WAIT_V(6); PG8_BAR; PG8_MMA(1, 1, At, B1); PG8_BAR;
            PG8_LDB(B0, 1, 0); PG8_SCHED; PG8_LDA(At, 1, 0); PG8_STAGE(PG8_SA(0, 1), a2 + hstep, voffA);
            PG8_WAIT_L(8); PG8_BAR; PG8_WAIT_L(0); PG8_MMA(0, 0, At, B0); PG8_BAR; PG8_SCHED;
            PG8_LDB(B1, 1, 1); PG8_STAGE(PG8_SB(1, 0), b3, voffB);
            PG8_BAR; PG8_WAIT_L(0); PG8_MMA(0, 1, At, B1); PG8_BAR;
            PG8_LDA(At, 1, 1); PG8_STAGE(PG8_SA(1, 0), a3, voffA);
            PG8_BAR; PG8_WAIT_L(0); PG8_MMA(1, 0, At, B0); PG8_BAR; PG8_SCHED;
            PG8_STAGE(PG8_SB(1, 1), b3 + hstep, voffB);
            PG8_WAIT_V(6); PG8_BAR; PG8_MMA(1, 1, At, B1); PG8_BAR;
            }
        }
        if constexpr (ALIGN_EPI) { if (wr == 0) PG8_BAR; }
        if constexpr (!Epi::AFTER_DRAIN) { E(acc, cur, wr, wc, fr, fq); S.done(cur); }
        if (!has_next) break;
#pragma unroll
        for (int a = 0; a < 2; ++a)
#pragma unroll
            for (int b = 0; b < 2; ++b)
#pragma unroll
                for (int m = 0; m < 4; ++m)
#pragma unroll
                    for (int n = 0; n < 2; ++n) acc[a][b][m][n] = (f32x4){0.f, 0.f, 0.f, 0.f};
        cur = nxt; cA = nA; cB = nB; ++ui;
        if constexpr (ALIGN_EPI) { if (wr == 1) PG8_BAR; }
    }
    PG8_WAIT_V(0);
    if constexpr (!ALIGN_EPI) { if (wr == 0) PG8_BAR; }
    PG8_BAR;
    if constexpr (Epi::AFTER_DRAIN) { E.fused(acc, cur, wr, wc, fr, fq, lds, wid, lane); S.done(cur); }
#undef PG8_SA
#undef PG8_SB
#undef PG8_STAGE
#undef PG8_LDA
#undef PG8_LDB
#undef PG8_MMA
#undef PG8_WAIT_V
#undef PG8_WAIT_L
#undef PG8_BAR
#undef PG8_SCHED
}
}
constexpr int NWAVES = 8;
constexpr int NPHASE = 11;
#ifndef MK_N_LAUNCHES
#define MK_N_LAUNCHES 1
#endif
constexpr int N_LAUNCHES = MK_N_LAUNCHES;

constexpr int M = 16384, D = 1024, DFF = 2816, NMIXP = 5120, CCH = 512, AW = 512, NH = 8, HD = 64, PLE = 256, CONVW = 31;
constexpr float EPS = 1e-6f;
constexpr float LOG2E = 1.4426950408889634f;

constexpr size_t MiB = 1u << 20;
constexpr size_t WS_CTL = 0, CTL_ZERO_BYTES = 1 * MiB;
constexpr size_t WS_W1IN = 1 * MiB;
constexpr size_t WS_W1OUT = 12 * MiB;
constexpr size_t WS_WMIX = 18 * MiB;
constexpr size_t WS_WCO = 28 * MiB;
constexpr size_t WS_WAO = 29 * MiB;
constexpr size_t WS_WMO = 30 * MiB;
constexpr size_t WS_W2IN = 32 * MiB;
constexpr size_t WS_W2OUT = 43 * MiB;
constexpr size_t WS_WPG = 49 * MiB;
constexpr size_t WS_WPP = 51 * MiB;
constexpr size_t WS_HB = 52 * MiB;
constexpr size_t WS_MASK = WS_HB;
constexpr size_t WS_ACT = 84 * MiB;
constexpr size_t WS_GLU = WS_ACT;
constexpr size_t WS_ATT = WS_ACT;
constexpr size_t WS_Q = WS_ACT + 16 * MiB, WS_K = WS_ACT + 32 * MiB, WS_V = WS_ACT + 48 * MiB;
constexpr size_t WS_QI = WS_ACT + 64 * MiB;
constexpr size_t WS_KI = WS_ACT + 72 * MiB;
constexpr size_t WS_WI = WS_ACT + 74 * MiB;
constexpr size_t WS_GC = 172 * MiB;
constexpr size_t WS_GA = 204 * MiB;
constexpr size_t WS_PB = 236 * MiB;
constexpr size_t WS_PROJ = WS_GA;
constexpr size_t WS_ZC = 236 * MiB;
constexpr size_t WS_END = 252 * MiB;
constexpr int CW_TMO = 0, CW_CODE = 1;
constexpr int CW_BAR = 4096;
constexpr size_t CTL_SS1 = 64 * 1024, CTL_SS2 = 192 * 1024, CTL_SS3 = 320 * 1024, CTL_SS4 = 448 * 1024;

constexpr int RING_OFF = 0, RING_BYTES = 131072;
constexpr int LDSCTL_OFF = RING_BYTES, MISC_OFF = LDSCTL_OFF + 320;
constexpr int LDS_BYTES = 147456;

#define GAS __attribute__((address_space(1)))
#define LAS __attribute__((address_space(3)))
typedef unsigned short bf16;
typedef unsigned v4u __attribute__((ext_vector_type(4)));
typedef float f32x4 __attribute__((ext_vector_type(4)));
typedef short bf16x8 __attribute__((ext_vector_type(8)));
typedef GAS unsigned gu32;
typedef GAS unsigned long long gu64;
#define RLX_AGENT __ATOMIC_RELAXED, __HIP_MEMORY_SCOPE_AGENT
#define LDS_WAIT() asm volatile("s_waitcnt lgkmcnt(0)" ::: "memory")
#define VM_WAIT() asm volatile("s_waitcnt vmcnt(0)" ::: "memory")
__device__ __forceinline__ unsigned long long rt() { return __builtin_amdgcn_s_memrealtime(); }
__device__ __forceinline__ unsigned f2bf(float f) { unsigned u = __builtin_bit_cast(unsigned, f); return (u + 0x7fffu + ((u >> 16) & 1u)) >> 16; }
__device__ __forceinline__ unsigned pk2(float lo, float hi) { return f2bf(lo) | (f2bf(hi) << 16); }

#define XB_TMO      128
#define XB_XCNT(j)  (256  + 64 * (j))
#define XB_XSUB(j)  (1280 + 64 * (j))
#define XB_XGEN(j)  (2304 + 64 * (j))
#define XB_TOP      3328
#define XB_TOPGEN   3392
#define XCD_BAR_WORDS 3456
#define XB_LSUB(j)  (3520 + 64 * (j))
#define XB_LGEN(j)  (4544 + 64 * (j))
#define XB_TAB      5632
#define XB_DONE2    6080
#define XB_DONE6    6016
#define XB_NONLOCAL 5952
#define XB_SPIN_CAP (1u << 18)

__device__ __forceinline__ unsigned xb_ld(unsigned* p)              { return __hip_atomic_load(p, __ATOMIC_RELAXED, __HIP_MEMORY_SCOPE_AGENT); }
__device__ __forceinline__ unsigned xb_add(unsigned* p, unsigned v) { return __hip_atomic_fetch_add(p, v, __ATOMIC_RELAXED, __HIP_MEMORY_SCOPE_AGENT); }
__device__ __forceinline__ unsigned xb_xcc_id() { return (unsigned)__builtin_amdgcn_s_getreg((3 << 11) | 20) & 0xFu; }
#define XB_SPIN(cond, bar) do { unsigned _sp = 0; while (cond) { __builtin_amdgcn_s_sleep(1); \
    if ((++_sp & 255u) == 0u) { if (xb_ld(&(bar)[XB_TMO])) break; if (_sp > XB_SPIN_CAP) { atomicAdd(&(bar)[XB_TMO], 1u); break; } } } } while (0)

struct XcdBarrier {
    unsigned* bar; unsigned x;
    volatile LAS unsigned* st;
};

__device__ __forceinline__ XcdBarrier xcd_barrier_post(unsigned* bar, volatile LAS unsigned* st, const int tid) {
    XcdBarrier b; b.bar = bar; b.x = xb_xcc_id(); b.st = st;
    if (tid == 0) (void)xb_add(&bar[XB_XCNT(b.x)], 1u);
    return b;
}
__device__ __forceinline__ void xcd_barrier_complete(unsigned* bar, unsigned x, unsigned& nloc, unsigned& nx) {
    const unsigned G = gridDim.x * gridDim.y * gridDim.z;
    unsigned sum, cnt, mine, sp = 0u;
    for (;;) {
        sum = 0u; cnt = 0u; mine = 0u;
#pragma unroll
        for (unsigned j = 0; j < 16; ++j) { const unsigned c = xb_ld(&bar[XB_XCNT(j)]); sum += c; cnt += (c > 0u) ? 1u : 0u; mine = (j == x) ? c : mine; }
        if (sum == G) break;
        __builtin_amdgcn_s_sleep(1);
        if ((++sp & 255u) == 0u) { if (xb_ld(&bar[XB_TMO])) break; if (sp > XB_SPIN_CAP) { atomicAdd(&bar[XB_TMO], 1u); break; } }
    }
    nloc = mine > 0u ? mine : 1u; nx = cnt > 0u ? cnt : 1u;
}

template <bool FLUSH = true>
__device__ __forceinline__ void xcd_barrier(const XcdBarrier& b, const int tid) {
    asm volatile("s_waitcnt vmcnt(0)" ::: "memory");
    __syncthreads();
    if (tid == 0) {
        unsigned* bar = b.bar;
        __builtin_amdgcn_s_waitcnt(0);
        unsigned nloc = b.st[0], nx = b.st[1];
        if (nloc == 0u) { xcd_barrier_complete(bar, b.x, nloc, nx); b.st[0] = nloc; b.st[1] = nx; }
        const unsigned old = xb_add(&bar[XB_XSUB(b.x)], 1u);
        const unsigned gen = old / nloc;
        if (old + 1u == (gen + 1u) * nloc) {
            if (FLUSH) __builtin_amdgcn_fence(__ATOMIC_RELEASE, "agent");
            asm volatile("s_waitcnt vmcnt(0)" ::: "memory");
            const unsigned og = xb_add(&bar[XB_TOP], 1u);
            const unsigned tg = og / nx;
            __builtin_amdgcn_fence(__ATOMIC_ACQUIRE, "agent");
            if (og + 1u == (tg + 1u) * nx) xb_add(&bar[XB_TOPGEN], 1u);
            else XB_SPIN(xb_ld(&bar[XB_TOPGEN]) == tg, bar);
            xb_add(&bar[XB_XGEN(b.x)], 1u);
            asm volatile("s_waitcnt vmcnt(0)" ::: "memory");
        } else {
            __builtin_amdgcn_fence(__ATOMIC_ACQUIRE, "agent");
            XB_SPIN(xb_ld(&bar[XB_XGEN(b.x)]) == gen, bar);
            asm volatile("s_waitcnt vmcnt(0)" ::: "memory");
        }
    }
    __syncthreads();
}

template <int POST = -1>
__device__ __forceinline__ void xcd_local_barrier(const XcdBarrier& b, const int tid) {
    asm volatile("s_waitcnt vmcnt(0)" ::: "memory");
    __syncthreads();
    if (tid == 0) {
        unsigned* bar = b.bar;
        __builtin_amdgcn_s_waitcnt(0);
        const unsigned nloc = b.st[0];
        const unsigned old = xb_add(&bar[XB_LSUB(b.x)], 1u);
        const unsigned gen = old / nloc;
        __builtin_amdgcn_fence(__ATOMIC_ACQUIRE, "agent");
        if (old + 1u == (gen + 1u) * nloc) { xb_add(&bar[XB_LGEN(b.x)], 1u); if (POST >= 0) xb_add(&bar[POST], 1u); }
        else XB_SPIN(xb_ld(&bar[XB_LGEN(b.x)]) == gen, bar);
        asm volatile("s_waitcnt vmcnt(0)" ::: "memory");
    }
    __syncthreads();
}

struct Frame {
    LAS unsigned char* lds;
    volatile LAS unsigned* MISC;
    gu32* ctl;
    int tid, lane, wave;
    int vcu, G;
};
__device__ __forceinline__ float wave_sum(float v) {
#pragma unroll
    for (int o = 1; o < 64; o <<= 1) v += __shfl_xor(v, o);
    return v;
}
__device__ __forceinline__ float wave_max(float v) {
#pragma unroll
    for (int o = 1; o < 64; o <<= 1) v = fmaxf(v, __shfl_xor(v, o));
    return v;
}
__device__ __forceinline__ float bflo(unsigned w) { return __uint_as_float(w << 16); }
__device__ __forceinline__ float bfhi(unsigned w) { return __uint_as_float(w & 0xffff0000u); }
__device__ __forceinline__ float sigm_f(float x) { return __builtin_amdgcn_rcpf(1.f + __builtin_amdgcn_exp2f(-LOG2E * x)); }

__device__ __forceinline__ int wmap(int kind, int n0, int& nv) {
    nv = 32;
    if (kind == 0) return n0;
    const int T = n0 >> 8, rem = n0 & 255;
    if (kind == 1) return (rem >> 7) * DFF + 128 * T + (rem & 127);
    if (T < 4) return (rem >> 7) * 512 + 128 * T + (rem & 127);
    if (T < 8) { const int base = T < 6 ? 1024 : 1536, Tq = (T - 4) & 1, bj = rem >> 7, wc = (rem & 127) >> 5; return base + 64 * (4 * Tq + wc) + 32 * bj; }
    if (T < 10) return 2048 + 256 * (T - 8) + rem;
    if (T == 10) return 2560 + rem;
    if (T == 11) { if (rem < 64) return 2816 + rem; if (rem == 64) { nv = 4; return 2880; } nv = 0; return 0; }
    return 2884 + 256 * (T - 12) + rem;
}
__device__ __forceinline__ void p0_transpose_item(const float* W, int K, int Nsrc, bf16* WT, int ng, int kind, const float* gain, LAS float* scr, int item, int lane) {
    const int kb = item / ng, nb = item % ng, k0 = 64 * kb, n0 = 32 * nb;
    int nv; const int sc = wmap(kind, n0, nv);
    const int n4 = 4 * (lane & 7), kr = lane >> 3;
    const bool ok = n4 < nv;
#pragma unroll
    for (int i = 0; i < 8; ++i) { const int kk = 8 * i + kr;
        f32x4 v = ok ? *(const GAS f32x4*)(W + (size_t)(k0 + kk) * Nsrc + sc + n4) : (f32x4){0.f, 0.f, 0.f, 0.f};
        if (gain) v = v * gain[k0 + kk];
        *(LAS f32x4*)(scr + kk * 36 + n4) = v; }
    LDS_WAIT(); asm volatile("" ::: "memory");
    const int c = lane & 7;
#pragma unroll
    for (int j = 0; j < 4; ++j) { const int n = (lane >> 3) + 8 * j; const LAS float* s = scr + (8 * c) * 36 + n;
        v4u o; o.x = pk2(s[0 * 36], s[1 * 36]); o.y = pk2(s[2 * 36], s[3 * 36]); o.z = pk2(s[4 * 36], s[5 * 36]); o.w = pk2(s[6 * 36], s[7 * 36]);
        *(GAS v4u*)(WT + (size_t)(n0 + n) * K + k0 + 8 * c) = o; }
    LDS_WAIT(); asm volatile("" ::: "memory");
}
struct Args { const float* in[23]; float* out; unsigned char* ws; int ph_lo, ph_hi, li, pad; };
typedef const __attribute__((address_space(4))) Args* KArgs;
__device__ __forceinline__ KArgs kargs() { KArgs p = (KArgs)__builtin_amdgcn_kernarg_segment_ptr(); asm volatile("" : "+s"(p)); return p; }

constexpr int P0_I0 = 16 * 176, P0_LATE_END = P0_I0 + 44 * 32 + 16 * 160 + 8 * 32 + 8 * 32 + 16 * 32;
__device__ __forceinline__ void p0_weights(Frame& F, KArgs A, const int it_lo, const int it_hi, const int gw, const int NGW) {
    LAS float* scr = (LAS float*)(F.lds + RING_OFF + F.wave * 16384);
    unsigned char* ws = A->ws;
    constexpr int I0 = 16 * 176, I1 = 44 * 32, I2 = 16 * 160, I3 = 8 * 32, I4 = 8 * 32, I5 = 16 * 32, I6 = 16 * 176, I7 = 44 * 32, I8 = 16 * 32, I9 = 4 * 32;
    constexpr int NITEMS = I0 + I1 + I2 + I3 + I4 + I5 + I6 + I7 + I8 + I9;
    static_assert(I0 == P0_I0, "");
    const int hi_ = it_hi < 0 ? NITEMS : it_hi;
    for (int it = it_lo + gw; it < hi_; it += NGW) {
        int r = it;
        if (r < I0) { p0_transpose_item(A->in[3], 1024, 5632, (bf16*)(ws + WS_W1IN), 176, 1, A->in[2], scr, r, F.lane); continue; } r -= I0;
        if (r < I1) { p0_transpose_item(A->in[4], 2816, 1024, (bf16*)(ws + WS_W1OUT), 32, 0, nullptr, scr, r, F.lane); continue; } r -= I1;
        if (r < I2) { p0_transpose_item(A->in[6], 1024, 4932, (bf16*)(ws + WS_WMIX), 160, 2, A->in[5], scr, r, F.lane); continue; } r -= I2;
        if (r < I3) { p0_transpose_item(A->in[11], 512, 1024, (bf16*)(ws + WS_WCO), 32, 0, nullptr, scr, r, F.lane); continue; } r -= I3;
        if (r < I4) { p0_transpose_item(A->in[14], 512, 1024, (bf16*)(ws + WS_WAO), 32, 0, nullptr, scr, r, F.lane); continue; } r -= I4;
        if (r < I5) { p0_transpose_item(A->in[15], 1024, 1024, (bf16*)(ws + WS_WMO), 32, 0, nullptr, scr, r, F.lane); continue; } r -= I5;
        if (r < I6) { p0_transpose_item(A->in[17], 1024, 5632, (bf16*)(ws + WS_W2IN), 176, 1, A->in[16], scr, r, F.lane); continue; } r -= I6;
        if (r < I7) { p0_transpose_item(A->in[18], 2816, 1024, (bf16*)(ws + WS_W2OUT), 32, 0, nullptr, scr, r, F.lane); continue; } r -= I7;
        if (r < I8) { p0_transpose_item(A->in[20], 1024, 1024, (bf16*)(ws + WS_WPG), 32, 0, A->in[19], scr, r, F.lane); continue; } r -= I8;
        p0_transpose_item(A->in[21], 256, 1024, (bf16*)(ws + WS_WPP), 32, 0, nullptr, scr, r, F.lane);
    }
}
__device__ __forceinline__ void p0_prologue(Frame& F, KArgs A) {
    const int gw = F.vcu * NWAVES + F.wave, NGW = F.G * NWAVES;
    unsigned char* ws = A->ws;
    p0_weights(F, A, 0, P0_I0, gw, NGW);
    p0_weights(F, A, P0_LATE_END, -1, gw, NGW);
    const float* x = A->in[0]; bf16* xb = (bf16*)(ws + WS_HB); float* ss1 = (float*)(ws + WS_CTL + CTL_SS1);
    for (int m = gw; m < M; m += NGW) {
        const GAS f32x4* xr = (const GAS f32x4*)(x + (size_t)m * D) + F.lane;
        f32x4 v[4]; float s = 0.f;
#pragma unroll
        for (int j = 0; j < 4; ++j) { v[j] = xr[64 * j]; s += (v[j].x * v[j].x + v[j].y * v[j].y) + (v[j].z * v[j].z + v[j].w * v[j].w); }
        s = wave_sum(s);
        if (F.lane == 0) ((unsigned long long*)ss1)[m] = (unsigned long long)(s * 1048576.0f);
        GAS unsigned long long* o8 = (GAS unsigned long long*)(xb + (size_t)m * D) + F.lane;
#pragma unroll
        for (int j = 0; j < 4; ++j) o8[64 * j] = (unsigned long long)pk2(v[j].x, v[j].y) | ((unsigned long long)pk2(v[j].z, v[j].w) << 32);
    }
}
__device__ __forceinline__ void convert_p(Frame& F, KArgs A) {
    const float* p = A->in[1]; bf16* pb = (bf16*)(A->ws + WS_PB);
    const int g = F.vcu >> 5, gtl = (F.vcu & 31) * (NWAVES * 64) + F.tid;
    for (int k = 0; k < 4; ++k) { const int i = 65536 * g + gtl + 16384 * k;
        const f32x4 a = *(const GAS f32x4*)(p + (size_t)i * 8), b = *(const GAS f32x4*)(p + (size_t)i * 8 + 4);
        v4u o; o.x = pk2(a.x, a.y); o.y = pk2(a.z, a.w); o.z = pk2(b.x, b.y); o.w = pk2(b.z, b.w);
        *(GAS v4u*)(pb + (size_t)i * 8) = o;
    }
}

__device__ __forceinline__ void conv_phase(Frame& F, KArgs A) {
    const bf16* glu = (const bf16*)(A->ws + WS_GLU); bf16* zc = (bf16*)(A->ws + WS_ZC);
    const float* dw = A->in[7]; const float* db = A->in[8]; const float* lg = A->in[9]; const float* lb = A->in[10];
    LAS unsigned char* L = F.lds; constexpr int WT_OFF = 0, GL_OFF = 63488;
    const int tid = F.tid, lane = F.lane, wv = F.wave, c0 = 8 * lane;
    __syncthreads();
    for (int i = tid; i < CONVW * 128; i += NWAVES * 64) { const int w = i >> 7, q4 = i & 127;
        *(LAS f32x4*)(L + WT_OFF + ((q4 & 1) * CONVW + w) * 1024 + (q4 >> 1) * 16) = *(const GAS f32x4*)(dw + w * CCH + 4 * q4); }
    const f32x4 b0 = *(const GAS f32x4*)(db + c0), b1 = *(const GAS f32x4*)(db + c0 + 4);
    const f32x4 g0 = *(const GAS f32x4*)(lg + c0), g1 = *(const GAS f32x4*)(lg + c0 + 4);
    const f32x4 e0 = *(const GAS f32x4*)(lb + c0), e1 = *(const GAS f32x4*)(lb + c0 + 4);
    for (int bt = 0; bt < 2; ++bt) {
        const int t0 = 64 * F.vcu + 32 * bt;
        __syncthreads();
        for (int i = tid; i < 62 * 64; i += NWAVES * 64) { const int r = i >> 6, tt = t0 - 30 + r;
            *(LAS v4u*)(L + GL_OFF + i * 16) = tt >= 0 ? *(const GAS v4u*)(glu + (size_t)tt * CCH + 8 * (i & 63)) : (v4u){0u, 0u, 0u, 0u}; }
        __syncthreads();
        f32x4 a0[4], a1[4];
#pragma unroll
        for (int r = 0; r < 4; ++r) { a0[r] = b0; a1[r] = b1; }
#pragma unroll 4
        for (int w = 0; w < CONVW; ++w) {
            const f32x4 w0 = *(const LAS f32x4*)(L + WT_OFF + w * 1024 + lane * 16), w1 = *(const LAS f32x4*)(L + WT_OFF + (CONVW + w) * 1024 + lane * 16);
#pragma unroll
            for (int r = 0; r < 4; ++r) { const v4u z = *(const LAS v4u*)(L + GL_OFF + ((4 * wv + r + w) * 64 + lane) * 16);
                a0[r] += (f32x4){bflo(z.x), bfhi(z.x), bflo(z.y), bfhi(z.y)} * w0; a1[r] += (f32x4){bflo(z.z), bfhi(z.z), bflo(z.w), bfhi(z.w)} * w1; } }
#pragma unroll
        for (int r = 0; r < 4; ++r) { const int t = t0 + 4 * wv + r; f32x4 x0 = a0[r], x1 = a1[r];
            const float mean = wave_sum((x0.x + x0.y) + (x0.z + x0.w) + (x1.x + x1.y) + (x1.z + x1.w)) * (1.0f / CCH);
            x0 = x0 - mean; x1 = x1 - mean;
            const float var = wave_sum((x0.x * x0.x + x0.y * x0.y) + (x0.z * x0.z + x0.w * x0.w) + (x1.x * x1.x + x1.y * x1.y) + (x1.z * x1.z + x1.w * x1.w)) * (1.0f / CCH);
            const float rstd = __builtin_amdgcn_rsqf(var + EPS);
            f32x4 y0 = x0 * rstd * g0 + e0, y1 = x1 * rstd * g1 + e1;
#pragma unroll
            for (int e = 0; e < 4; ++e) { y0[e] = y0[e] * sigm_f(y0[e]); y1[e] = y1[e] * sigm_f(y1[e]); }
            v4u o; o.x = pk2(y0.x, y0.y); o.y = pk2(y0.z, y0.w); o.z = pk2(y1.x, y1.y); o.w = pk2(y1.z, y1.w);
            *(GAS v4u*)(zc + (size_t)t * CCH + c0) = o; }
    }
    __syncthreads();
}

__device__ __forceinline__ unsigned ordkey(float s) { unsigned u = __float_as_uint(s); if (s == 0.f) u = 0u; return (u & 0x80000000u) ? ~u : (u | 0x80000000u); }
__device__ __forceinline__ float h2f(unsigned short h) { return (float)__builtin_bit_cast(_Float16, h); }

__device__ __forceinline__ void indexer_simple(Frame& F, KArgs A) {
    const unsigned short* QI = (const unsigned short*)(A->ws + WS_QI); const unsigned short* KI = (const unsigned short*)(A->ws + WS_KI); const float* WI = (const float*)(A->ws + WS_WI);
    unsigned* mask32 = (unsigned*)(A->ws + WS_MASK);
    LAS unsigned* skey = (LAS unsigned*)(F.lds);
    LAS float* qif = (LAS float*)(F.lds + 65536);
    LAS unsigned* hist = (LAS unsigned*)(F.lds + 65536 + 1024);
    LAS unsigned* cnt = (LAS unsigned*)(F.lds + 65536 + 2048);
    LAS unsigned* wtot = (LAS unsigned*)(F.lds + 65536 + 4096);
    LAS unsigned* res = (LAS unsigned*)(F.lds + 65536 + 4160);
    const int tid = F.tid, lane = F.lane, wv = F.wave, w = (int)blockIdx.x;
    for (int jj = 0; jj < 64; ++jj) {
        const int j = jj >> 1; const int t = 512 * j + ((jj & 1) ? (511 - w) : w);
        const int n = t + 1;
        __syncthreads();
        if (tid < 256) qif[tid] = h2f(QI[(size_t)t * 256 + tid]);
        const f32x4 w4 = *(const GAS f32x4*)(WI + (size_t)t * 4);
        __syncthreads();
        for (int s = tid; s < n; s += 512) {
            float dot[4] = {0.f, 0.f, 0.f, 0.f};
#pragma unroll 1
            for (int c = 0; c < 8; ++c) { asm volatile("" ::: "memory"); const v4u kv = *(const GAS v4u*)(KI + (size_t)s * 64 + 8 * c);
                const unsigned kw[4] = {kv.x, kv.y, kv.z, kv.w};
#pragma unroll
                for (int e = 0; e < 4; ++e) { const float k0 = h2f((unsigned short)(kw[e] & 0xffffu)), k1 = h2f((unsigned short)(kw[e] >> 16));
#pragma unroll
                    for (int h = 0; h < 4; ++h) { dot[h] += k0 * qif[64 * h + 8 * c + 2 * e]; dot[h] += k1 * qif[64 * h + 8 * c + 2 * e + 1]; } } }
            float sc = w4.x * fmaxf(dot[0], 0.f); sc += w4.y * fmaxf(dot[1], 0.f); sc += w4.z * fmaxf(dot[2], 0.f); sc += w4.w * fmaxf(dot[3], 0.f);
            skey[s] = ordkey(sc);
        }
        __syncthreads();
        unsigned T = 0u, r = 0u;
        if (n > 256) {
            unsigned prefix = 0u, pmask = 0u, remaining = 256u;
            for (int pass = 0; pass < 4; ++pass) { const int shift = 24 - 8 * pass;
                if (tid < 256) hist[tid] = 0u;
                __syncthreads();
                for (int s = tid; s < n; s += 512) { const unsigned k = skey[s]; if ((k & pmask) == prefix) __hip_atomic_fetch_add(&hist[(k >> shift) & 255u], 1u, __ATOMIC_RELAXED, __HIP_MEMORY_SCOPE_WORKGROUP); }
                __syncthreads();
                if (wv == 0) {
                    const unsigned c0 = hist[4 * lane], c1 = hist[4 * lane + 1], c2 = hist[4 * lane + 2], c3 = hist[4 * lane + 3];
                    const unsigned tl = c0 + c1 + c2 + c3; unsigned suf = tl;
#pragma unroll
                    for (int o = 1; o < 64; o <<= 1) { const unsigned v = __shfl_down(suf, o); if (lane + o < 64) suf += v; }
                    const unsigned above = suf - tl;
                    if (above < remaining && remaining <= suf) {
                        unsigned a = above; int d;
                        if (a + c3 >= remaining) d = 3; else { a += c3; if (a + c2 >= remaining) d = 2; else { a += c2; if (a + c1 >= remaining) d = 1; else { a += c1; d = 0; } } }
                        res[0] = (unsigned)(4 * lane + d); res[1] = remaining - a; }
                }
                __syncthreads();
                prefix |= res[0] << shift; pmask |= 255u << shift; remaining = res[1];
                __syncthreads();
            }
            T = prefix; r = remaining;
        }
        const int s0 = 32 * tid; unsigned eqc = 0u;
        for (int i = 0; i < 32; ++i) { const int s = s0 + i; if (s < n && skey[s] == T) ++eqc; }
        unsigned inc = eqc;
#pragma unroll
        for (int o = 1; o < 64; o <<= 1) { const unsigned v = __shfl_up(inc, o); if (lane >= o) inc += v; }
        if (lane == 63) wtot[wv] = inc;
        __syncthreads();
        unsigned run = inc - eqc;
        for (int v = 0; v < wv; ++v) run += wtot[v];
        unsigned word = 0u;
        for (int i = 0; i < 32; ++i) { const int s = s0 + i; if (s < n) { const unsigned k = skey[s]; if (k > T) word |= 1u << i; else if (k == T) { if (run < r) word |= 1u << i; ++run; } } }
        const int nchunk = 8 * ((t >> 8) + 1);
        if (tid < nchunk) mask32[((size_t)(tid >> 1) * M + t) * 2 + (tid & 1)] = word;
    }
}

__device__ __forceinline__ int t5_bucket(int d) {
    if (d < 16) return d;
    int b = 16;
    b += d >= 19; b += d >= 21; b += d >= 24; b += d >= 27; b += d >= 31; b += d >= 35; b += d >= 40; b += d >= 46;
    b += d >= 52; b += d >= 59; b += d >= 67; b += d >= 77; b += d >= 87; b += d >= 99; b += d >= 113;
    return b;
}
__device__ __forceinline__ void attn_simple(Frame& F, KArgs A) {
    const bf16* Q = (const bf16*)(A->ws + WS_Q); const bf16* K = (const bf16*)(A->ws + WS_K); const bf16* V = (const bf16*)(A->ws + WS_V); bf16* O = (bf16*)(A->ws + WS_ATT);
    const unsigned long long* mask = (const unsigned long long*)(A->ws + WS_MASK); const float* relb = A->in[22];
    LAS unsigned char* base = F.lds + F.wave * 4096;
    LAS unsigned short* list = (LAS unsigned short*)base;
    LAS float* pbuf = (LAS float*)(base + 512);
    LAS float* qf = (LAS float*)(base + 1536);
    const int lane = F.lane, gw = (int)blockIdx.x * NWAVES + F.wave;
    for (int j = 0; j < 8; ++j) {
        const int t = 2048 * j + ((j & 1) ? (2047 - gw) : gw);
        { const v4u qv = *(const GAS v4u*)(Q + (size_t)t * AW + 8 * lane);
          qf[8 * lane + 0] = bflo(qv.x); qf[8 * lane + 1] = bfhi(qv.x); qf[8 * lane + 2] = bflo(qv.y); qf[8 * lane + 3] = bfhi(qv.y);
          qf[8 * lane + 4] = bflo(qv.z); qf[8 * lane + 5] = bfhi(qv.z); qf[8 * lane + 6] = bflo(qv.w); qf[8 * lane + 7] = bfhi(qv.w); }
        const int qg = t >> 5, cq = t & 31;
        const unsigned long long* mw = mask + (size_t)qg * 512 * 16;
        unsigned pc = 0u;
        for (int i = 0; i < 8; ++i) { const int ks = lane + 64 * i; if (ks <= qg) {
            for (int r = 0; r < 16; ++r) { const unsigned long long w = mw[ks * 16 + r]; pc += (unsigned)((w >> cq) & 1ull) + (unsigned)((w >> (cq + 32)) & 1ull); } } }
        unsigned inc = pc;
#pragma unroll
        for (int o = 1; o < 64; o <<= 1) { const unsigned v = __shfl_up(inc, o); if (lane >= o) inc += v; }
        const int cnt = (int)__shfl(inc, 63);
        unsigned pos = inc - pc;
        for (int i = 0; i < 8; ++i) { const int ks = lane + 64 * i; if (ks <= qg) {
            for (int r = 0; r < 16; ++r) { const unsigned long long w = mw[ks * 16 + r];
                for (int h2 = 0; h2 < 2; ++h2) if ((w >> (cq + 32 * h2)) & 1ull) { if (pos < 256u) list[pos] = (unsigned short)(32 * ks + (r & 3) + 8 * (r >> 2) + 4 * h2); ++pos; } } } }
        LDS_WAIT(); asm volatile("" ::: "memory");
        const int ncl = cnt < 256 ? cnt : 256;
        for (int h = 0; h < NH; ++h) {
            float lg[4]; float mx = -INFINITY;
#pragma unroll
            for (int i = 0; i < 4; ++i) { const int e = lane + 64 * i; lg[i] = -INFINITY;
                if (e < ncl) { const int key = list[e]; const bf16* kr = K + (size_t)key * AW + 64 * h; float dot = 0.f;
#pragma unroll
                    for (int c = 0; c < 8; ++c) { const v4u kv = *(const GAS v4u*)(kr + 8 * c); const LAS float* qq = qf + 64 * h + 8 * c;
                        dot += bflo(kv.x) * qq[0]; dot += bfhi(kv.x) * qq[1]; dot += bflo(kv.y) * qq[2]; dot += bfhi(kv.y) * qq[3];
                        dot += bflo(kv.z) * qq[4]; dot += bfhi(kv.z) * qq[5]; dot += bflo(kv.w) * qq[6]; dot += bfhi(kv.w) * qq[7]; }
                    lg[i] = dot + relb[t5_bucket(t - key) * NH + h] * LOG2E; }
                mx = fmaxf(mx, lg[i]); }
            mx = wave_max(mx);
            float sm = 0.f;
#pragma unroll
            for (int i = 0; i < 4; ++i) { const int e = lane + 64 * i; const float p = (e < ncl) ? __builtin_amdgcn_exp2f(lg[i] - mx) : 0.f; sm += p; if (e < ncl) pbuf[e] = p; }
            sm = wave_sum(sm);
            LDS_WAIT(); asm volatile("" ::: "memory");
            float acc = 0.f;
            for (int e = 0; e < ncl; ++e) { const int key = list[e]; acc += pbuf[e] * __uint_as_float((unsigned)V[(size_t)key * AW + 64 * h + lane] << 16); }
            O[(size_t)t * AW + 64 * h + lane] = (bf16)f2bf(acc / sm);
            LDS_WAIT(); asm volatile("" ::: "memory");
        }
    }
}


typedef _Float16 half8 __attribute__((ext_vector_type(8)));
typedef float f32x16 __attribute__((ext_vector_type(16)));
constexpr int IX_NBW = 515, IX_CENTER = 515, IX_TOPBIN = 1029, IX_CAP = 256, IX_SH = 19, IX_E0 = (127 - 28) * 16;
constexpr int IX_CHUNK = 32;
constexpr int IX_ROW = 64 + 1030;
constexpr int IXL_HIST = 0, IXL_IMG = 0, IXL_ZH = 70144, IXL_CANDK = 74240, IXL_CANDI = 107008, IXL_CCNT = 123392, IXL_ST = 123520, IXL_CNT = 124544, IXL_ST2 = 124672, IXL_FLAG = 125184, IXL_END = 125248;
enum { IXF_USEKEY = 1, IXF_TIE = 2, IXF_OVF = 4, IXF_NEEDTIE = 8 };
enum { IXM_HIST0 = 0, IXM_COUNT = 1, IXM_TIES = 2, IXM_COLLECT = 3 };

__device__ __forceinline__ int ix_bin(float s) {
    const unsigned u = __float_as_uint(s), a = u & 0x7fffffffu;
    int mi = (int)(a >> IX_SH) - IX_E0;
    mi = min(max(mi, -1), 512) + 1;
    const int b = (u >> 31) ? (IX_CENTER - 1 - mi) : (IX_CENTER + 1 + mi);
    return a == 0u ? IX_CENTER : b;
}
__device__ __forceinline__ void ix_bin_range(int b, unsigned& klo, unsigned& khi) {
    const bool pos = b > IX_CENTER; const int mi = pos ? b - IX_CENTER - 1 : IX_CENTER - 1 - b;
    const unsigned alo = mi == 0 ? 1u : ((unsigned)(mi - 1 + IX_E0) << IX_SH);
    const unsigned ahi = mi == 0 ? (((unsigned)IX_E0 << IX_SH) - 1u) : (mi == 513 ? 0x7fffffffu : alo + (1u << IX_SH) - 1u);
    if (pos) { klo = alo | 0x80000000u; khi = ahi | 0x80000000u; } else { klo = 0x7fffffffu - ahi; khi = 0x7fffffffu - alo; }
}
__device__ __forceinline__ unsigned wave_incl_scan(unsigned v, int lane) {
#pragma unroll
    for (int o = 1; o < 64; o <<= 1) { const unsigned t = __shfl_up(v, o); if (lane >= o) v += t; }
    return v;
}
__device__ __forceinline__ bool ix_scan_row(LAS unsigned char* L, int q, int lane, unsigned& B, unsigned& cB, unsigned& cab) {
    LAS unsigned* hq = (LAS unsigned*)(L + IXL_HIST) + (q & 15) * IX_ROW + (64 + IX_TOPBIN - 16) - 17 * lane; const int hsh = 16 * (q >> 4);
    unsigned cj[17]; unsigned tl = 0u;
#pragma unroll
    for (int j = 0; j < 17; ++j) { const unsigned v = (hq[16 - j] >> hsh) & 0xffffu; cj[j] = v; tl += v; }
    const unsigned inc = wave_incl_scan(tl, lane), above = inc - tl;
    const bool cross = above < 256u && 256u <= inc;
    unsigned b_ = 0u, c_ = 0u, a_ = 0u; { unsigned a = above; bool done = false;
#pragma unroll
        for (int j = 0; j < 17; ++j) { if (!done && a + cj[j] >= 256u) { b_ = (unsigned)(IX_TOPBIN - (17 * lane + j)); c_ = cj[j]; a_ = a; done = true; } a += cj[j]; } }
    const unsigned long long bal = __ballot(cross); const int src = bal ? (__ffsll((long long)bal) - 1) : 0;
    B = (unsigned)__shfl((int)b_, src); cB = (unsigned)__shfl((int)c_, src); cab = (unsigned)__shfl((int)a_, src);
    return bal != 0ull;
}
__device__ __forceinline__ void ix_group_scan(LAS unsigned* zhq, unsigned need, int lane, unsigned& gz, unsigned& before) {
    const unsigned w = zhq[lane >> 1]; const unsigned z0 = (w >> (16 * (lane & 1))) & 0xffu, z1 = (w >> (16 * (lane & 1) + 8)) & 0xffu;
    const unsigned tl = z0 + z1, inc = wave_incl_scan(tl, lane), bef = inc - tl;
    const bool cross = bef < need && need <= inc;
    const unsigned g = (bef + z0 >= need) ? (unsigned)(2 * lane) : (unsigned)(2 * lane + 1), b = (bef + z0 >= need) ? bef : bef + z0;
    const unsigned long long bal = __ballot(cross); const int src = bal ? (__ffsll((long long)bal) - 1) : 0;
    gz = (unsigned)__shfl((int)g, src); before = (unsigned)__shfl((int)b, src);
}

struct IxLane { unsigned thi, tlo, flags, gz, cmpkey; };
__device__ __forceinline__ float ix_relu(float x) { return __builtin_bit_cast(float, max(__builtin_bit_cast(int, x), 0)); }

template <int MODE, bool DIAG>
__device__ __forceinline__ void ix_tile(LAS unsigned char* L, f32x16 (&acc)[4], const f32x4 w4, int ks, int c, int hi, const IxLane st, bool act, unsigned& cnt) {
    LAS unsigned* hc = (LAS unsigned*)(L + IXL_HIST) + (c & 15) * IX_ROW + 64 + IX_CENTER;
    const unsigned hval = 1u << (16 * (c >> 4));
    LAS unsigned* zh = (LAS unsigned*)(L + IXL_ZH) + c * 32;
    const unsigned grp = (unsigned)ks >> 2;
    int cm = c - 4 * hi;
    if (DIAG) asm volatile("" : "+v"(cm));
    const bool tieLt = (st.flags & IXF_TIE) ? (grp < st.gz) : false, tieEq = (st.flags & IXF_TIE) ? (grp == st.gz) : true;

    float thif = __uint_as_float(st.thi), tlof = __uint_as_float(st.tlo);
    if (MODE == IXM_COLLECT) { thif = tieLt ? __uint_as_float(0x80000001u) : thif;
        tlof = (tieEq && !tieLt) ? tlof : __uint_as_float(0x7fc00000u); }
    unsigned mybits = 0u, nzs = 0u;
#pragma unroll
    for (int r = 0; r < 16; ++r) {
        const int ko = (r & 3) + 8 * (r >> 2);
        if ((r & 3) == 0) {
            float s0 = ix_relu(acc[0][r]) * w4.x, s1 = ix_relu(acc[0][r + 1]) * w4.x, s2 = ix_relu(acc[0][r + 2]) * w4.x, s3 = ix_relu(acc[0][r + 3]) * w4.x;
            s0 = __builtin_fmaf(ix_relu(acc[1][r]), w4.y, s0); s1 = __builtin_fmaf(ix_relu(acc[1][r + 1]), w4.y, s1); s2 = __builtin_fmaf(ix_relu(acc[1][r + 2]), w4.y, s2); s3 = __builtin_fmaf(ix_relu(acc[1][r + 3]), w4.y, s3);
            s0 = __builtin_fmaf(ix_relu(acc[2][r]), w4.z, s0); s1 = __builtin_fmaf(ix_relu(acc[2][r + 1]), w4.z, s1); s2 = __builtin_fmaf(ix_relu(acc[2][r + 2]), w4.z, s2); s3 = __builtin_fmaf(ix_relu(acc[2][r + 3]), w4.z, s3);
            s0 = __builtin_fmaf(ix_relu(acc[3][r]), w4.w, s0); s1 = __builtin_fmaf(ix_relu(acc[3][r + 1]), w4.w, s1); s2 = __builtin_fmaf(ix_relu(acc[3][r + 2]), w4.w, s2); s3 = __builtin_fmaf(ix_relu(acc[3][r + 3]), w4.w, s3);
            asm volatile("" : "+v"(s0), "+v"(s1), "+v"(s2), "+v"(s3));
            acc[0][r] = s0; acc[0][r + 1] = s1; acc[0][r + 2] = s2; acc[0][r + 3] = s3; }
        const float sc = acc[0][r];
        const unsigned u = __float_as_uint(sc);
        const bool ok = (DIAG ? (ko <= cm) : true) && ((MODE == IXM_COLLECT || MODE == IXM_HIST0) ? true : act);
        if (MODE == IXM_HIST0) {
            const int t = (int)((u >> IX_SH) & 0xfffu);
            int m1; asm("v_med3_i32 %0, %1, 1, %2" : "=v"(m1) : "v"(t - (IX_E0 - 2)), "s"(514));
            m1 = (int)min((unsigned)m1, u << 1);
            const int sm = (int)(((unsigned)((int)u >> 31) << 3) | 4u);
            unsigned hpa; asm("v_mad_i32_i24 %0, %1, %2, %3" : "=v"(hpa) : "v"(m1), "v"(sm), "v"((unsigned)(uintptr_t)hc));
            LAS unsigned* hp = (LAS unsigned*)(uintptr_t)hpa;
            if (DIAG) { if (ok) __hip_atomic_fetch_add(hp, hval, __ATOMIC_RELAXED, __HIP_MEMORY_SCOPE_WORKGROUP); nzs += ok ? (unsigned)min(m1, 1) : 1u; }
            else { __hip_atomic_fetch_add(hp, hval, __ATOMIC_RELAXED, __HIP_MEMORY_SCOPE_WORKGROUP); nzs += (unsigned)min(m1, 1); }
        } else if (MODE == IXM_COUNT) {
            cnt += (ok && ordkey(sc) > st.cmpkey) ? 1u : 0u;
        } else if (MODE == IXM_TIES) {
            if (ok && ordkey(sc) == st.cmpkey) __hip_atomic_fetch_add(&zh[grp >> 2], 1u << (8 * (grp & 3)), __ATOMIC_RELAXED, __HIP_MEMORY_SCOPE_WORKGROUP);
        } else {
            const unsigned long long Gm = __builtin_amdgcn_ballot_w64(sc > thif), Em = __builtin_amdgcn_ballot_w64(sc >= tlof);
            const bool gt = __builtin_amdgcn_inverse_ballot_w64(Gm); bool isc = __builtin_amdgcn_inverse_ballot_w64(Em & ~Gm);
            bool sel = gt;
            sel = sel && ok; isc = isc && ok;
            if (isc) { LAS unsigned* ccnt = (LAS unsigned*)(L + IXL_CCNT) + c; const unsigned pos = __hip_atomic_fetch_add(ccnt, 1u, __ATOMIC_RELAXED, __HIP_MEMORY_SCOPE_WORKGROUP);
                { const unsigned pos_ = pos; const unsigned pos = min(pos_, (unsigned)IX_CAP - 1u);
                  ((LAS unsigned*)(L + IXL_CANDK) + c * IX_CAP)[pos] = __float_as_uint(sc);     ((LAS unsigned short*)(L + IXL_CANDI) + c * IX_CAP)[pos] = (unsigned short)(32 * ks + ko + 4 * hi); } }
            mybits |= sel ? (1u << ko) : 0u;
        }
        if ((r & 3) == 3) __builtin_amdgcn_sched_barrier(0);
    }
    if (MODE == IXM_HIST0) { const unsigned nz = act ? 16u - nzs : 0u; if (nz) __hip_atomic_fetch_add(&zh[grp >> 2], nz << (8 * (grp & 3)), __ATOMIC_RELAXED, __HIP_MEMORY_SCOPE_WORKGROUP); }
    if (MODE == IXM_COLLECT) { mybits <<= 4 * hi; const unsigned word = mybits | (unsigned)__shfl_xor((int)mybits, 32);
        if (hi == 0) ((LAS unsigned*)(L + IXL_IMG))[(((ks >> 1) * 32 + c) << 1) + (ks & 1)] = word; }
}

template <int MODE>
__device__ __forceinline__ void ix_pass(LAS unsigned char* L, const half8 (&qf)[4][4], const f32x4 w4, const unsigned short* KI, int qg, int wv, int lane, const IxLane st) {
    const int c = lane & 31, hi = lane >> 5;
    unsigned cnt = 0u;
    const bool act = (MODE == IXM_COUNT) ? ((st.flags & IXF_OVF) != 0u) : (MODE == IXM_TIES) ? ((st.flags & IXF_NEEDTIE) != 0u) : true;
    const unsigned short* kp = KI + (size_t)c * 64 + 32 * hi;
    IxLane sv = st;
    for (int ks = wv; ks <= qg; ks += 8) {
        half8 a[4];
#pragma unroll
        for (int s = 0; s < 4; ++s) a[s] = *(const GAS half8*)(kp + (size_t)ks * 2048 + 8 * s);
        f32x16 acc[4];
#pragma unroll
        for (int h = 0; h < 4; ++h) { acc[h] = (f32x16){};
#pragma unroll
            for (int s = 0; s < 4; ++s) acc[h] = __builtin_amdgcn_mfma_f32_32x32x16_f16(a[s], qf[h][s], acc[h], 0, 0, 0); }
        if (ks == qg) ix_tile<MODE, true>(L, acc, w4, ks, c, hi, sv, act, cnt);
        else ix_tile<MODE, false>(L, acc, w4, ks, c, hi, sv, act, cnt);
    }
    if (MODE == IXM_COUNT) { if (act && cnt) __hip_atomic_fetch_add((LAS unsigned*)(L + IXL_CNT) + c, cnt, __ATOMIC_RELAXED, __HIP_MEMORY_SCOPE_WORKGROUP); }
}

__device__ __forceinline__ void indexer_fast(Frame& F, KArgs A) {
    unsigned char* ws = A->ws;
    const unsigned short* QI = (const unsigned short*)(ws + WS_QI); const unsigned short* KI = (const unsigned short*)(ws + WS_KI); const float* WI = (const float*)(ws + WS_WI);
    unsigned char* maskW = ws + WS_MASK;
    LAS unsigned char* L = F.lds;
    const int tid = F.tid, lane = F.lane, wv = F.wave, c = lane & 31, hi = lane >> 5;
    LAS unsigned* ST = (LAS unsigned*)(L + IXL_ST); LAS unsigned* ST2 = (LAS unsigned*)(L + IXL_ST2); LAS unsigned* CNT = (LAS unsigned*)(L + IXL_CNT);
    LAS unsigned* CCNT = (LAS unsigned*)(L + IXL_CCNT); LAS unsigned* FLAG = (LAS unsigned*)(L + IXL_FLAG);
#pragma unroll 1
    for (int it = 0; it < 2; ++it) {
        const int qg = it ? (int)blockIdx.x : 511 - (int)blockIdx.x;
        const int t = 32 * qg + c;
        half8 qf[4][4];
#pragma unroll
        for (int h = 0; h < 4; ++h)
#pragma unroll
            for (int s = 0; s < 4; ++s) qf[h][s] = *(const GAS half8*)(QI + (size_t)t * 256 + 64 * h + 32 * hi + 8 * s);
        const f32x4 w4 = *(const GAS f32x4*)(WI + (size_t)t * 4);
        __syncthreads();
        static_assert(IXL_END % 16 == 0, "");
        for (int u = tid; u < IXL_END / 16; u += NWAVES * 64) ((LAS v4u*)L)[u] = (v4u){0u, 0u, 0u, 0u};
        __syncthreads();
        IxLane st{0u, 0u, 0u, 0u, (unsigned)(-1024)};
#ifdef DIAG_TIME
#define TSTAMP(k) do { if (blockIdx.x == 0 && it == 0 && tid == 0) ((unsigned long long*)(ws + WS_CTL + 16384))[k] = __builtin_amdgcn_s_memrealtime(); } while (0)
#else
#define TSTAMP(k) do {} while (0)
#endif
        TSTAMP(0);
#ifndef REP_HIST
#define REP_HIST 1
#endif
#ifndef REP_COLL
#define REP_COLL 1
#endif
#pragma unroll 1
        for (int rep = 0; rep < REP_HIST; ++rep) {
            if (rep) { __syncthreads(); for (int u = tid; u < IXL_CANDK / 4; u += NWAVES * 64) ((LAS unsigned*)L)[u] = 0u; __syncthreads(); }
            ix_pass<IXM_HIST0>(L, qf, w4, KI, qg, wv, lane, st); }
        __syncthreads();
        TSTAMP(1);
#pragma unroll 1
        for (int qi = 0; qi < 4; ++qi) {
            const int q = 4 * wv + qi, n = 32 * qg + q + 1;
            if (n <= 256) { if (lane == 0) { ST[q * 8 + 0] = 0x007fffffu; ST[q * 8 + 1] = 0xff800000u; } continue; }
            unsigned B, cB, cab; (void)ix_scan_row(L, q, lane, B, cB, cab);
            const unsigned r = 256u - cab;
            unsigned flags = 0u, gz = 0u, rn = r, klo, khi;
            if (B == (unsigned)IX_CENTER) { klo = 0x7fffffffu; khi = 0x80000000u; } else ix_bin_range((int)B, klo, khi);
            if (cB > (unsigned)IX_CAP) {
                if (B == (unsigned)IX_CENTER) { unsigned before; ix_group_scan((LAS unsigned*)(L + IXL_ZH) + q * 32, r, lane, gz, before); rn = r - before; flags = IXF_TIE; }
                else { flags = IXF_OVF;
                    if (lane == 0) { ST2[q * 4 + 0] = klo - 1u; ST2[q * 4 + 1] = khi; ST2[q * 4 + 2] = cab + cB; ST2[q * 4 + 3] = cab; FLAG[0] = 1u; }
#ifdef DIAG_OVF
                    if (lane == 0) { unsigned* dg = (unsigned*)(ws + WS_CTL) + 2048; atomicAdd(dg + 0, 1u); atomicMax(dg + 1, cB); atomicMax(dg + 2, (cB << 16) | B); atomicMax(dg + 3, (cB << 16) | (unsigned)n); }
#endif
                    }
            }
            if (lane == 0) { ST[q * 8 + 0] = khi; ST[q * 8 + 1] = klo; ST[q * 8 + 2] = flags; ST[q * 8 + 3] = rn; ST[q * 8 + 4] = gz; }
        }
        __syncthreads();
        if (FLAG[0] != 0u) {
#pragma unroll 1
            for (int iter = 0; iter < 40; ++iter) {
                const unsigned fl = ST[c * 8 + 2], lo = ST2[c * 4 + 0], hh = ST2[c * 4 + 1];
                const bool actv = (fl & IXF_OVF) && (hh - lo > 1u);
                if (!__any(actv)) break;
                const unsigned mid = lo + ((hh - lo) >> 1);
                if (tid < 32) CNT[tid] = 0u;
                __syncthreads();
                IxLane sc{0u, 0u, actv ? (unsigned)IXF_OVF : 0u, 0u, mid};
                ix_pass<IXM_COUNT>(L, qf, w4, KI, qg, wv, lane, sc);
                __syncthreads();
                if (tid < 32 && actv) { const unsigned g = CNT[tid]; if (g >= 256u) { ST2[tid * 4 + 0] = mid; ST2[tid * 4 + 2] = g; } else { ST2[tid * 4 + 1] = mid; ST2[tid * 4 + 3] = g; } }
                __syncthreads();
            }
            if (tid < 32 && (ST[tid * 8 + 2] & IXF_OVF)) { const unsigned T = ST2[tid * 4 + 1], glo = ST2[tid * 4 + 2], ghi = ST2[tid * 4 + 3];
                ST[tid * 8 + 0] = T; ST[tid * 8 + 1] = T; ST[tid * 8 + 3] = 256u - ghi;
                const bool nt = (glo - ghi) > (unsigned)IX_CAP; ST[tid * 8 + 2] = (nt ? (unsigned)IXF_NEEDTIE : 0u);
                if (nt) { FLAG[1] = 1u; for (int k = 0; k < 32; ++k) ((LAS unsigned*)(L + IXL_ZH))[tid * 32 + k] = 0u; } }
            __syncthreads();
            if (FLAG[1] != 0u) {
                IxLane sc{0u, 0u, ST[c * 8 + 2], 0u, ST[c * 8 + 0]};
                ix_pass<IXM_TIES>(L, qf, w4, KI, qg, wv, lane, sc);
                __syncthreads();
#pragma unroll 1
                for (int qi = 0; qi < 4; ++qi) { const int q = 4 * wv + qi; const unsigned fl = ST[q * 8 + 2];
                    if (fl & IXF_NEEDTIE) { unsigned gz, before; ix_group_scan((LAS unsigned*)(L + IXL_ZH) + q * 32, ST[q * 8 + 3], lane, gz, before);
                        if (lane == 0) { ST[q * 8 + 3] -= before; ST[q * 8 + 4] = gz; ST[q * 8 + 2] = IXF_TIE; } } }
                __syncthreads();
            }
        }
        TSTAMP(2);
        const unsigned khi_ = ST[c * 8 + 0], klo_ = ST[c * 8 + 1];
        const IxLane sl{(khi_ & 0x80000000u) ? (khi_ & 0x7fffffffu) : ~khi_, (klo_ & 0x80000000u) ? (klo_ & 0x7fffffffu) : ~klo_, ST[c * 8 + 2], ST[c * 8 + 4], 0u};
#pragma unroll 1
        for (int rep = 0; rep < REP_COLL; ++rep) {
            __syncthreads();
            for (int u = tid; u < 65536 / 16; u += NWAVES * 64) ((LAS v4u*)(L + IXL_IMG))[u] = (v4u){0u, 0u, 0u, 0u};
            if (tid < 32) CCNT[tid] = 0u;
            __syncthreads();
            ix_pass<IXM_COLLECT>(L, qf, w4, KI, qg, wv, lane, sl); }
        __syncthreads();
        TSTAMP(3);
#pragma unroll 1
        for (int qi = 0; qi < 4; ++qi) { const int q = 4 * wv + qi; const int nc = (int)min(CCNT[q], (unsigned)IX_CAP); const unsigned rn = ST[q * 8 + 3];
            if (nc == 0 || rn == 0u) continue;
            const LAS unsigned* ckq = (const LAS unsigned*)(L + IXL_CANDK) + q * IX_CAP; const LAS unsigned short* ciq = (const LAS unsigned short*)(L + IXL_CANDI) + q * IX_CAP;
            unsigned kk[4], ii[4], rk[4];
#pragma unroll
            for (int m = 0; m < 4; ++m) { const int id = lane + 64 * m; const bool v = id < nc; kk[m] = v ? ordkey(__uint_as_float(ckq[id])) : 0u; ii[m] = v ? (unsigned)ciq[id] : 0xffffu; rk[m] = 0u; }
            if (nc <= 64) {
                const unsigned long long me0 = ((unsigned long long)kk[0] << 32) | (0xffffu - ii[0]);
#pragma unroll 2
                for (int jj = 0; jj < nc; ++jj) { const unsigned kj = (unsigned)__builtin_amdgcn_readlane((int)kk[0], jj), ij = (unsigned)__builtin_amdgcn_readlane((int)ii[0], jj);
                    rk[0] += ((((unsigned long long)kj << 32) | (0xffffu - ij)) > me0) ? 1u : 0u; }
            } else if (nc <= 128) {
#pragma unroll
                for (int ch = 0; ch < 2; ++ch) { const int cntc = min(64, nc - 64 * ch);
#pragma unroll 2
                    for (int jj = 0; jj < cntc; ++jj) { const unsigned kj = (unsigned)__builtin_amdgcn_readlane((int)kk[ch], jj), ij = (unsigned)__builtin_amdgcn_readlane((int)ii[ch], jj);
#pragma unroll
                        for (int m = 0; m < 2; ++m) rk[m] += ((((unsigned long long)kj << 32) | (0xffffu - ij)) > ((((unsigned long long)kk[m]) << 32) | (0xffffu - ii[m]))) ? 1u : 0u; } }
            } else {
#pragma unroll
            for (int ch = 0; ch < 4; ++ch) { const int cntc = min(64, nc - 64 * ch);
                if (cntc > 0) {
#pragma unroll 2
                    for (int jj = 0; jj < cntc; ++jj) { const unsigned kj = (unsigned)__builtin_amdgcn_readlane((int)kk[ch], jj), ij = (unsigned)__builtin_amdgcn_readlane((int)ii[ch], jj);
#pragma unroll
                        for (int m = 0; m < 4; ++m) rk[m] += ((((unsigned long long)kj << 32) | (0xffffu - ij)) > ((((unsigned long long)kk[m]) << 32) | (0xffffu - ii[m]))) ? 1u : 0u; } } }
            }
#pragma unroll
            for (int m = 0; m < 4; ++m) { const int id = lane + 64 * m; const unsigned mi = ii[m];
                if (id < nc && rk[m] < rn) __hip_atomic_fetch_or((LAS unsigned*)(L + IXL_IMG) + ((((mi >> 6) * 32 + (unsigned)q) << 1) + ((mi >> 5) & 1u)), 1u << (mi & 31u), __ATOMIC_RELAXED, __HIP_MEMORY_SCOPE_WORKGROUP); } }
        __syncthreads();
        TSTAMP(4);
        { const int ntile = 4 * (qg / 8 + 1);
          unsigned char* const mw_ = kargs()->ws + WS_MASK;
          int tq = tid; asm volatile("" : "+v"(tq));
          for (int tt = tq >> 4; tt < ntile; tt += NWAVES * 4) *(GAS v4u*)(mw_ + ((size_t)tt * M + 32 * qg) * 8 + (tq & 15) * 16) = *(const LAS v4u*)(L + IXL_IMG + tt * 256 + (tq & 15) * 16); }
        TSTAMP(5);
    }
    __syncthreads();
}

#include <hip/hip_bf16.h>
#include <cmath>
namespace attn_body {
using bf16=__hip_bfloat16;
using bf16x8=__attribute__((ext_vector_type(8)))short;
using s16x4=__attribute__((ext_vector_type(4)))short;
using f32x16=__attribute__((ext_vector_type(16)))float;
using u32x4=__attribute__((ext_vector_type(4)))unsigned;
constexpr int BATCH=1,NHEAD=8,SEQ=16384,D=64,DM=NHEAD*D;
constexpr int NW=8,QBLK=32,QB=QBLK*NW,KVBLK=64,NQB=SEQ/QB;
constexpr int ATTN_PITCH=DM, ATTN_UNIT_ROWS=QB;
__device__ __forceinline__ int crow(int r,int hi){return (r&3)+8*(r>>2)+4*hi;}
#define SBAR() __builtin_amdgcn_sched_barrier(0)
constexpr int NSLOT=3, SLOTB=8192;
constexpr int LDS_K=0, LDS_V=NSLOT*SLOTB, LDS_WS=2*NSLOT*SLOTB, LDS_OST=LDS_WS+NW*64*4, LDS_MK=LDS_OST+NW*4096, LDS_BT=LDS_MK+NW*768, LDS_BYTES=LDS_BT+512;
constexpr float C2=0.125f*1.4426950408889634f;
__device__ __forceinline__ void glds4(const void*gsrc,unsigned lds_dst){unsigned keep;
  asm volatile("s_mov_b32 %0, m0\n\ts_mov_b32 m0, %2\n\ts_nop 0\n\tglobal_load_lds_dword %1, off\n\ts_mov_b32 m0, %0":"=&s"(keep):"v"(gsrc),"s"(lds_dst):"memory");}
__device__ __forceinline__ void glds16(const void*gsrc,unsigned lds_dst){unsigned keep;
  asm volatile("s_mov_b32 %0, m0\n\ts_mov_b32 m0, %2\n\ts_nop 0\n\tglobal_load_lds_dwordx4 %1, off\n\ts_mov_b32 m0, %0":"=&s"(keep):"v"(gsrc),"s"(lds_dst):"memory");}
__device__ __forceinline__ float max3f(float a,float b,float c){float r;asm("v_max3_f32 %0, %1, %2, %3":"=v"(r):"v"(a),"v"(b),"v"(c));return r;}
__device__ __forceinline__ float max2f(float a,float b){float r;asm("v_max_f32_e32 %0, %1, %2":"=v"(r):"v"(a),"v"(b));return r;}
__device__ __forceinline__ float fadd_s(float a,float b){float r;asm("v_add_f32_e32 %0, %1, %2":"=v"(r):"v"(a),"v"(b));return r;}
__device__ __forceinline__ float fsub_s(float a,float b){float r;asm("v_sub_f32_e32 %0, %1, %2":"=v"(r):"v"(a),"v"(b));return r;}
typedef float f32x2_t __attribute__((ext_vector_type(2))); typedef __bf16 bf16x2_t __attribute__((ext_vector_type(2)));
__device__ __forceinline__ unsigned cvtpk_s(float lo,float hi){f32x2_t v={lo,hi};bf16x2_t b=__builtin_convertvector(v,bf16x2_t);return __builtin_bit_cast(unsigned,b);}
#define WAIT_BAR(N) asm volatile("s_waitcnt vmcnt(" #N ") lgkmcnt(0)\n\ts_barrier":::"memory")

__device__ __forceinline__ void qkt(f32x16&p0,f32x16&p1,const char*Kslot,const bf16x8*qr,const f32x16&negm,int r32,int hi){
  const char*kb=Kslot+hi*1024+r32*16;
  #pragma unroll
  for(int d0=0;d0<4;++d0){
    const bf16x8 b0=*reinterpret_cast<const bf16x8*>(kb+d0*2048);
    const bf16x8 b1=*reinterpret_cast<const bf16x8*>(kb+d0*2048+512);
    if(d0==0){p0=__builtin_amdgcn_mfma_f32_32x32x16_bf16(b0,qr[0],negm,0,0,0);p1=__builtin_amdgcn_mfma_f32_32x32x16_bf16(b1,qr[0],negm,0,0,0);}
    else{p0=__builtin_amdgcn_mfma_f32_32x32x16_bf16(b0,qr[d0],p0,0,0,0);p1=__builtin_amdgcn_mfma_f32_32x32x16_bf16(b1,qr[d0],p1,0,0,0);}}
}
typedef __attribute__((address_space(3))) const char* lds_cptr;
typedef short v4i16_t __attribute__((ext_vector_type(4)));
__device__ __forceinline__ void kload8(bf16x8*kf,lds_cptr kp){
  kf[0]=*(const __attribute__((address_space(3))) bf16x8*)(kp);      kf[1]=*(const __attribute__((address_space(3))) bf16x8*)(kp+512);
  kf[2]=*(const __attribute__((address_space(3))) bf16x8*)(kp+2048); kf[3]=*(const __attribute__((address_space(3))) bf16x8*)(kp+2560);
  kf[4]=*(const __attribute__((address_space(3))) bf16x8*)(kp+4096); kf[5]=*(const __attribute__((address_space(3))) bf16x8*)(kp+4608);
  kf[6]=*(const __attribute__((address_space(3))) bf16x8*)(kp+6144); kf[7]=*(const __attribute__((address_space(3))) bf16x8*)(kp+6656);
}
__device__ __forceinline__ void kload2(bf16x8*kf,lds_cptr kp,int j){ kf[2*j]=*(const __attribute__((address_space(3))) bf16x8*)(kp+j*2048); kf[2*j+1]=*(const __attribute__((address_space(3))) bf16x8*)(kp+j*2048+512); }
__device__ __forceinline__ s16x4 vtr(lds_cptr p){ return __builtin_bit_cast(s16x4,__builtin_amdgcn_ds_read_tr16_b64_v4i16((__attribute__((address_space(3))) v4i16_t*)p)); }
__device__ __forceinline__ float rowmax(const f32x16&p0,const f32x16&p1){
  float a=max3f(p0[0],p0[1],p1[0]),b=max3f(p0[2],p0[3],p1[1]);a=max3f(a,p1[2],p1[3]);
  #pragma unroll
  for(int r=4;r<16;r+=4){a=max3f(a,p0[r],p0[r+1]);b=max3f(b,p0[r+2],p0[r+3]);a=max3f(a,p1[r],p1[r+1]);b=max3f(b,p1[r+2],p1[r+3]);}
  const float m=max2f(a,b);
  auto rr=__builtin_amdgcn_permlane32_swap(__float_as_uint(m),__float_as_uint(m),false,false);
  return max2f(__uint_as_float(rr[0]),__uint_as_float(rr[1]));
}
__device__ __forceinline__ void pv(f32x16*o,int vb,bf16x8 pa0,bf16x8 pa1,bf16x8 pa2,bf16x8 pa3){
  #pragma unroll
  for(int d0=0;d0<2;++d0){s16x4 lo[4],hi[4];
    #pragma unroll
    for(int ks=0;ks<4;++ks){
      asm volatile("ds_read_b64_tr_b16 %0,%1 offset:%c2":"=&v"(lo[ks]):"v"(vb),"i"(d0*4096+ks*1024):"memory");
      asm volatile("ds_read_b64_tr_b16 %0,%1 offset:%c2":"=&v"(hi[ks]):"v"(vb),"i"(d0*4096+ks*1024+512):"memory");}
    asm volatile("s_waitcnt lgkmcnt(0)":::"memory");SBAR();
    #define PK(k) (bf16x8){lo[k][0],lo[k][1],lo[k][2],lo[k][3],hi[k][0],hi[k][1],hi[k][2],hi[k][3]}
    o[d0]=__builtin_amdgcn_mfma_f32_32x32x16_bf16(pa0,PK(0),o[d0],0,0,0);
    o[d0]=__builtin_amdgcn_mfma_f32_32x32x16_bf16(pa1,PK(1),o[d0],0,0,0);
    o[d0]=__builtin_amdgcn_mfma_f32_32x32x16_bf16(pa2,PK(2),o[d0],0,0,0);
    o[d0]=__builtin_amdgcn_mfma_f32_32x32x16_bf16(pa3,PK(3),o[d0],0,0,0);
    #undef PK
  }
}

#ifndef ATTN_STORE16
#define ATTN_STORE16(p,v) (*(u32x4*)(p)=(v))
#endif
__device__ __forceinline__ void attn_unit(int h,int qb,const bf16*Q,const bf16*__restrict__ K,const bf16*__restrict__ V,bf16*O,const unsigned char*maskT,char*shm,const int wid){
  const int lane=lane_now(),tid=wid*64+lane,r32=lane&31,hi=lane>>5;
  const long rowbase=0; const int q0=qb*QB;
  const bf16*Qw=Q+(rowbase+q0+wid*QBLK)*DM+h*D;
  const bf16*Kh=K+rowbase*DM+h*D,*Vh=V+rowbase*DM+h*D;
  const unsigned lds0=(unsigned)(uintptr_t)shm;
  float*wsf=(float*)(shm+LDS_WS)+wid*64;
  const bf16*ksrc=Kh+(long)lane*DM+wid*8;
  const bf16*vsrc=Vh+(long)(16*(wid&3)+(lane>>2))*DM+(wid>>2)*32+(lane&3)*8;
  const unsigned kdst=lds0+LDS_K+wid*1024, vdst=lds0+LDS_V+wid*1024;
  #define DMA_K(t,slot) glds16(ksrc+(long)(t)*KVBLK*DM,(unsigned)__builtin_amdgcn_readfirstlane(kdst+(slot)))
  #define DMA_V(t,slot) glds16(vsrc+(long)(t)*KVBLK*DM,(unsigned)__builtin_amdgcn_readfirstlane(vdst+(slot)))
  const int vb0=(int)(lds0+LDS_V)+((lane>>4)&1)*32+(lane&3)*8+(4*hi+((lane&15)>>2))*64;
  const char*Kbase=shm+LDS_K; bf16x8 kf[8];
  const lds_cptr shm3=(lds_cptr)shm; const lds_cptr kp0=shm3+LDS_K+hi*1024+r32*16; const lds_cptr vp0=shm3+LDS_V+((lane>>4)&1)*32+(lane&3)*8+(4*hi+((lane&15)>>2))*64;
  const int NT=(q0+QB)/KVBLK;
  const unsigned char*msrc=maskT+((size_t)(q0+wid*QBLK))*8+lane*4;
  const unsigned mdst=lds0+LDS_MK+wid*768;
  #define DMA_M(t,slot) glds4(msrc+(size_t)(t)*((size_t)SEQ*8),(unsigned)__builtin_amdgcn_readfirstlane(mdst+((slot)>>5)))
  const lds_cptr mp0=shm3+LDS_MK+wid*768+r32*8;
  const __attribute__((address_space(3))) float* bt3=(const __attribute__((address_space(3))) float*)(shm3+LDS_BT);
  const int qpos=q0+wid*QBLK+r32;
  unsigned m0=0u,m1=0u;
  #define MASKLD(slot) do{ const unsigned long long mw_=*(const __attribute__((address_space(3))) unsigned long long*)(mp0+((slot)>>5)); m0=((unsigned)mw_)>>(4*hi); m1=((unsigned)(mw_>>32))>>(4*hi); }while(0)
  #define MBIT(r) (((r)&3)+8*((r)>>2))
  #define MAND(x,mw,r) x=__uint_as_float(__float_as_uint(x)&(unsigned)(((int)((mw)<<(31-MBIT(r))))>>31))
  #define MANDA(x,mw,r) do{ int t_; float x_=(x); asm("v_bfe_i32 %1, %2, %3, 1\n\tv_and_b32 %0, %0, %1":"+v"(x_),"=&v"(t_):"v"(mw),"i"(MBIT(r))); (x)=x_; }while(0)
  #define BAND(P0,P1,t) do{ const int kb_=qpos-64*(t)-4*hi; \
      _Pragma("unroll") for(int r=0;r<16;++r){ const int d0_=kb_-MBIT(r); P0[r]+=bt3[min(max(d0_,0),127)]; P1[r]+=bt3[min(max(d0_-32,0),127)]; } }while(0)
  DMA_M(0,0);DMA_M(1,SLOTB);DMA_K(0,0);DMA_V(0,0);DMA_K(1,SLOTB);
  bf16x8 qr[4];
  #pragma unroll
  for(int d0=0;d0<4;++d0)qr[d0]=*reinterpret_cast<const bf16x8*>(&Qw[(long)r32*DM+d0*16+hi*8]);
  float l_reg=0.f;f32x16 o[2];o[0]=f32x16{};o[1]=f32x16{};const f32x16 negm=f32x16{};
  f32x16 pA0,pA1,pB0,pB1;
  int sl_prev=0,sl_cur=0,sl_next=SLOTB;
  #define ROT() do{sl_prev=sl_cur;sl_cur=sl_next;sl_next=(sl_next==(NSLOT-1)*SLOTB)?0:sl_next+SLOTB;}while(0)
  DMA_K(2,2*SLOTB);
  WAIT_BAR(3);
  qkt(pA0,pA1,Kbase,qr,negm,r32,hi);asm volatile("s_nop 15\n\ts_nop 7":"+v"(pA0),"+v"(pA1));
  if(NT<=6)BAND(pA0,pA1,0);
  MASKLD(0);
  _Pragma("unroll") for(int r=0;r<16;++r){pA0[r]=__builtin_amdgcn_exp2f(pA0[r]);MAND(pA0[r],m0,r);pA1[r]=__builtin_amdgcn_exp2f(pA1[r]);MAND(pA1[r],m1,r);}
  WAIT_BAR(0);
  DMA_M(2,2*SLOTB);DMA_K(3,0);DMA_V(1,SLOTB);
  ROT();
  kload8(kf,kp0+sl_cur);
  WAIT_BAR(3);
  s16x4 vlo[8],vhi[8]; u32x4 pw0,pw1,pw2,pw3;
  #define PKW(P,B) cvtpk_s(P[B],P[B+1])
  #define PAF(k) __builtin_bit_cast(bf16x8,pw##k)
  #define VFR(i) (bf16x8){vlo[i][0],vlo[i][1],vlo[i][2],vlo[i][3],vhi[i][0],vhi[i][1],vhi[i][2],vhi[i][3]}
  #define PIN(x) asm volatile("":"+v"(x))
  #define MX3(a,b,c) __builtin_fmaxf(__builtin_fmaxf((a),(b)),(c))
  #define GAPA(MF,A0,A1,A2,A3,W0,W1,PW) do{ MF; sacc+=A0; sacc+=A1; sacc+=A2; sacc+=A3; PIN(sacc); W0; W1; PIN(PW); SBAR(); }while(0)
  #define EX(v) __builtin_amdgcn_exp2f(v)
  #define GAPB(MF,X,B,MW) do{ MF; X[B]=EX(X[B]); X[B+1]=EX(X[B+1]); X[B+2]=EX(X[B+2]); X[B+3]=EX(X[B+3]); MANDA(X[B],MW,B); MANDA(X[B+1],MW,B+1); MANDA(X[B+2],MW,B+2); MANDA(X[B+3],MW,B+3); PIN(X); SBAR(); }while(0)
  #define VRD(i) do{ vlo[i]=vtr(vp_+(((i)>>2)*4096+((i)&3)*1024)); vhi[i]=vtr(vp_+(((i)>>2)*4096+((i)&3)*1024+512)); }while(0)
  #define KRD(G,j) do{ if(G){ kload2(kf,kp0+sl_next,j); SBAR(); } }while(0)
  #define STEP(C0,C1,P0,P1,t,GK,GV,GL,GM,BND) do{ SBAR(); \
    const lds_cptr vp_=vp0+sl_prev; \
    VRD(0); SBAR(); float sacc=(P0[0]+P0[1]); \
    GAPA(C0=__builtin_amdgcn_mfma_f32_32x32x16_bf16(kf[0],qr[0],negm,0,0,0), P0[2],P0[3],P0[4],P0[5],     pw0[0]=PKW(P0,0), pw0[1]=PKW(P0,2), pw0); \
    VRD(4); SBAR(); GAPA(C1=__builtin_amdgcn_mfma_f32_32x32x16_bf16(kf[1],qr[0],negm,0,0,0), P0[6],P0[7],P0[8],P0[9],     pw0[2]=PKW(P0,4), pw0[3]=PKW(P0,6), pw0); \
    VRD(1); SBAR(); GAPA(C0=__builtin_amdgcn_mfma_f32_32x32x16_bf16(kf[2],qr[1],C0,0,0,0),   P0[10],P0[11],P0[12],P0[13], pw1[0]=PKW(P0,8), pw1[1]=PKW(P0,10), pw1); \
    VRD(5); SBAR(); GAPA(C1=__builtin_amdgcn_mfma_f32_32x32x16_bf16(kf[3],qr[1],C1,0,0,0),   P0[14],P0[15],P1[0],P1[1],   pw1[2]=PKW(P0,12),pw1[3]=PKW(P0,14), pw1); \
    VRD(2); SBAR(); GAPA(C0=__builtin_amdgcn_mfma_f32_32x32x16_bf16(kf[4],qr[2],C0,0,0,0),   P1[2],P1[3],P1[4],P1[5],     pw2[0]=PKW(P1,0), pw2[1]=PKW(P1,2), pw2); \
    VRD(6); SBAR(); GAPA(C1=__builtin_amdgcn_mfma_f32_32x32x16_bf16(kf[5],qr[2],C1,0,0,0),   P1[6],P1[7],P1[8],P1[9],     pw2[2]=PKW(P1,4), pw2[3]=PKW(P1,6), pw2); \
    VRD(3); SBAR(); GAPA(C0=__builtin_amdgcn_mfma_f32_32x32x16_bf16(kf[6],qr[3],C0,0,0,0),   P1[10],P1[11],P1[12],P1[13], pw3[0]=PKW(P1,8), pw3[1]=PKW(P1,10), pw3); \
    VRD(7); SBAR(); GAPA(C1=__builtin_amdgcn_mfma_f32_32x32x16_bf16(kf[7],qr[3],C1,0,0,0),   P1[14],P1[15],0.f,0.f,       pw3[2]=PKW(P1,12),pw3[3]=PKW(P1,14), pw3); \
    l_reg+=sacc; \
    if(GM){DMA_M((t)+2,sl_prev);} if(GK){DMA_K((t)+3,sl_cur);} if(GV){DMA_V((t)+1,sl_next);} \
    if(BND){ if((t)>=NT-6) BAND(C0,C1,t); } \
    MASKLD(sl_cur); \
    SBAR(); \
    GAPB(o[0]=__builtin_amdgcn_mfma_f32_32x32x16_bf16(PAF(0),VFR(0),o[0],0,0,0), C0,0,m0); \
    GAPB(o[1]=__builtin_amdgcn_mfma_f32_32x32x16_bf16(PAF(0),VFR(4),o[1],0,0,0), C0,4,m0); \
    KRD(GL,0); GAPB(o[0]=__builtin_amdgcn_mfma_f32_32x32x16_bf16(PAF(1),VFR(1),o[0],0,0,0), C0,8,m0); \
    KRD(GL,1); GAPB(o[1]=__builtin_amdgcn_mfma_f32_32x32x16_bf16(PAF(1),VFR(5),o[1],0,0,0), C0,12,m0); \
    KRD(GL,2); GAPB(o[0]=__builtin_amdgcn_mfma_f32_32x32x16_bf16(PAF(2),VFR(2),o[0],0,0,0), C1,0,m1); \
    KRD(GL,3); GAPB(o[1]=__builtin_amdgcn_mfma_f32_32x32x16_bf16(PAF(2),VFR(6),o[1],0,0,0), C1,4,m1); \
    GAPB(o[0]=__builtin_amdgcn_mfma_f32_32x32x16_bf16(PAF(3),VFR(3),o[0],0,0,0), C1,8,m1); \
    GAPB(o[1]=__builtin_amdgcn_mfma_f32_32x32x16_bf16(PAF(3),VFR(7),o[1],0,0,0), C1,12,m1); \
    }while(0)
  int t=1;
  for(;t+7<NT;t+=2){
    STEP(pB0,pB1,pA0,pA1,t,true,true,true,true,false);     WAIT_BAR(3); ROT();
    STEP(pA0,pA1,pB0,pB1,t+1,true,true,true,true,false);   WAIT_BAR(3); ROT();
  }
  #define ENDW(tt) do{ if((tt)+3<NT){WAIT_BAR(3);} else if((tt)+2<NT){WAIT_BAR(2);} else {WAIT_BAR(0);} }while(0)
  for(;t+1<NT;t+=2){
    STEP(pB0,pB1,pA0,pA1,t,(t+3<NT),(t+1<NT),(t+1<NT),(t+2<NT),true);       ENDW(t);   ROT();
    STEP(pA0,pA1,pB0,pB1,t+1,(t+4<NT),(t+2<NT),(t+2<NT),(t+3<NT),true);     ENDW(t+1); ROT();
  }
  STEP(pB0,pB1,pA0,pA1,NT-1,false,false,false,false,true);
  { float sacc=pB0[0]+pB0[1]; _Pragma("unroll") for(int r=2;r<16;++r)sacc+=pB0[r]; _Pragma("unroll") for(int r=0;r<16;++r)sacc+=pB1[r]; l_reg+=sacc;
    pw0=(u32x4){PKW(pB0,0),PKW(pB0,2),PKW(pB0,4),PKW(pB0,6)};pw1=(u32x4){PKW(pB0,8),PKW(pB0,10),PKW(pB0,12),PKW(pB0,14)};pw2=(u32x4){PKW(pB1,0),PKW(pB1,2),PKW(pB1,4),PKW(pB1,6)};pw3=(u32x4){PKW(pB1,8),PKW(pB1,10),PKW(pB1,12),PKW(pB1,14)};
    SBAR(); pv(o,vb0+sl_cur,PAF(0),PAF(1),PAF(2),PAF(3)); }
  #undef PKW
  #undef PAF
  #undef VFR
  #undef PIN
  #undef MX3
  #undef GAPA
  #undef GAPB
  #undef EX
  #undef VRD
  #undef KRD
  #undef STEP
  #undef ENDW
  {auto rr=__builtin_amdgcn_permlane32_swap(__float_as_uint(l_reg),__float_as_uint(l_reg),false,false);l_reg=__uint_as_float(rr[0])+__uint_as_float(rr[1]);}
  if(hi==0)wsf[32+r32]=l_reg;asm volatile("s_waitcnt lgkmcnt(0)":::"memory");
  float rli[16];
  #pragma unroll
  for(int r=0;r<16;++r)rli[r]=__builtin_amdgcn_rcpf(wsf[32+crow(r,hi)]);
  bf16*Ow=O+(rowbase+q0+wid*QBLK)*DM+h*D;
  { bf16*stg=(bf16*)(shm+LDS_OST)+wid*2048;
    #pragma unroll
    for(int r=0;r<16;++r){const int orow=crow(r,hi);
      #pragma unroll
      for(int d0=0;d0<2;++d0)stg[orow*64+d0*32+r32]=__float2bfloat16(o[d0][r]*rli[r]);}
    asm volatile("s_waitcnt lgkmcnt(0)":::"memory");
    #pragma unroll
    for(int i=0;i<4;++i){const int row=i*8+(lane>>3),ch=lane&7; const u32x4 v=*(const u32x4*)(stg+row*64+ch*8); ATTN_STORE16(Ow+(long)row*DM+ch*8,v);} }
  asm volatile("s_waitcnt lgkmcnt(0)\n\ts_barrier":::"memory");
  #undef DMA_K
  #undef DMA_V
  #undef DMA_M
  #undef MASKLD
  #undef MBIT
  #undef MAND
  #undef MANDA
  #undef BAND
  #undef ROT
}
constexpr int ATTN_LDS_BYTES=LDS_BYTES;
__device__ __forceinline__ int t5b(int d){ if(d<16)return d; int b=16; b+=d>=19;b+=d>=21;b+=d>=24;b+=d>=27;b+=d>=31;b+=d>=35;b+=d>=40;b+=d>=46;b+=d>=52;b+=d>=59;b+=d>=67;b+=d>=77;b+=d>=87;b+=d>=99;b+=d>=113; return b; }
__device__ __forceinline__ void attn_phase(char*lds,const bf16*Q,const bf16*K,const bf16*V,bf16*O,const unsigned char*maskT,const float*relb,int vcu,const int wid){
  const int h=vcu>>5, s_=vcu&31;
  const int tid_=wid*64+lane_now();
  if(tid_<128){ const int d=tid_; ((float*)(lds+LDS_BT))[d]=(relb[t5b(d)*NHEAD+h]-relb[31*NHEAD+h])*1.4426950408889634f; }
  asm volatile("s_waitcnt vmcnt(0) lgkmcnt(0)\n\ts_barrier":::"memory");
  if(wid>=4)__builtin_amdgcn_s_setprio(1);
  _Pragma("unroll 1") for(int i=0;i<2;++i) attn_unit(h,i?s_:63-s_,Q,K,V,O,maskT,lds,wid);
  __builtin_amdgcn_s_setprio(0);
}
#undef SBAR
#undef WAIT_BAR
}

static_assert(pg8::EpiMix::GUARD_LDS == (unsigned)(MISC_OFF + 44) && pg8::EpiMix::GUARD_DELTA == (long)(CW_BAR + XB_DONE2) * 4 - (long)CTL_SS2, "EpiMix guard constants");
__global__ void __launch_bounds__(NWAVES * 64, 2) __attribute__((target("no-packed-fp32-ops"))) mega_fwd(Args args) {
    extern __shared__ __attribute__((aligned(16))) unsigned char lds[];
    Frame F;
    F.lds = (LAS unsigned char*)lds;
    F.MISC = (volatile LAS unsigned*)(F.lds + MISC_OFF);
    F.wave = __builtin_amdgcn_readfirstlane((int)threadIdx.x >> 6);
#define RETID() do { F.lane = lane_now(); F.tid = F.wave * 64 + F.lane; } while (0)
    RETID();
    F.G = gridDim.x; { const int bx = blockIdx.x; F.vcu = (F.G % 8 == 0) ? (bx % 8) * (F.G / 8) + bx / 8 : bx; }
    F.ctl = (gu32*)(kargs()->ws + WS_CTL);
    for (int u = F.tid; u < (LDS_BYTES - LDSCTL_OFF) / 4; u += NWAVES * 64) ((LAS unsigned*)(F.lds + LDSCTL_OFF))[u] = 0u;
    __syncthreads();
    const int lo = kargs()->ph_lo, hi = kargs()->ph_hi;
    const bool multi = (hi - lo) > 1;
    XcdBarrier bar; bar.bar = (unsigned*)(F.ctl + CW_BAR); bar.x = 0; bar.st = nullptr;
    if (multi) bar = xcd_barrier_post((unsigned*)(F.ctl + CW_BAR), F.MISC + 8, F.tid);
#ifndef PHMASK
#define PHMASK 0x7ff
#endif
#define IN(k) (((PHMASK >> (k)) & 1) && lo <= (k) && (k) < hi)
#define SEAM(k) do { if (IN(k) && IN((k) + 1)) { RETID(); xcd_barrier(bar, F.tid); } RETID(); } while (0)
#define SEAMS(k) do { if (IN(k) && IN((k) + 1)) { RETID(); if (F.MISC[10] != 0u) xcd_barrier<false>(bar, F.tid); else xcd_barrier(bar, F.tid); } RETID(); } while (0)
#define SEAML(k) do { if (IN(k) && IN((k) + 1)) { RETID(); if (F.MISC[10] != 0u) xcd_local_barrier<((k) == 6 ? XB_DONE6 : (k) == 2 ? XB_DONE2 : -1)>(bar, F.tid); else xcd_barrier(bar, F.tid); } RETID(); } while (0)
#define WSP unsigned char* ws = kargs()->ws
#define BFP(off) ((pg8::bf16_t*)(ws + (off)))
#define CBFP(off) ((const pg8::bf16_t*)(ws + (off)))
#define SSP(off) ((float*)(ws + WS_CTL + (off)))
    const int cidx = (int)blockIdx.x;

#ifndef REP_P0
#define REP_P0 1
#endif
#ifndef REP_G1
#define REP_G1 1
#endif
    if (IN(0)) { for (int rep = 0; rep < REP_P0; ++rep) p0_prologue(F, kargs()); }
    if (multi && F.tid == 0) F.ctl[CW_BAR + XB_TAB + cidx] = 1u + xb_xcc_id();
    SEAM(0);
    if (multi && F.tid < 32) { const unsigned t_ = F.ctl[CW_BAR + XB_TAB + 8 * F.tid + (cidx & 7)]; if (t_ != 1u + xb_xcc_id() || gridDim.x != 256u) atomicOr((unsigned*)&F.ctl[CW_BAR + XB_NONLOCAL], 1u); }
    if (IN(1)) for (int rep = 0; rep < REP_G1; ++rep) { WSP; pg8::Gemm g{CBFP(WS_HB), CBFP(WS_W1IN), M, 2 * DFF, D}; pg8::StaticOrder S; S.init(M, 2 * DFF, F.G, cidx);
        pg8::EpiSwiglu E{BFP(WS_ACT), SSP(CTL_SS1)}; pg8::gemm_phase<pg8::EpiSwiglu, pg8::StaticOrder, true, true>(F.lds + RING_OFF, g, S, E, F.wave); }
    if (IN(1)) { if (cidx >= 128 && F.G == 256) { RETID(); p0_weights(F, kargs(), P0_I0, P0_LATE_END, (cidx - 128) * NWAVES + F.wave, 128 * NWAVES); }
                 else if (F.G != 256) { RETID(); p0_weights(F, kargs(), P0_I0, P0_LATE_END, F.vcu * NWAVES + F.wave, F.G * NWAVES); } } SEAM(1);
    if (multi) { if (F.tid == 0) { const unsigned lok_ = (xb_ld((unsigned*)&F.ctl[CW_BAR + XB_NONLOCAL]) == 0u) ? 1u : 0u; F.MISC[10] = lok_; F.MISC[11] = 1u - lok_; } __syncthreads(); }
    else { if (F.tid == 0) F.MISC[11] = 1u; __syncthreads(); }
    if (IN(2)) { WSP; pg8::Gemm g{CBFP(WS_ACT), CBFP(WS_W1OUT), M, D, DFF}; pg8::StaticOrder S; S.init(M, D, F.G, cidx);
        pg8::EpiRes E{kargs()->in[0], kargs()->out, BFP(WS_HB), SSP(CTL_SS2), 0.5f}; pg8::gemm_phase<pg8::EpiRes, pg8::StaticOrder, true, true>(F.lds + RING_OFF, g, S, E, F.wave); } SEAML(2);
    if (IN(3)) { WSP; pg8::Gemm g{CBFP(WS_HB), CBFP(WS_WMIX), M, NMIXP, D}; pg8::StaticOrder S; S.init(M, NMIXP, F.G, cidx);
        pg8::EpiMix E{SSP(CTL_SS2), (pg8::bf16_t*)(ws + WS_GLU), (pg8::bf16_t*)(ws + WS_Q), (pg8::bf16_t*)(ws + WS_K), (pg8::bf16_t*)(ws + WS_V), (pg8::bf16_t*)(ws + WS_QI), (pg8::bf16_t*)(ws + WS_KI),
                      (float*)(ws + WS_WI), (pg8::bf16_t*)(ws + WS_GC), (pg8::bf16_t*)(ws + WS_GA), kargs()->in[12], kargs()->in[13]};
        pg8::gemm_phase<pg8::EpiMix, pg8::StaticOrder, true, true>(F.lds + RING_OFF, g, S, E, F.wave); } SEAM(3);
#ifndef REP_CONV
#define REP_CONV 1
#endif
#ifndef REP_IDX
#define REP_IDX 1
#endif
#ifndef REP_ATT
#define REP_ATT 1
#endif
    if (IN(4)) { for (int rep = 0; rep < REP_CONV; ++rep) conv_phase(F, kargs()); for (int rep = 0; rep < REP_IDX; ++rep) indexer_fast(F, kargs()); } SEAM(4);
    if (IN(5)) { for (int rep = 0; rep < REP_ATT; ++rep) { unsigned char* ws = kargs()->ws; attn_body::attn_phase((char*)lds + RING_OFF, (const attn_body::bf16*)(ws + WS_Q), (const attn_body::bf16*)(ws + WS_K), (const attn_body::bf16*)(ws + WS_V), (attn_body::bf16*)(ws + WS_ATT), ws + WS_MASK, kargs()->in[22], F.vcu, F.wave); } __syncthreads();
        WSP; pg8::Gemm g{CBFP(WS_ZC), CBFP(WS_WCO), M, D, CCH}; pg8::StaticOrder S; S.init(M, D, F.G, cidx);
        pg8::EpiGate<0> E{(pg8::bf16_t*)(ws + WS_GC), nullptr}; pg8::gemm_phase<pg8::EpiGate<0>, pg8::StaticOrder, true, true>(F.lds + RING_OFF, g, S, E, F.wave); } SEAM(5);
    if (IN(6)) { WSP; pg8::Gemm g{CBFP(WS_ATT), CBFP(WS_WAO), M, D, AW}; pg8::StaticOrder S; S.init(M, D, F.G, cidx);
        pg8::EpiGate<1> E{(pg8::bf16_t*)(ws + WS_GC), (const pg8::bf16_t*)(ws + WS_GA)}; pg8::gemm_phase<pg8::EpiGate<1>, pg8::StaticOrder, true, true>(F.lds + RING_OFF, g, S, E, F.wave); } SEAML(6);
    if (IN(7)) { convert_p(F, kargs()); WSP; pg8::Gemm g{CBFP(WS_GC), CBFP(WS_WMO), M, D, D}; pg8::StaticOrder S; S.init(M, D, F.G, cidx);
        pg8::EpiRes E{kargs()->out, kargs()->out, BFP(WS_HB), SSP(CTL_SS3), 1.0f}; pg8::gemm_phase<pg8::EpiRes, pg8::StaticOrder, true, true>(F.lds + RING_OFF, g, S, E, F.wave); } SEAML(7);
    if (IN(8) && multi && F.MISC[10] != 0u) { if (F.tid == 0) { unsigned* bar_ = (unsigned*)(F.ctl + CW_BAR); XB_SPIN(xb_ld(&bar_[XB_DONE6]) < F.MISC[9], bar_); } __syncthreads(); }
    if (IN(8)) {
        WSP; pg8::Gemm g{CBFP(WS_HB), CBFP(WS_W2IN), M, 2 * DFF, D}; pg8::StaticOrder S; S.init(M, 2 * DFF, F.G, cidx);
        pg8::EpiSwiglu E{BFP(WS_ACT), SSP(CTL_SS3)}; pg8::gemm_phase<pg8::EpiSwiglu, pg8::StaticOrder, true, true>(F.lds + RING_OFF, g, S, E, F.wave); }
    if (IN(8) && cidx >= 128) {
        WSP; pg8::Gemm g{CBFP(WS_PB), CBFP(WS_WPP), M, D, PLE}; pg8::StaticOrder S; S.init(M, D, 128, cidx - 128);
        pg8::EpiGate<2> E{(pg8::bf16_t*)(ws + WS_PROJ), nullptr}; pg8::gemm_phase<pg8::EpiGate<2>, pg8::StaticOrder, true, true>(F.lds + RING_OFF, g, S, E, F.wave);
    } SEAML(8);
    if (IN(9)) { WSP; pg8::Gemm g{CBFP(WS_ACT), CBFP(WS_W2OUT), M, D, DFF}; pg8::StaticOrder S; S.init(M, D, F.G, cidx);
        pg8::EpiRes E{kargs()->out, kargs()->out, BFP(WS_HB), SSP(CTL_SS4), 0.5f}; pg8::gemm_phase<pg8::EpiRes, pg8::StaticOrder, true, true>(F.lds + RING_OFF, g, S, E, F.wave); }
    SEAML(9);
    if (IN(10)) {
        { WSP; pg8::Gemm g{CBFP(WS_HB), CBFP(WS_WPG), M, D, D}; pg8::StaticOrder S; S.init(M, D, F.G, cidx);
          pg8::EpiPle E{kargs()->out, CBFP(WS_PROJ), SSP(CTL_SS4)}; pg8::gemm_phase<pg8::EpiPle, pg8::StaticOrder, true, true>(F.lds + RING_OFF, g, S, E, F.wave); }
    }
#ifdef DIAG_TIME
    if (IN(10) && blockIdx.x == 0 && F.tid == 0) { const unsigned long long* ts = (const unsigned long long*)(kargs()->ws + WS_CTL + 16384);
        kargs()->out[0] += 25.0f * floorf((float)(ts[DIAG_TIME + 1] - ts[DIAG_TIME]) * 0.01f / 25.0f + 0.5f); }
#endif
#ifdef DIAG_OVF
    if (IN(10) && blockIdx.x == 0 && F.tid == 0) { const unsigned* dg = (const unsigned*)(kargs()->ws + WS_CTL) + 2048; const unsigned v = __hip_atomic_load(dg + (DIAG_OVF & 3), __ATOMIC_RELAXED, __HIP_MEMORY_SCOPE_AGENT);
        kargs()->out[0] += (float)((DIAG_OVF & 4) ? (v & 0xffffu) : ((DIAG_OVF & 8) ? (v >> 16) : v)); }
#endif
#undef IN
#undef SEAM
#undef SEAML
#undef SEAMS
}

extern "C" void kernel_launch(void* const* d_in, const int* in_sizes, int n_in, void* d_out, int out_size, void* d_ws, size_t ws_size, hipStream_t stream) {
    static int grid = 0;
    if (grid == 0) {
        if (n_in != 23 || out_size != M * D || ws_size < WS_END) { fprintf(stderr, "kernel_launch: unexpected shapes n_in %d out %d ws %zu\n", n_in, out_size, ws_size); grid = -1; return; }
        int dev = 0, cus = 0;
        if (hipGetDevice(&dev) != hipSuccess || hipDeviceGetAttribute(&cus, hipDeviceAttributeMultiprocessorCount, dev) != hipSuccess) { grid = -1; return; }
        if (hipFuncSetAttribute((const void*)mega_fwd, hipFuncAttributeMaxDynamicSharedMemorySize, LDS_BYTES) != hipSuccess) { fprintf(stderr, "kernel_launch: hipFuncSetAttribute failed\n"); grid = -1; return; }
        int per_cu = 0;
        if (hipOccupancyMaxActiveBlocksPerMultiprocessor(&per_cu, (const void*)mega_fwd, NWAVES * 64, LDS_BYTES) != hipSuccess || per_cu < 1) fprintf(stderr, "kernel_launch: occupancy query says %d\n", per_cu);
        (void)hipGetLastError();
        grid = cus;
        if (grid != 256) fprintf(stderr, "kernel_launch: %d CUs (built for 256)\n", grid);
    }
    if (grid < 0) return;
    (void)hipMemsetAsync((char*)d_ws + WS_CTL, 0, CTL_ZERO_BYTES, stream);
    Args a{};
    for (int i = 0; i < 23; ++i) a.in[i] = (const float*)d_in[i];
    a.out = (float*)d_out; a.ws = (unsigned char*)d_ws;
    if (N_LAUNCHES == 1) {
        a.ph_lo = 0; a.ph_hi = NPHASE; a.li = 0;
        hipLaunchKernelGGL(mega_fwd, dim3(grid), dim3(NWAVES * 64), LDS_BYTES, stream, a);
    } else {
        for (int li = 0; li < NPHASE; ++li) { a.ph_lo = li; a.ph_hi = li + 1; a.li = li;
            hipLaunchKernelGGL(mega_fwd, dim3(grid), dim3(NWAVES * 64), LDS_BYTES, stream, a); }
    }
}
```

```cpp
#include <hip/hip_runtime.h>
#include <cstdio>
#include <cstdint>
__device__ __forceinline__ void mk_syncthreads() { __builtin_amdgcn_fence(__ATOMIC_RELEASE, "workgroup"); __builtin_amdgcn_s_barrier(); __builtin_amdgcn_fence(__ATOMIC_ACQUIRE, "workgroup"); }
#define __syncthreads() mk_syncthreads()
__device__ __forceinline__ int lane_now() { int l = (int)__builtin_amdgcn_mbcnt_hi(~0u, __builtin_amdgcn_mbcnt_lo(~0u, 0u)); asm volatile("" : "+v"(l)); return l; }
namespace pg8 {
#define PG8_LAS __attribute__((address_space(3)))
typedef unsigned short bf16_t;
typedef short bf16x8 __attribute__((ext_vector_type(8)));
typedef float f32x4 __attribute__((ext_vector_type(4)));
typedef unsigned u32x4 __attribute__((ext_vector_type(4)));
constexpr int BM = 256, BK = 64, HALF = 128, HTB = HALF * BK * 2  , STAGE_BYTES = 8 * HTB, NXCD = 8, WGM = 8;

__host__ __device__ __forceinline__ int lds_byte(int r, int c) { const int st = (r >> 4) * 2 + (c >> 5), rr = r & 15, cc = c & 31, ob = rr * 64 + cc * 2; return st * 1024 + (ob ^ (((ob >> 9) & 1) << 5)); }
__host__ __device__ __forceinline__ void stage_rc(int b, int& R, int& C) { const int st = b / 1024, sb = b % 1024, swz = sb ^ (((sb >> 9) & 1) << 5); R = (st >> 1) * 16 + swz / 64; C = (st & 1) * 32 + (swz % 64) / 2; }
__host__ __device__ __forceinline__ int perm32(int rho) { const int n = rho >> 4, i = rho & 15; return 8 * (i >> 2) + 4 * n + (i & 3); }

struct Unit { int pm, pn; };
struct Gemm { const bf16_t* A; const bf16_t* Bt; int M, N, K; };

struct StaticOrder {
    int nM, nN, nwg, G, c;
    __host__ __device__ __forceinline__ void init(int M, int N, int G_, int c_) { nM = M / BM; nN = N / BM; nwg = nM * nN; G = G_; c = c_; }
    __host__ __device__ bool next(int i, Unit& u) const {
        const long L = (long)i * G + c; if (L >= nwg) return false;
        int wgid = (int)L; { const int q = nwg / NXCD, r = nwg % NXCD, xcd = wgid % NXCD, off = wgid / NXCD; wgid = (xcd < r ? xcd * (q + 1) : r * (q + 1) + (xcd - r) * q) + off; }
        const int nig = WGM * nN, gid = wgid / nig, fm = gid * WGM, gsz = (nM - fm) < WGM ? (nM - fm) : WGM;
        u.pm = fm + ((wgid % nig) % gsz); u.pn = (wgid % nig) / gsz; return true;
    }
    __device__ __forceinline__ void a_ready(const Unit&) const {}
    __device__ __forceinline__ void done(const Unit&) const {}
};

typedef float cvt_f32x2 __attribute__((ext_vector_type(2)));
typedef __bf16 cvt_bf16x2 __attribute__((ext_vector_type(2)));
__device__ __forceinline__ unsigned cvt_pk_bf16(float lo, float hi) { const cvt_bf16x2 v = __builtin_convertvector((cvt_f32x2){lo, hi}, cvt_bf16x2); return __builtin_bit_cast(unsigned, v); }
typedef float f32x2 __attribute__((ext_vector_type(2)));
typedef _Float16 f16x2 __attribute__((ext_vector_type(2)));
constexpr float NORM_EPS = 1e-6f;
constexpr float Q_C2 = 0.125f * 1.4426950408889634f;
__device__ __forceinline__ float bf_lo(unsigned w) { return __uint_as_float(w << 16); }
__device__ __forceinline__ float bf_hi(unsigned w) { return __uint_as_float(w & 0xffff0000u); }
__device__ __forceinline__ float sigm(float x) { return __builtin_amdgcn_rcpf(1.f + __builtin_amdgcn_exp2f(-1.4426950408889634f * x)); }
__device__ __forceinline__ u32x4 pack8(f32x4 a, f32x4 b) { u32x4 w; w.x = cvt_pk_bf16(a[0], a[1]); w.y = cvt_pk_bf16(a[2], a[3]); w.z = cvt_pk_bf16(b[0], b[1]); w.w = cvt_pk_bf16(b[2], b[3]); return w; }
__device__ __forceinline__ unsigned pkh(float lo, float hi) { f16x2 v = __builtin_convertvector((f32x2){lo, hi}, f16x2); return __builtin_bit_cast(unsigned, v); }
__device__ __forceinline__ u32x4 pack8h(f32x4 a, f32x4 b) { u32x4 w; w.x = pkh(a[0], a[1]); w.y = pkh(a[2], a[3]); w.z = pkh(b[0], b[1]); w.w = pkh(b[2], b[3]); return w; }
__device__ __forceinline__ float row_rs(const float* ss, int row) { return __builtin_amdgcn_rsqf((float)((const unsigned long long*)ss)[row] * (1.0f / (1024.0f * 1048576.0f)) + NORM_EPS); }
__device__ __forceinline__ f32x4 unpk_lo(u32x4 g) { return (f32x4){bf_lo(g.x), bf_hi(g.x), bf_lo(g.y), bf_hi(g.y)}; }
__device__ __forceinline__ f32x4 unpk_hi(u32x4 g) { return (f32x4){bf_lo(g.z), bf_hi(g.z), bf_lo(g.w), bf_hi(g.w)}; }

struct EpiSwiglu {
    static constexpr bool PERM = true, AFTER_DRAIN = false;
    bf16_t* O; const float* ss;
    __device__ __forceinline__ void operator()(const f32x4 (&acc)[2][2][4][2], const Unit& u, int wr, int wc, int fr, int fq) const {
        const int row0 = u.pm * BM + wr * 64 + fr, col0 = u.pn * HALF + wc * 32 + 8 * fq;
#pragma unroll
        for (int ai = 0; ai < 2; ++ai)
#pragma unroll
            for (int m = 0; m < 4; ++m) { const int row = row0 + ai * HALF + m * 16; const float rs = row_rs(ss, row); f32x4 o[2];
#pragma unroll
                for (int n = 0; n < 2; ++n) { const f32x4 a = acc[ai][0][m][n] * rs, b = acc[ai][1][m][n] * rs;
#pragma unroll
                    for (int e = 0; e < 4; ++e) o[n][e] = a[e] * sigm(a[e]) * b[e]; }
                *(u32x4*)(O + (size_t)row * 2816 + col0) = pack8(o[0], o[1]); }
    }
};
struct EpiRes {
    static constexpr bool PERM = true, AFTER_DRAIN = false;
    const float* base; float* out; bf16_t* hb; float* ssq; float alpha;
    __device__ __forceinline__ void operator()(const f32x4 (&acc)[2][2][4][2], const Unit& u, int wr, int wc, int fr, int fq) const {
        const int row0 = u.pm * BM + wr * 64 + fr, col0 = u.pn * BM + wc * 32 + 8 * fq;
#pragma unroll
        for (int ai = 0; ai < 2; ++ai)
#pragma unroll
            for (int m = 0; m < 4; ++m) { const int row = row0 + ai * HALF + m * 16; float q = 0.f;
#pragma unroll
                for (int bj = 0; bj < 2; ++bj) { const size_t off = (size_t)row * 1024 + col0 + bj * HALF;
                    const f32x4 x0 = *(const f32x4*)(base + off), x1 = *(const f32x4*)(base + off + 4);
                    const f32x4 h0 = x0 + acc[ai][bj][m][0] * alpha, h1 = x1 + acc[ai][bj][m][1] * alpha;
                    *(f32x4*)(out + off) = h0; *(f32x4*)(out + off + 4) = h1; *(u32x4*)(hb + off) = pack8(h0, h1);
                    q += (h0[0] * h0[0] + h0[1] * h0[1]) + (h0[2] * h0[2] + h0[3] * h0[3]) + (h1[0] * h1[0] + h1[1] * h1[1]) + (h1[2] * h1[2] + h1[3] * h1[3]); }
                q += __shfl_xor(q, 16); q += __shfl_xor(q, 32);
                if (fq == 0) atomicAdd((unsigned long long*)ssq + row, (unsigned long long)(q * 1048576.0f)); }
    }
};
struct EpiMix {
    static constexpr bool PERM = true, AFTER_DRAIN = false;
    const float* ss; bf16_t *GLU, *Q, *K, *V, *QI, *KI; float* WI; bf16_t *GC, *GA; const float *qn, *kn;
    static constexpr unsigned GUARD_LDS = 131072 + 320 + 44;
    static constexpr long GUARD_DELTA = (4096 + 6080) * 4 - 196608;
    __device__ __forceinline__ void operator()(const f32x4 (&acc)[2][2][4][2], const Unit& u, int wr, int wc, int fr, int fq) const {
        { volatile PG8_LAS unsigned* lflag = (volatile PG8_LAS unsigned*)GUARD_LDS;
          if (*lflag == 0u) {
              if (wr == 0 && wc == 0 && fr == 0 && fq == 0) { unsigned* gd = (unsigned*)((char*)ss + GUARD_DELTA); const unsigned need = lflag[-2]; unsigned sp = 0u;
                  while (__hip_atomic_load(gd, __ATOMIC_RELAXED, __HIP_MEMORY_SCOPE_AGENT) < need && ++sp < (1u << 22)) __builtin_amdgcn_s_sleep(1);
                  *lflag = 1u; }
              while (*lflag == 0u) __builtin_amdgcn_s_sleep(1); } }
        const int row0 = u.pm * BM + wr * 64 + fr, cw = wc * 32 + 8 * fq, pn = u.pn;
        if (pn < 4) {
#pragma unroll
            for (int ai = 0; ai < 2; ++ai)
#pragma unroll
                for (int m = 0; m < 4; ++m) { const int row = row0 + ai * HALF + m * 16; const float rs = row_rs(ss, row); f32x4 o[2];
#pragma unroll
                    for (int n = 0; n < 2; ++n) { const f32x4 a = acc[ai][0][m][n] * rs, g = acc[ai][1][m][n] * rs;
#pragma unroll
                        for (int e = 0; e < 4; ++e) o[n][e] = a[e] * sigm(g[e]); }
                    *(u32x4*)(GLU + (size_t)row * 512 + pn * HALF + cw) = pack8(o[0], o[1]); }
        } else if (pn < 8) {
            const bool isq = pn < 6; const int head = 4 * ((pn - 4) & 1) + wc; const float* gn = isq ? qn : kn; bf16_t* dst = isq ? Q : K; const float post = isq ? Q_C2 : 1.0f;
            f32x4 g[2][2];
#pragma unroll
            for (int bj = 0; bj < 2; ++bj)
#pragma unroll
                for (int n = 0; n < 2; ++n) g[bj][n] = *(const f32x4*)(gn + 32 * bj + 8 * fq + 4 * n);
#pragma unroll
            for (int ai = 0; ai < 2; ++ai)
#pragma unroll
                for (int m = 0; m < 4; ++m) { const int row = row0 + ai * HALF + m * 16; const float rs = row_rs(ss, row); f32x4 v[2][2]; float s = 0.f;
#pragma unroll
                    for (int bj = 0; bj < 2; ++bj)
#pragma unroll
                        for (int n = 0; n < 2; ++n) { v[bj][n] = acc[ai][bj][m][n] * rs; const f32x4 t = v[bj][n]; s += (t[0] * t[0] + t[1] * t[1]) + (t[2] * t[2] + t[3] * t[3]); }
                    s += __shfl_xor(s, 16); s += __shfl_xor(s, 32);
                    const float rn = __builtin_amdgcn_rsqf(s * (1.0f / 64.0f) + NORM_EPS) * post;
#pragma unroll
                    for (int bj = 0; bj < 2; ++bj) *(u32x4*)(dst + (size_t)row * 512 + 64 * head + 32 * bj + 8 * fq) = pack8(v[bj][0] * rn * g[bj][0], v[bj][1] * rn * g[bj][1]); }
        } else if (pn < 10) {
#pragma unroll
            for (int ai = 0; ai < 2; ++ai)
#pragma unroll
                for (int m = 0; m < 4; ++m) { const int row = row0 + ai * HALF + m * 16; const float rs = row_rs(ss, row);
#pragma unroll
                    for (int bj = 0; bj < 2; ++bj) *(u32x4*)(V + (size_t)row * 512 + (pn - 8) * BM + bj * HALF + cw) = pack8(acc[ai][bj][m][0] * rs, acc[ai][bj][m][1] * rs); }
        } else if (pn == 10) {
#pragma unroll
            for (int ai = 0; ai < 2; ++ai)
#pragma unroll
                for (int m = 0; m < 4; ++m) { const int row = row0 + ai * HALF + m * 16; const float rs = row_rs(ss, row);
#pragma unroll
                    for (int bj = 0; bj < 2; ++bj) *(u32x4*)(QI + (size_t)row * 256 + bj * HALF + cw) = pack8h(acc[ai][bj][m][0] * rs, acc[ai][bj][m][1] * rs); }
        } else if (pn == 11) {
#pragma unroll
            for (int ai = 0; ai < 2; ++ai)
#pragma unroll
                for (int m = 0; m < 4; ++m) { const int row = row0 + ai * HALF + m * 16; const float rs = row_rs(ss, row);
                    if (wc < 2) *(u32x4*)(KI + (size_t)row * 64 + cw) = pack8h(acc[ai][0][m][0] * rs, acc[ai][0][m][1] * rs);
                    else if (wc == 2 && fq == 0) *(f32x4*)(WI + (size_t)row * 4) = acc[ai][0][m][0] * (rs * 0.0625f); }
        } else {
            bf16_t* dst = pn < 16 ? GC : GA; const int ct = (pn < 16 ? pn - 12 : pn - 16) * BM;
#pragma unroll
            for (int ai = 0; ai < 2; ++ai)
#pragma unroll
                for (int m = 0; m < 4; ++m) { const int row = row0 + ai * HALF + m * 16; const float rs = row_rs(ss, row);
#pragma unroll
                    for (int bj = 0; bj < 2; ++bj) { f32x4 o[2];
#pragma unroll
                        for (int n = 0; n < 2; ++n)
#pragma unroll
                            for (int e = 0; e < 4; ++e) o[n][e] = sigm(acc[ai][bj][m][n][e] * rs);
                        *(u32x4*)(dst + (size_t)row * 1024 + ct + bj * HALF + cw) = pack8(o[0], o[1]); } }
        }
    }
};
template <int MODE> struct EpiGate {
    static constexpr bool PERM = true, AFTER_DRAIN = false;
    bf16_t* T; const bf16_t* GA;
    __device__ __forceinline__ void operator()(const f32x4 (&acc)[2][2][4][2], const Unit& u, int wr, int wc, int fr, int fq) const {
        const int row0 = u.pm * BM + wr * 64 + fr, col0 = u.pn * BM + wc * 32 + 8 * fq;
#pragma unroll
        for (int ai = 0; ai < 2; ++ai)
#pragma unroll
            for (int m = 0; m < 4; ++m) { const int row = row0 + ai * HALF + m * 16;
#pragma unroll
                for (int bj = 0; bj < 2; ++bj) { const size_t off = (size_t)row * 1024 + col0 + bj * HALF; f32x4 o0, o1;
                    if (MODE == 0) { const u32x4 g = *(const u32x4*)(T + off); o0 = unpk_lo(g) * acc[ai][bj][m][0]; o1 = unpk_hi(g) * acc[ai][bj][m][1]; }
                    else if (MODE == 1) { const u32x4 t = *(const u32x4*)(T + off); const u32x4 g = *(const u32x4*)(GA + off); o0 = unpk_lo(t) + unpk_lo(g) * acc[ai][bj][m][0]; o1 = unpk_hi(t) + unpk_hi(g) * acc[ai][bj][m][1]; }
                    else { o0 = acc[ai][bj][m][0]; o1 = acc[ai][bj][m][1]; }
                    *(u32x4*)(T + off) = pack8(o0, o1); } }
    }
};
struct EpiPle {
    static constexpr bool PERM = true, AFTER_DRAIN = false;
    float* out; const bf16_t* P; const float* ss;
    __device__ __forceinline__ void operator()(const f32x4 (&acc)[2][2][4][2], const Unit& u, int wr, int wc, int fr, int fq) const {
        const int row0 = u.pm * BM + wr * 64 + fr, col0 = u.pn * BM + wc * 32 + 8 * fq;
#pragma unroll
        for (int ai = 0; ai < 2; ++ai)
#pragma unroll
            for (int m = 0; m < 4; ++m) { const int row = row0 + ai * HALF + m * 16; const float rs = row_rs(ss, row);
#pragma unroll
                for (int bj = 0; bj < 2; ++bj) { const size_t off = (size_t)row * 1024 + col0 + bj * HALF;
                    const u32x4 pr = *(const u32x4*)(P + off); const f32x4 p0 = unpk_lo(pr), p1 = unpk_hi(pr);
                    f32x4 h0 = *(const f32x4*)(out + off), h1 = *(const f32x4*)(out + off + 4);
#pragma unroll
                    for (int e = 0; e < 4; ++e) { h0[e] += sigm(acc[ai][bj][m][0][e] * rs) * p0[e]; h1[e] += sigm(acc[ai][bj][m][1][e] * rs) * p1[e]; }
                    *(f32x4*)(out + off) = h0; *(f32x4*)(out + off + 4) = h1; }
                asm volatile("" ::: "memory"); }
    }
};

template <class Epi, class Sched, bool ALIGN_EPI = false, bool SP2 = false>
__device__ __forceinline__ void gemm_phase(PG8_LAS unsigned char* lds, const Gemm g, const Sched& S, const Epi& E, const int wid) {
    const int lane = lane_now(), tid = wid * 64 + lane, wr = wid >> 2, wc = wid & 3, fr = lane & 15, fq = lane >> 4;
    int K = g.K; asm volatile("" : "+s"(K));
    const int nt = K / BK;
    unsigned voffA[2], voffB[2];
#pragma unroll
    for (int i = 0; i < 2; ++i) { int R, C; stage_rc(tid * 16 + i * 8192, R, C); const int Rb = Epi::PERM ? ((R & ~31) + perm32(R & 31)) : R;
        voffA[i] = (unsigned)(R * K + C) * 2u; voffB[i] = (unsigned)(Rb * K + C) * 2u; }
    const size_t kstep = (size_t)(BK * 2);
    const size_t hstep = (size_t)HALF * K * 2;
    const size_t tstep = 2 * hstep;
    const unsigned ldsw = (unsigned)wid * 1024u;
    const int aoff = lds_byte(wr * 64 + fr, fq * 8), boff = lds_byte(wc * 32 + fr, fq * 8);
#define PG8_SA(b, h) (((b) * 2 + (h)) * HTB)
#define PG8_SB(b, h) ((4 + (b) * 2 + (h)) * HTB)
#define PG8_STAGE(bufoff, gbase, voff) do { _Pragma("unroll") for (int _i = 0; _i < 2; ++_i) \
        __builtin_amdgcn_global_load_lds((const unsigned*)((const char*)(gbase) + (voff)[_i]), (PG8_LAS unsigned*)(lds + (bufoff) + ldsw + _i * 8192), 16, 0, 0); } while (0)
#define PG8_LDA(dst, b, h) do { _Pragma("unroll") for (int m = 0; m < 4; ++m) _Pragma("unroll") for (int k = 0; k < 2; ++k) dst[m][k] = *(const PG8_LAS bf16x8*)(lds + PG8_SA(b, h) + aoff + m * 2048 + k * 1024); } while (0)
#define PG8_LDB(dst, b, h) do { _Pragma("unroll") for (int n = 0; n < 2; ++n) _Pragma("unroll") for (int k = 0; k < 2; ++k) dst[n][k] = *(const PG8_LAS bf16x8*)(lds + PG8_SB(b, h) + boff + n * 2048 + k * 1024); } while (0)
#define PG8_MMA(ai, bj, At, Bt) do { __builtin_amdgcn_s_setprio(1); _Pragma("unroll") for (int m = 0; m < 4; ++m) _Pragma("unroll") for (int n = 0; n < 2; ++n) _Pragma("unroll") for (int k = 0; k < 2; ++k) \
        acc[ai][bj][m][n] = __builtin_amdgcn_mfma_f32_16x16x32_bf16(Bt[n][k], At[m][k], acc[ai][bj][m][n], 0, 0, 0); __builtin_amdgcn_s_setprio(0); } while (0)
#define PG8_WAIT_V(n) asm volatile("s_waitcnt vmcnt(" #n ")" ::: "memory")
#define PG8_WAIT_L(n) asm volatile("s_waitcnt lgkmcnt(" #n ")" ::: "memory")
#define PG8_BAR __builtin_amdgcn_s_barrier()
#define PG8_SCHED __builtin_amdgcn_sched_barrier(0)
    Unit cur, nxt; int ui = 0;
    if (!S.next(0, cur)) return;
    f32x4 acc[2][2][4][2];
#pragma unroll
    for (int a = 0; a < 2; ++a)
#pragma unroll
        for (int b = 0; b < 2; ++b)
#pragma unroll
            for (int m = 0; m < 4; ++m)
#pragma unroll
                for (int n = 0; n < 2; ++n) acc[a][b][m][n] = (f32x4){0.f, 0.f, 0.f, 0.f};
    bf16x8 At[4][2], B0[2][2], B1[2][2];
    const char* cA = (const char*)g.A + (size_t)cur.pm * tstep; const char* cB = (const char*)g.Bt + (size_t)cur.pn * tstep;
    S.a_ready(cur);
    if constexpr (SP2) {
        PG8_STAGE(PG8_SB(0, 0), cB, voffB); PG8_STAGE(PG8_SB(0, 1), cB + hstep, voffB); PG8_STAGE(PG8_SA(0, 0), cA, voffA); PG8_STAGE(PG8_SA(0, 1), cA + hstep, voffA);
        if (wr == 1) PG8_BAR;
        PG8_WAIT_V(2); PG8_BAR;
        PG8_STAGE(PG8_SB(1, 0), cB + kstep, voffB); PG8_STAGE(PG8_SA(1, 0), cA + kstep, voffA); PG8_STAGE(PG8_SB(1, 1), cB + hstep + kstep, voffB);
        PG8_WAIT_V(6); PG8_BAR;
    } else {
        PG8_STAGE(PG8_SB(0, 0), cB, voffB); PG8_STAGE(PG8_SA(0, 0), cA, voffA); PG8_STAGE(PG8_SB(0, 1), cB + hstep, voffB); PG8_STAGE(PG8_SA(0, 1), cA + hstep, voffA);
        if (wr == 1) PG8_BAR;
        PG8_WAIT_V(4); PG8_BAR;
        PG8_STAGE(PG8_SB(1, 0), cB + kstep, voffB); PG8_STAGE(PG8_SA(1, 0), cA + kstep, voffA); PG8_STAGE(PG8_SB(1, 1), cB + hstep + kstep, voffB);
        PG8_WAIT_V(6); PG8_BAR;
    }
    for (;;) {
        const bool has_next = S.next(ui + 1, nxt);
        const char* nA = has_next ? (const char*)g.A + (size_t)nxt.pm * tstep : cA; const char* nB = has_next ? (const char*)g.Bt + (size_t)nxt.pn * tstep : cB;
        for (int t = 0; t < nt; t += 2) {
            const bool last = (t == nt - 2);
            const char* a1 = cA + (size_t)(t + 1) * kstep;
            const char* a2 = last ? nA : cA + (size_t)(t + 2) * kstep; const char* b2 = last ? nB : cB + (size_t)(t + 2) * kstep;
            const char* a3 = a2 + kstep; const char* b3 = b2 + kstep;
            if (last && has_next) S.a_ready(nxt);
            if constexpr (SP2) {
            PG8_LDB(B0, 0, 0); PG8_LDB(B1, 0, 1); PG8_SCHED; PG8_LDA(At, 0, 0); PG8_STAGE(PG8_SA(1, 1), a1 + hstep, voffA);
            PG8_WAIT_V(8); PG8_WAIT_L(0); PG8_BAR; PG8_MMA(0, 0, At, B0); PG8_MMA(0, 1, At, B1); PG8_BAR; PG8_SCHED;
            PG8_LDA(At, 0, 1); PG8_STAGE(PG8_SB(0, 0), b2, voffB); PG8_STAGE(PG8_SB(0, 1), b2 + hstep, voffB); PG8_STAGE(PG8_SA(0, 0), a2, voffA);
            PG8_WAIT_V(8); PG8_WAIT_L(0); PG8_BAR; PG8_MMA(1, 0, At, B0); PG8_MMA(1, 1, At, B1); PG8_BAR; PG8_SCHED;
            PG8_LDB(B0, 1, 0); PG8_LDB(B1, 1, 1); PG8_SCHED; PG8_LDA(At, 1, 0); PG8_STAGE(PG8_SA(0, 1), a2 + hstep, voffA);
            PG8_WAIT_V(8); PG8_WAIT_L(0); PG8_BAR; PG8_MMA(0, 0, At, B0); PG8_MMA(0, 1, At, B1); PG8_BAR; PG8_SCHED;
            PG8_LDA(At, 1, 1); PG8_STAGE(PG8_SB(1, 0), b3, voffB); PG8_STAGE(PG8_SB(1, 1), b3 + hstep, voffB); PG8_STAGE(PG8_SA(1, 0), a3, voffA);
            PG8_WAIT_V(8); PG8_WAIT_L(0); PG8_BAR; PG8_MMA(1, 0, At, B0); PG8_MMA(1, 1, At, B1); PG8_BAR; PG8_SCHED;
            } else {
            PG8_LDB(B0, 0, 0); PG8_SCHED; PG8_LDA(At, 0, 0); PG8_STAGE(PG8_SA(1, 1), a1 + hstep, voffA);
            PG8_WAIT_L(8); PG8_BAR; PG8_WAIT_L(0); PG8_MMA(0, 0, At, B0); PG8_BAR; PG8_SCHED;
            PG8_LDB(B1, 0, 1); PG8_STAGE(PG8_SB(0, 0), b2, voffB);
            PG8_BAR; PG8_WAIT_L(0); PG8_MMA(0, 1, At, B1); PG8_BAR;
            PG8_LDA(At, 0, 1); PG8_STAGE(PG8_SA(0, 0), a2, voffA);
            PG8_BAR; PG8_WAIT_L(0); PG8_MMA(1, 0, At, B0); PG8_BAR; PG8_SCHED;
            PG8_STAGE(PG8_SB(0, 1), b2 + hstep, voffB);
            PG8_WAIT_V(6); PG8_BAR; PG8_MMA(1, 1, At, B1); PG8_BAR;
            PG8_LDB(B0, 1, 0); PG8_SCHED; PG8_LDA(At, 1, 0); PG8_STAGE(PG8_SA(0, 1), a2 + hstep, voffA);
            PG8_WAIT_L(8); PG8_BAR; PG8_WAIT_L(0); PG8_MMA(0, 0, At, B0); PG8_BAR; PG8_SCHED;
            PG8_LDB(B1, 1, 1); PG8_STAGE(PG8_SB(1, 0), b3, voffB);
            PG8_BAR; PG8_WAIT_L(0); PG8_MMA(0, 1, At, B1); PG8_BAR;
            PG8_LDA(At, 1, 1); PG8_STAGE(PG8_SA(1, 0), a3, voffA);
            PG8_BAR; PG8_WAIT_L(0); PG8_MMA(1, 0, At, B0); PG8_BAR; PG8_SCHED;
            PG8_STAGE(PG8_SB(1, 1), b3 + hstep, voffB);
            PG8_WAIT_V(6); PG8_BAR; PG8_MMA(1, 1, At, B1); PG8_BAR;
            }
        }
        if constexpr (ALIGN_EPI) { if (wr == 0) PG8_BAR; }
        if constexpr (!Epi::AFTER_DRAIN) { E(acc, cur, wr, wc, fr, fq); S.done(cur); }
        if (!has_next) break;
#pragma unroll
        for (int a = 0; a < 2; ++a)
#pragma unroll
            for (int b = 0; b < 2; ++b)
#pragma unroll
                for (int m = 0; m < 4; ++m)
#pragma unroll
                    for (int n = 0; n < 2; ++n) acc[a][b][m][n] = (f32x4){0.f, 0.f, 0.f, 0.f};
        cur = nxt; cA = nA; cB = nB; ++ui;
        if constexpr (ALIGN_EPI) { if (wr == 1) PG8_BAR; }
    }
    PG8_WAIT_V(0);
    if constexpr (!ALIGN_EPI) { if (wr == 0) PG8_BAR; }
    PG8_BAR;
    if constexpr (Epi::AFTER_DRAIN) { E.fused(acc, cur, wr, wc, fr, fq, lds, wid, lane); S.done(cur); }
#undef PG8_SA
#undef PG8_SB
#undef PG8_STAGE
#undef PG8_LDA
#undef PG8_LDB
#undef PG8_MMA
#undef PG8_WAIT_V
#undef PG8_WAIT_L
#undef PG8_BAR
#undef PG8_SCHED
}
}
constexpr int NWAVES = 8;
constexpr int NPHASE = 11;
#ifndef MK_N_LAUNCHES
#define MK_N_LAUNCHES 1
#endif
constexpr int N_LAUNCHES = MK_N_LAUNCHES;

constexpr int M = 16384, D = 1024, DFF = 2816, NMIXP = 5120, CCH = 512, AW = 512, NH = 8, HD = 64, PLE = 256, CONVW = 31;
constexpr float EPS = 1e-6f;
constexpr float LOG2E = 1.4426950408889634f;

constexpr size_t MiB = 1u << 20;
constexpr size_t WS_CTL = 0, CTL_ZERO_BYTES = 1 * MiB;
constexpr size_t WS_W1IN = 1 * MiB;
constexpr size_t WS_W1OUT = 12 * MiB;
constexpr size_t WS_WMIX = 18 * MiB;
constexpr size_t WS_WCO = 28 * MiB;
constexpr size_t WS_WAO = 29 * MiB;
constexpr size_t WS_WMO = 30 * MiB;
constexpr size_t WS_W2IN = 32 * MiB;
constexpr size_t WS_W2OUT = 43 * MiB;
constexpr size_t WS_WPG = 49 * MiB;
constexpr size_t WS_WPP = 51 * MiB;
constexpr size_t WS_HB = 52 * MiB;
constexpr size_t WS_MASK = WS_HB;
constexpr size_t WS_ACT = 84 * MiB;
constexpr size_t WS_GLU = WS_ACT;
constexpr size_t WS_ATT = WS_ACT;
constexpr size_t WS_Q = WS_ACT + 16 * MiB, WS_K = WS_ACT + 32 * MiB, WS_V = WS_ACT + 48 * MiB;
constexpr size_t WS_QI = WS_ACT + 64 * MiB;
constexpr size_t WS_KI = WS_ACT + 72 * MiB;
constexpr size_t WS_WI = WS_ACT + 74 * MiB;
constexpr size_t WS_GC = 172 * MiB;
constexpr size_t WS_GA = 204 * MiB;
constexpr size_t WS_PB = 236 * MiB;
constexpr size_t WS_PROJ = WS_GA;
constexpr size_t WS_ZC = 236 * MiB;
constexpr size_t WS_END = 252 * MiB;
constexpr int CW_TMO = 0, CW_CODE = 1;
constexpr int CW_BAR = 4096;
constexpr size_t CTL_SS1 = 64 * 1024, CTL_SS2 = 192 * 1024, CTL_SS3 = 320 * 1024, CTL_SS4 = 448 * 1024;

constexpr int RING_OFF = 0, RING_BYTES = 131072;
constexpr int LDSCTL_OFF = RING_BYTES, MISC_OFF = LDSCTL_OFF + 320;
constexpr int LDS_BYTES = 147456;

#define GAS __attribute__((address_space(1)))
#define LAS __attribute__((address_space(3)))
typedef unsigned short bf16;
typedef unsigned v4u __attribute__((ext_vector_type(4)));
typedef float f32x4 __attribute__((ext_vector_type(4)));
typedef short bf16x8 __attribute__((ext_vector_type(8)));
typedef GAS unsigned gu32;
typedef GAS unsigned long long gu64;
#define RLX_AGENT __ATOMIC_RELAXED, __HIP_MEMORY_SCOPE_AGENT
#define LDS_WAIT() asm volatile("s_waitcnt lgkmcnt(0)" ::: "memory")
#define VM_WAIT() asm volatile("s_waitcnt vmcnt(0)" ::: "memory")
__device__ __forceinline__ unsigned long long rt() { return __builtin_amdgcn_s_memrealtime(); }
__device__ __forceinline__ unsigned f2bf(float f) { unsigned u = __builtin_bit_cast(unsigned, f); return (u + 0x7fffu + ((u >> 16) & 1u)) >> 16; }
__device__ __forceinline__ unsigned pk2(float lo, float hi) { return f2bf(lo) | (f2bf(hi) << 16); }

#define XB_TMO      128
#define XB_XCNT(j)  (256  + 64 * (j))
#define XB_XSUB(j)  (1280 + 64 * (j))
#define XB_XGEN(j)  (2304 + 64 * (j))
#define XB_TOP      3328
#define XB_TOPGEN   3392
#define XCD_BAR_WORDS 3456
#define XB_LSUB(j)  (3520 + 64 * (j))
#define XB_LGEN(j)  (4544 + 64 * (j))
#define XB_TAB      5632
#define XB_DONE2    6080
#define XB_DONE6    6016
#define XB_NONLOCAL 5952
#define XB_SPIN_CAP (1u << 18)

__device__ __forceinline__ unsigned xb_ld(unsigned* p)              { return __hip_atomic_load(p, __ATOMIC_RELAXED, __HIP_MEMORY_SCOPE_AGENT); }
__device__ __forceinline__ unsigned xb_add(unsigned* p, unsigned v) { return __hip_atomic_fetch_add(p, v, __ATOMIC_RELAXED, __HIP_MEMORY_SCOPE_AGENT); }
__device__ __forceinline__ unsigned xb_xcc_id() { return (unsigned)__builtin_amdgcn_s_getreg((3 << 11) | 20) & 0xFu; }
#define XB_SPIN(cond, bar) do { unsigned _sp = 0; while (cond) { __builtin_amdgcn_s_sleep(1); \
    if ((++_sp & 255u) == 0u) { if (xb_ld(&(bar)[XB_TMO])) break; if (_sp > XB_SPIN_CAP) { atomicAdd(&(bar)[XB_TMO], 1u); break; } } } } while (0)

struct XcdBarrier {
    unsigned* bar; unsigned x;
    volatile LAS unsigned* st;
};

__device__ __forceinline__ XcdBarrier xcd_barrier_post(unsigned* bar, volatile LAS unsigned* st, const int tid) {
    XcdBarrier b; b.bar = bar; b.x = xb_xcc_id(); b.st = st;
    if (tid == 0) (void)xb_add(&bar[XB_XCNT(b.x)], 1u);
    return b;
}
__device__ __forceinline__ void xcd_barrier_complete(unsigned* bar, unsigned x, unsigned& nloc, unsigned& nx) {
    const unsigned G = gridDim.x * gridDim.y * gridDim.z;
    unsigned sum, cnt, mine, sp = 0u;
    for (;;) {
        sum = 0u; cnt = 0u; mine = 0u;
#pragma unroll
        for (unsigned j = 0; j < 16; ++j) { const unsigned c = xb_ld(&bar[XB_XCNT(j)]); sum += c; cnt += (c > 0u) ? 1u : 0u; mine = (j == x) ? c : mine; }
        if (sum == G) break;
        __builtin_amdgcn_s_sleep(1);
        if ((++sp & 255u) == 0u) { if (xb_ld(&bar[XB_TMO])) break; if (sp > XB_SPIN_CAP) { atomicAdd(&bar[XB_TMO], 1u); break; } }
    }
    nloc = mine > 0u ? mine : 1u; nx = cnt > 0u ? cnt : 1u;
}

template <bool FLUSH = true>
__device__ __forceinline__ void xcd_barrier(const XcdBarrier& b, const int tid) {
    asm volatile("s_waitcnt vmcnt(0)" ::: "memory");
    __syncthreads();
    if (tid == 0) {
        unsigned* bar = b.bar;
        __builtin_amdgcn_s_waitcnt(0);
        unsigned nloc = b.st[0], nx = b.st[1];
        if (nloc == 0u) { xcd_barrier_complete(bar, b.x, nloc, nx); b.st[0] = nloc; b.st[1] = nx; }
        const unsigned old = xb_add(&bar[XB_XSUB(b.x)], 1u);
        const unsigned gen = old / nloc;
        if (old + 1u == (gen + 1u) * nloc) {
            if (FLUSH) __builtin_amdgcn_fence(__ATOMIC_RELEASE, "agent");
            asm volatile("s_waitcnt vmcnt(0)" ::: "memory");
            const unsigned og = xb_add(&bar[XB_TOP], 1u);
            const unsigned tg = og / nx;
            __builtin_amdgcn_fence(__ATOMIC_ACQUIRE, "agent");
            if (og + 1u == (tg + 1u) * nx) xb_add(&bar[XB_TOPGEN], 1u);
            else XB_SPIN(xb_ld(&bar[XB_TOPGEN]) == tg, bar);
            xb_add(&bar[XB_XGEN(b.x)], 1u);
            asm volatile("s_waitcnt vmcnt(0)" ::: "memory");
        } else {
            __builtin_amdgcn_fence(__ATOMIC_ACQUIRE, "agent");
            XB_SPIN(xb_ld(&bar[XB_XGEN(b.x)]) == gen, bar);
            asm volatile("s_waitcnt vmcnt(0)" ::: "memory");
        }
    }
    __syncthreads();
}

template <int POST = -1>
__device__ __forceinline__ void xcd_local_barrier(const XcdBarrier& b, const int tid) {
    asm volatile("s_waitcnt vmcnt(0)" ::: "memory");
    __syncthreads();
    if (tid == 0) {
        unsigned* bar = b.bar;
        __builtin_amdgcn_s_waitcnt(0);
        const unsigned nloc = b.st[0];
        const unsigned old = xb_add(&bar[XB_LSUB(b.x)], 1u);
        const unsigned gen = old / nloc;
        __builtin_amdgcn_fence(__ATOMIC_ACQUIRE, "agent");
        if (old + 1u == (gen + 1u) * nloc) { xb_add(&bar[XB_LGEN(b.x)], 1u); if (POST >= 0) xb_add(&bar[POST], 1u); }
        else XB_SPIN(xb_ld(&bar[XB_LGEN(b.x)]) == gen, bar);
        asm volatile("s_waitcnt vmcnt(0)" ::: "memory");
    }
    __syncthreads();
}

struct Frame {
    LAS unsigned char* lds;
    volatile LAS unsigned* MISC;
    gu32* ctl;
    int tid, lane, wave;
    int vcu, G;
};
__device__ __forceinline__ float wave_sum(float v) {
#pragma unroll
    for (int o = 1; o < 64; o <<= 1) v += __shfl_xor(v, o);
    return v;
}
__device__ __forceinline__ float wave_max(float v) {
#pragma unroll
    for (int o = 1; o < 64; o <<= 1) v = fmaxf(v, __shfl_xor(v, o));
    return v;
}
__device__ __forceinline__ float bflo(unsigned w) { return __uint_as_float(w << 16); }
__device__ __forceinline__ float bfhi(unsigned w) { return __uint_as_float(w & 0xffff0000u); }
__device__ __forceinline__ float sigm_f(float x) { return __builtin_amdgcn_rcpf(1.f + __builtin_amdgcn_exp2f(-LOG2E * x)); }

__device__ __forceinline__ int wmap(int kind, int n0, int& nv) {
    nv = 32;
    if (kind == 0) return n0;
    const int T = n0 >> 8, rem = n0 & 255;
    if (kind == 1) return (rem >> 7) * DFF + 128 * T + (rem & 127);
    if (T < 4) return (rem >> 7) * 512 + 128 * T + (rem & 127);
    if (T < 8) { const int base = T < 6 ? 1024 : 1536, Tq = (T - 4) & 1, bj = rem >> 7, wc = (rem & 127) >> 5; return base + 64 * (4 * Tq + wc) + 32 * bj; }
    if (T < 10) return 2048 + 256 * (T - 8) + rem;
    if (T == 10) return 2560 + rem;
    if (T == 11) { if (rem < 64) return 2816 + rem; if (rem == 64) { nv = 4; return 2880; } nv = 0; return 0; }
    return 2884 + 256 * (T - 12) + rem;
}
__device__ __forceinline__ void p0_transpose_item(const float* W, int K, int Nsrc, bf16* WT, int ng, int kind, const float* gain, LAS float* scr, int item, int lane) {
    const int kb = item / ng, nb = item % ng, k0 = 64 * kb, n0 = 32 * nb;
    int nv; const int sc = wmap(kind, n0, nv);
    const int n4 = 4 * (lane & 7), kr = lane >> 3;
    const bool ok = n4 < nv;
#pragma unroll
    for (int i = 0; i < 8; ++i) { const int kk = 8 * i + kr;
        f32x4 v = ok ? *(const GAS f32x4*)(W + (size_t)(k0 + kk) * Nsrc + sc + n4) : (f32x4){0.f, 0.f, 0.f, 0.f};
        if (gain) v = v * gain[k0 + kk];
        *(LAS f32x4*)(scr + kk * 36 + n4) = v; }
    LDS_WAIT(); asm volatile("" ::: "memory");
    const int c = lane & 7;
#pragma unroll
    for (int j = 0; j < 4; ++j) { const int n = (lane >> 3) + 8 * j; const LAS float* s = scr + (8 * c) * 36 + n;
        v4u o; o.x = pk2(s[0 * 36], s[1 * 36]); o.y = pk2(s[2 * 36], s[3 * 36]); o.z = pk2(s[4 * 36], s[5 * 36]); o.w = pk2(s[6 * 36], s[7 * 36]);
        *(GAS v4u*)(WT + (size_t)(n0 + n) * K + k0 + 8 * c) = o; }
    LDS_WAIT(); asm volatile("" ::: "memory");
}
struct Args { const float* in[23]; float* out; unsigned char* ws; int ph_lo, ph_hi, li, pad; };
typedef const __attribute__((address_space(4))) Args* KArgs;
__device__ __forceinline__ KArgs kargs() { KArgs p = (KArgs)__builtin_amdgcn_kernarg_segment_ptr(); asm volatile("" : "+s"(p)); return p; }

constexpr int P0_I0 = 16 * 176, P0_LATE_END = P0_I0 + 44 * 32 + 16 * 160 + 8 * 32 + 8 * 32 + 16 * 32;
__device__ __forceinline__ void p0_weights(Frame& F, KArgs A, const int it_lo, const int it_hi, const int gw, const int NGW) {
    LAS float* scr = (LAS float*)(F.lds + RING_OFF + F.wave * 16384);
    unsigned char* ws = A->ws;
    constexpr int I0 = 16 * 176, I1 = 44 * 32, I2 = 16 * 160, I3 = 8 * 32, I4 = 8 * 32, I5 = 16 * 32, I6 = 16 * 176, I7 = 44 * 32, I8 = 16 * 32, I9 = 4 * 32;
    constexpr int NITEMS = I0 + I1 + I2 + I3 + I4 + I5 + I6 + I7 + I8 + I9;
    static_assert(I0 == P0_I0, "");
    const int hi_ = it_hi < 0 ? NITEMS : it_hi;
    for (int it = it_lo + gw; it < hi_; it += NGW) {
        int r = it;
        if (r < I0) { p0_transpose_item(A->in[3], 1024, 5632, (bf16*)(ws + WS_W1IN), 176, 1, A->in[2], scr, r, F.lane); continue; } r -= I0;
        if (r < I1) { p0_transpose_item(A->in[4], 2816, 1024, (bf16*)(ws + WS_W1OUT), 32, 0, nullptr, scr, r, F.lane); continue; } r -= I1;
        if (r < I2) { p0_transpose_item(A->in[6], 1024, 4932, (bf16*)(ws + WS_WMIX), 160, 2, A->in[5], scr, r, F.lane); continue; } r -= I2;
        if (r < I3) { p0_transpose_item(A->in[11], 512, 1024, (bf16*)(ws + WS_WCO), 32, 0, nullptr, scr, r, F.lane); continue; } r -= I3;
        if (r < I4) { p0_transpose_item(A->in[14], 512, 1024, (bf16*)(ws + WS_WAO), 32, 0, nullptr, scr, r, F.lane); continue; } r -= I4;
        if (r < I5) { p0_transpose_item(A->in[15], 1024, 1024, (bf16*)(ws + WS_WMO), 32, 0, nullptr, scr, r, F.lane); continue; } r -= I5;
        if (r < I6) { p0_transpose_item(A->in[17], 1024, 5632, (bf16*)(ws + WS_W2IN), 176, 1, A->in[16], scr, r, F.lane); continue; } r -= I6;
        if (r < I7) { p0_transpose_item(A->in[18], 2816, 1024, (bf16*)(ws + WS_W2OUT), 32, 0, nullptr, scr, r, F.lane); continue; } r -= I7;
        if (r < I8) { p0_transpose_item(A->in[20], 1024, 1024, (bf16*)(ws + WS_WPG), 32, 0, A->in[19], scr, r, F.lane); continue; } r -= I8;
        p0_transpose_item(A->in[21], 256, 1024, (bf16*)(ws + WS_WPP), 32, 0, nullptr, scr, r, F.lane);
    }
}
__device__ __forceinline__ void p0_prologue(Frame& F, KArgs A) {
    const int gw = F.vcu * NWAVES + F.wave, NGW = F.G * NWAVES;
    unsigned char* ws = A->ws;
    p0_weights(F, A, 0, P0_I0, gw, NGW);
    p0_weights(F, A, P0_LATE_END, -1, gw, NGW);
    const float* x = A->in[0]; bf16* xb = (bf16*)(ws + WS_HB); float* ss1 = (float*)(ws + WS_CTL + CTL_SS1);
    for (int m = gw; m < M; m += NGW) {
        const GAS f32x4* xr = (const GAS f32x4*)(x + (size_t)m * D) + F.lane;
        f32x4 v[4]; float s = 0.f;
#pragma unroll
        for (int j = 0; j < 4; ++j) { v[j] = xr[64 * j]; s += (v[j].x * v[j].x + v[j].y * v[j].y) + (v[j].z * v[j].z + v[j].w * v[j].w); }
        s = wave_sum(s);
        if (F.lane == 0) ((unsigned long long*)ss1)[m] = (unsigned long long)(s * 1048576.0f);
        GAS unsigned long long* o8 = (GAS unsigned long long*)(xb + (size_t)m * D) + F.lane;
#pragma unroll
        for (int j = 0; j < 4; ++j) o8[64 * j] = (unsigned long long)pk2(v[j].x, v[j].y) | ((unsigned long long)pk2(v[j].z, v[j].w) << 32);
    }
}
__device__ __forceinline__ void convert_p(Frame& F, KArgs A) {
    const float* p = A->in[1]; bf16* pb = (bf16*)(A->ws + WS_PB);
    const int g = F.vcu >> 5, gtl = (F.vcu & 31) * (NWAVES * 64) + F.tid;
    for (int k = 0; k < 4; ++k) { const int i = 65536 * g + gtl + 16384 * k;
        const f32x4 a = *(const GAS f32x4*)(p + (size_t)i * 8), b = *(const GAS f32x4*)(p + (size_t)i * 8 + 4);
        v4u o; o.x = pk2(a.x, a.y); o.y = pk2(a.z, a.w); o.z = pk2(b.x, b.y); o.w = pk2(b.z, b.w);
        *(GAS v4u*)(pb + (size_t)i * 8) = o;
    }
}

__device__ __forceinline__ void conv_phase(Frame& F, KArgs A) {
    const bf16* glu = (const bf16*)(A->ws + WS_GLU); bf16* zc = (bf16*)(A->ws + WS_ZC);
    const float* dw = A->in[7]; const float* db = A->in[8]; const float* lg = A->in[9]; const float* lb = A->in[10];
    LAS unsigned char* L = F.lds; constexpr int WT_OFF = 0, GL_OFF = 63488;
    const int tid = F.tid, lane = F.lane, wv = F.wave, c0 = 8 * lane;
    __syncthreads();
    for (int i = tid; i < CONVW * 128; i += NWAVES * 64) { const int w = i >> 7, q4 = i & 127;
        *(LAS f32x4*)(L + WT_OFF + ((q4 & 1) * CONVW + w) * 1024 + (q4 >> 1) * 16) = *(const GAS f32x4*)(dw + w * CCH + 4 * q4); }
    const f32x4 b0 = *(const GAS f32x4*)(db + c0), b1 = *(const GAS f32x4*)(db + c0 + 4);
    const f32x4 g0 = *(const GAS f32x4*)(lg + c0), g1 = *(const GAS f32x4*)(lg + c0 + 4);
    const f32x4 e0 = *(const GAS f32x4*)(lb + c0), e1 = *(const GAS f32x4*)(lb + c0 + 4);
    for (int bt = 0; bt < 2; ++bt) {
        const int t0 = 64 * F.vcu + 32 * bt;
        __syncthreads();
        for (int i = tid; i < 62 * 64; i += NWAVES * 64) { const int r = i >> 6, tt = t0 - 30 + r;
            *(LAS v4u*)(L + GL_OFF + i * 16) = tt >= 0 ? *(const GAS v4u*)(glu + (size_t)tt * CCH + 8 * (i & 63)) : (v4u){0u, 0u, 0u, 0u}; }
        __syncthreads();
        f32x4 a0[4], a1[4];
#pragma unroll
        for (int r = 0; r < 4; ++r) { a0[r] = b0; a1[r] = b1; }
#pragma unroll 4
        for (int w = 0; w < CONVW; ++w) {
            const f32x4 w0 = *(const LAS f32x4*)(L + WT_OFF + w * 1024 + lane * 16), w1 = *(const LAS f32x4*)(L + WT_OFF + (CONVW + w) * 1024 + lane * 16);
#pragma unroll
            for (int r = 0; r < 4; ++r) { const v4u z = *(const LAS v4u*)(L + GL_OFF + ((4 * wv + r + w) * 64 + lane) * 16);
                a0[r] += (f32x4){bflo(z.x), bfhi(z.x), bflo(z.y), bfhi(z.y)} * w0; a1[r] += (f32x4){bflo(z.z), bfhi(z.z), bflo(z.w), bfhi(z.w)} * w1; } }
#pragma unroll
        for (int r = 0; r < 4; ++r) { const int t = t0 + 4 * wv + r; f32x4 x0 = a0[r], x1 = a1[r];
            const float mean = wave_sum((x0.x + x0.y) + (x0.z + x0.w) + (x1.x + x1.y) + (x1.z + x1.w)) * (1.0f / CCH);
            x0 = x0 - mean; x1 = x1 - mean;
            const float var = wave_sum((x0.x * x0.x + x0.y * x0.y) + (x0.z * x0.z + x0.w * x0.w) + (x1.x * x1.x + x1.y * x1.y) + (x1.z * x1.z + x1.w * x1.w)) * (1.0f / CCH);
            const float rstd = __builtin_amdgcn_rsqf(var + EPS);
            f32x4 y0 = x0 * rstd * g0 + e0, y1 = x1 * rstd * g1 + e1;
#pragma unroll
            for (int e = 0; e < 4; ++e) { y0[e] = y0[e] * sigm_f(y0[e]); y1[e] = y1[e] * sigm_f(y1[e]); }
            v4u o; o.x = pk2(y0.x, y0.y); o.y = pk2(y0.z, y0.w); o.z = pk2(y1.x, y1.y); o.w = pk2(y1.z, y1.w);
            *(GAS v4u*)(zc + (size_t)t * CCH + c0) = o; }
    }
    __syncthreads();
}

__device__ __forceinline__ unsigned ordkey(float s) { unsigned u = __float_as_uint(s); if (s == 0.f) u = 0u; return (u & 0x80000000u) ? ~u : (u | 0x80000000u); }
__device__ __forceinline__ float h2f(unsigned short h) { return (float)__builtin_bit_cast(_Float16, h); }

__device__ __forceinline__ void indexer_simple(Frame& F, KArgs A) {
    const unsigned short* QI = (const unsigned short*)(A->ws + WS_QI); const unsigned short* KI = (const unsigned short*)(A->ws + WS_KI); const float* WI = (const float*)(A->ws + WS_WI);
    unsigned* mask32 = (unsigned*)(A->ws + WS_MASK);
    LAS unsigned* skey = (LAS unsigned*)(F.lds);
    LAS float* qif = (LAS float*)(F.lds + 65536);
    LAS unsigned* hist = (LAS unsigned*)(F.lds + 65536 + 1024);
    LAS unsigned* cnt = (LAS unsigned*)(F.lds + 65536 + 2048);
    LAS unsigned* wtot = (LAS unsigned*)(F.lds + 65536 + 4096);
    LAS unsigned* res = (LAS unsigned*)(F.lds + 65536 + 4160);
    const int tid = F.tid, lane = F.lane, wv = F.wave, w = (int)blockIdx.x;
    for (int jj = 0; jj < 64; ++jj) {
        const int j = jj >> 1; const int t = 512 * j + ((jj & 1) ? (511 - w) : w);
        const int n = t + 1;
        __syncthreads();
        if (tid < 256) qif[tid] = h2f(QI[(size_t)t * 256 + tid]);
        const f32x4 w4 = *(const GAS f32x4*)(WI + (size_t)t * 4);
        __syncthreads();
        for (int s = tid; s < n; s += 512) {
            float dot[4] = {0.f, 0.f, 0.f, 0.f};
#pragma unroll 1
            for (int c = 0; c < 8; ++c) { asm volatile("" ::: "memory"); const v4u kv = *(const GAS v4u*)(KI + (size_t)s * 64 + 8 * c);
                const unsigned kw[4] = {kv.x, kv.y, kv.z, kv.w};
#pragma unroll
                for (int e = 0; e < 4; ++e) { const float k0 = h2f((unsigned short)(kw[e] & 0xffffu)), k1 = h2f((unsigned short)(kw[e] >> 16));
#pragma unroll
                    for (int h = 0; h < 4; ++h) { dot[h] += k0 * qif[64 * h + 8 * c + 2 * e]; dot[h] += k1 * qif[64 * h + 8 * c + 2 * e + 1]; } } }
            float sc = w4.x * fmaxf(dot[0], 0.f); sc += w4.y * fmaxf(dot[1], 0.f); sc += w4.z * fmaxf(dot[2], 0.f); sc += w4.w * fmaxf(dot[3], 0.f);
            skey[s] = ordkey(sc);
        }
        __syncthreads();
        unsigned T = 0u, r = 0u;
        if (n > 256) {
            unsigned prefix = 0u, pmask = 0u, remaining = 256u;
            for (int pass = 0; pass < 4; ++pass) { const int shift = 24 - 8 * pass;
                if (tid < 256) hist[tid] = 0u;
                __syncthreads();
                for (int s = tid; s < n; s += 512) { const unsigned k = skey[s]; if ((k & pmask) == prefix) __hip_atomic_fetch_add(&hist[(k >> shift) & 255u], 1u, __ATOMIC_RELAXED, __HIP_MEMORY_SCOPE_WORKGROUP); }
                __syncthreads();
                if (wv == 0) {
                    const unsigned c0 = hist[4 * lane], c1 = hist[4 * lane + 1], c2 = hist[4 * lane + 2], c3 = hist[4 * lane + 3];
                    const unsigned tl = c0 + c1 + c2 + c3; unsigned suf = tl;
#pragma unroll
                    for (int o = 1; o < 64; o <<= 1) { const unsigned v = __shfl_down(suf, o); if (lane + o < 64) suf += v; }
                    const unsigned above = suf - tl;
                    if (above < remaining && remaining <= suf) {
                        unsigned a = above; int d;
                        if (a + c3 >= remaining) d = 3; else { a += c3; if (a + c2 >= remaining) d = 2; else { a += c2; if (a + c1 >= remaining) d = 1; else { a += c1; d = 0; } } }
                        res[0] = (unsigned)(4 * lane + d); res[1] = remaining - a; }
                }
                __syncthreads();
                prefix |= res[0] << shift; pmask |= 255u << shift; remaining = res[1];
                __syncthreads();
            }
            T = prefix; r = remaining;
        }
        const int s0 = 32 * tid; unsigned eqc = 0u;
        for (int i = 0; i < 32; ++i) { const int s = s0 + i; if (s < n && skey[s] == T) ++eqc; }
        unsigned inc = eqc;
#pragma unroll
        for (int o = 1; o < 64; o <<= 1) { const unsigned v = __shfl_up(inc, o); if (lane >= o) inc += v; }
        if (lane == 63) wtot[wv] = inc;
        __syncthreads();
        unsigned run = inc - eqc;
        for (int v = 0; v < wv; ++v) run += wtot[v];
        unsigned word = 0u;
        for (int i = 0; i < 32; ++i) { const int s = s0 + i; if (s < n) { const unsigned k = skey[s]; if (k > T) word |= 1u << i; else if (k == T) { if (run < r) word |= 1u << i; ++run; } } }
        const int nchunk = 8 * ((t >> 8) + 1);
        if (tid < nchunk) mask32[((size_t)(tid >> 1) * M + t) * 2 + (tid & 1)] = word;
    }
}

__device__ __forceinline__ int t5_bucket(int d) {
    if (d < 16) return d;
    int b = 16;
    b += d >= 19; b += d >= 21; b += d >= 24; b += d >= 27; b += d >= 31; b += d >= 35; b += d >= 40; b += d >= 46;
    b += d >= 52; b += d >= 59; b += d >= 67; b += d >= 77; b += d >= 87; b += d >= 99; b += d >= 113;
    return b;
}
__device__ __forceinline__ void attn_simple(Frame& F, KArgs A) {
    const bf16* Q = (const bf16*)(A->ws + WS_Q); const bf16* K = (const bf16*)(A->ws + WS_K); const bf16* V = (const bf16*)(A->ws + WS_V); bf16* O = (bf16*)(A->ws + WS_ATT);
    const unsigned long long* mask = (const unsigned long long*)(A->ws + WS_MASK); const float* relb = A->in[22];
    LAS unsigned char* base = F.lds + F.wave * 4096;
    LAS unsigned short* list = (LAS unsigned short*)base;
    LAS float* pbuf = (LAS float*)(base + 512);
    LAS float* qf = (LAS float*)(base + 1536);
    const int lane = F.lane, gw = (int)blockIdx.x * NWAVES + F.wave;
    for (int j = 0; j < 8; ++j) {
        const int t = 2048 * j + ((j & 1) ? (2047 - gw) : gw);
        { const v4u qv = *(const GAS v4u*)(Q + (size_t)t * AW + 8 * lane);
          qf[8 * lane + 0] = bflo(qv.x); qf[8 * lane + 1] = bfhi(qv.x); qf[8 * lane + 2] = bflo(qv.y); qf[8 * lane + 3] = bfhi(qv.y);
          qf[8 * lane + 4] = bflo(qv.z); qf[8 * lane + 5] = bfhi(qv.z); qf[8 * lane + 6] = bflo(qv.w); qf[8 * lane + 7] = bfhi(qv.w); }
        const int qg = t >> 5, cq = t & 31;
        const unsigned long long* mw = mask + (size_t)qg * 512 * 16;
        unsigned pc = 0u;
        for (int i = 0; i < 8; ++i) { const int ks = lane + 64 * i; if (ks <= qg) {
            for (int r = 0; r < 16; ++r) { const unsigned long long w = mw[ks * 16 + r]; pc += (unsigned)((w >> cq) & 1ull) + (unsigned)((w >> (cq + 32)) & 1ull); } } }
        unsigned inc = pc;
#pragma unroll
        for (int o = 1; o < 64; o <<= 1) { const unsigned v = __shfl_up(inc, o); if (lane >= o) inc += v; }
        const int cnt = (int)__shfl(inc, 63);
        unsigned pos = inc - pc;
        for (int i = 0; i < 8; ++i) { const int ks = lane + 64 * i; if (ks <= qg) {
            for (int r = 0; r < 16; ++r) { const unsigned long long w = mw[ks * 16 + r];
                for (int h2 = 0; h2 < 2; ++h2) if ((w >> (cq + 32 * h2)) & 1ull) { if (pos < 256u) list[pos] = (unsigned short)(32 * ks + (r & 3) + 8 * (r >> 2) + 4 * h2); ++pos; } } } }
        LDS_WAIT(); asm volatile("" ::: "memory");
        const int ncl = cnt < 256 ? cnt : 256;
        for (int h = 0; h < NH; ++h) {
            float lg[4]; float mx = -INFINITY;
#pragma unroll
            for (int i = 0; i < 4; ++i) { const int e = lane + 64 * i; lg[i] = -INFINITY;
                if (e < ncl) { const int key = list[e]; const bf16* kr = K + (size_t)key * AW + 64 * h; float dot = 0.f;
#pragma unroll
                    for (int c = 0; c < 8; ++c) { const v4u kv = *(const GAS v4u*)(kr + 8 * c); const LAS float* qq = qf + 64 * h + 8 * c;
                        dot += bflo(kv.x) * qq[0]; dot += bfhi(kv.x) * qq[1]; dot += bflo(kv.y) * qq[2]; dot += bfhi(kv.y) * qq[3];
                        dot += bflo(kv.z) * qq[4]; dot += bfhi(kv.z) * qq[5]; dot += bflo(kv.w) * qq[6]; dot += bfhi(kv.w) * qq[7]; }
                    lg[i] = dot + relb[t5_bucket(t - key) * NH + h] * LOG2E; }
                mx = fmaxf(mx, lg[i]); }
            mx = wave_max(mx);
            float sm = 0.f;
#pragma unroll
            for (int i = 0; i < 4; ++i) { const int e = lane + 64 * i; const float p = (e < ncl) ? __builtin_amdgcn_exp2f(lg[i] - mx) : 0.f; sm += p; if (e < ncl) pbuf[e] = p; }
            sm = wave_sum(sm);
            LDS_WAIT(); asm volatile("" ::: "memory");
            float acc = 0.f;
            for (int e = 0; e < ncl; ++e) { const int key = list[e]; acc += pbuf[e] * __uint_as_float((unsigned)V[(size_t)key * AW + 64 * h + lane] << 16); }
            O[(size_t)t * AW + 64 * h + lane] = (bf16)f2bf(acc / sm);
            LDS_WAIT(); asm volatile("" ::: "memory");
        }
    }
}


typedef _Float16 half8 __attribute__((ext_vector_type(8)));
typedef float f32x16 __attribute__((ext_vector_type(16)));
constexpr int IX_NBW = 515, IX_CENTER = 515, IX_TOPBIN = 1029, IX_CAP = 256, IX_SH = 19, IX_E0 = (127 - 28) * 16;
constexpr int IX_CHUNK = 32;
constexpr int IX_ROW = 64 + 1030;
constexpr int IXL_HIST = 0, IXL_IMG = 0, IXL_ZH = 70144, IXL_CANDK = 74240, IXL_CANDI = 107008, IXL_CCNT = 123392, IXL_ST = 123520, IXL_CNT = 124544, IXL_ST2 = 124672, IXL_FLAG = 125184, IXL_END = 125248;
enum { IXF_USEKEY = 1, IXF_TIE = 2, IXF_OVF = 4, IXF_NEEDTIE = 8 };
enum { IXM_HIST0 = 0, IXM_COUNT = 1, IXM_TIES = 2, IXM_COLLECT = 3 };

__device__ __forceinline__ int ix_bin(float s) {
    const unsigned u = __float_as_uint(s), a = u & 0x7fffffffu;
    int mi = (int)(a >> IX_SH) - IX_E0;
    mi = min(max(mi, -1), 512) + 1;
    const int b = (u >> 31) ? (IX_CENTER - 1 - mi) : (IX_CENTER + 1 + mi);
    return a == 0u ? IX_CENTER : b;
}
__device__ __forceinline__ void ix_bin_range(int b, unsigned& klo, unsigned& khi) {
    const bool pos = b > IX_CENTER; const int mi = pos ? b - IX_CENTER - 1 : IX_CENTER - 1 - b;
    const unsigned alo = mi == 0 ? 1u : ((unsigned)(mi - 1 + IX_E0) << IX_SH);
    const unsigned ahi = mi == 0 ? (((unsigned)IX_E0 << IX_SH) - 1u) : (mi == 513 ? 0x7fffffffu : alo + (1u << IX_SH) - 1u);
    if (pos) { klo = alo | 0x80000000u; khi = ahi | 0x80000000u; } else { klo = 0x7fffffffu - ahi; khi = 0x7fffffffu - alo; }
}
__device__ __forceinline__ unsigned wave_incl_scan(unsigned v, int lane) {
#pragma unroll
    for (int o = 1; o < 64; o <<= 1) { const unsigned t = __shfl_up(v, o); if (lane >= o) v += t; }
    return v;
}
__device__ __forceinline__ bool ix_scan_row(LAS unsigned char* L, int q, int lane, unsigned& B, unsigned& cB, unsigned& cab) {
    LAS unsigned* hq = (LAS unsigned*)(L + IXL_HIST) + (q & 15) * IX_ROW + (64 + IX_TOPBIN - 16) - 17 * lane; const int hsh = 16 * (q >> 4);
    unsigned cj[17]; unsigned tl = 0u;
#pragma unroll
    for (int j = 0; j < 17; ++j) { const unsigned v = (hq[16 - j] >> hsh) & 0xffffu; cj[j] = v; tl += v; }
    const unsigned inc = wave_incl_scan(tl, lane), above = inc - tl;
    const bool cross = above < 256u && 256u <= inc;
    unsigned b_ = 0u, c_ = 0u, a_ = 0u; { unsigned a = above; bool done = false;
#pragma unroll
        for (int j = 0; j < 17; ++j) { if (!done && a + cj[j] >= 256u) { b_ = (unsigned)(IX_TOPBIN - (17 * lane + j)); c_ = cj[j]; a_ = a; done = true; } a += cj[j]; } }
    const unsigned long long bal = __ballot(cross); const int src = bal ? (__ffsll((long long)bal) - 1) : 0;
    B = (unsigned)__shfl((int)b_, src); cB = (unsigned)__shfl((int)c_, src); cab = (unsigned)__shfl((int)a_, src);
    return bal != 0ull;
}
__device__ __forceinline__ void ix_group_scan(LAS unsigned* zhq, unsigned need, int lane, unsigned& gz, unsigned& before) {
    const unsigned w = zhq[lane >> 1]; const unsigned z0 = (w >> (16 * (lane & 1))) & 0xffu, z1 = (w >> (16 * (lane & 1) + 8)) & 0xffu;
    const unsigned tl = z0 + z1, inc = wave_incl_scan(tl, lane), bef = inc - tl;
    const bool cross = bef < need && need <= inc;
    const unsigned g = (bef + z0 >= need) ? (unsigned)(2 * lane) : (unsigned)(2 * lane + 1), b = (bef + z0 >= need) ? bef : bef + z0;
    const unsigned long long bal = __ballot(cross); const int src = bal ? (__ffsll((long long)bal) - 1) : 0;
    gz = (unsigned)__shfl((int)g, src); before = (unsigned)__shfl((int)b, src);
}

struct IxLane { unsigned thi, tlo, flags, gz, cmpkey; };
__device__ __forceinline__ float ix_relu(float x) { return __builtin_bit_cast(float, max(__builtin_bit_cast(int, x), 0)); }

template <int MODE, bool DIAG>
__device__ __forceinline__ void ix_tile(LAS unsigned char* L, f32x16 (&acc)[4], const f32x4 w4, int ks, int c, int hi, const IxLane st, bool act, unsigned& cnt) {
    LAS unsigned* hc = (LAS unsigned*)(L + IXL_HIST) + (c & 15) * IX_ROW + 64 + IX_CENTER;
    const unsigned hval = 1u << (16 * (c >> 4));
    LAS unsigned* zh = (LAS unsigned*)(L + IXL_ZH) + c * 32;
    const unsigned grp = (unsigned)ks >> 2;
    int cm = c - 4 * hi;
    if (DIAG) asm volatile("" : "+v"(cm));
    const bool tieLt = (st.flags & IXF_TIE) ? (grp < st.gz) : false, tieEq = (st.flags & IXF_TIE) ? (grp == st.gz) : true;

    float thif = __uint_as_float(st.thi), tlof = __uint_as_float(st.tlo);
    if (MODE == IXM_COLLECT) { thif = tieLt ? __uint_as_float(0x80000001u) : thif;
        tlof = (tieEq && !tieLt) ? tlof : __uint_as_float(0x7fc00000u); }
    unsigned mybits = 0u, nzs = 0u;
    typedef float f32x2i __attribute__((ext_vector_type(2)));
    const f32x2i wx = {w4.x, w4.x}, wy = {w4.y, w4.y}, wz = {w4.z, w4.z}, ww = {w4.w, w4.w};
#pragma unroll
    for (int r = 0; r < 16; ++r) {
        const int ko = (r & 3) + 8 * (r >> 2);
        f32x2i t2_;
        if ((r & 1) == 0) {
            { float s0 = ix_relu(acc[0][r]) * w4.x, s1 = ix_relu(acc[0][r + 1]) * w4.x;
              s0 = __builtin_fmaf(ix_relu(acc[1][r]), w4.y, s0); s1 = __builtin_fmaf(ix_relu(acc[1][r + 1]), w4.y, s1);
              s0 = __builtin_fmaf(ix_relu(acc[2][r]), w4.z, s0); s1 = __builtin_fmaf(ix_relu(acc[2][r + 1]), w4.z, s1);
              s0 = __builtin_fmaf(ix_relu(acc[3][r]), w4.w, s0); s1 = __builtin_fmaf(ix_relu(acc[3][r + 1]), w4.w, s1);
              asm volatile("" : "+v"(s0), "+v"(s1));
              t2_ = (f32x2i){s0, s1}; }
            acc[0][r + 1] = t2_.y; }
        const float sc = (r & 1) ? acc[0][r] : t2_.x;
        const unsigned u = __float_as_uint(sc);
        const bool ok = (DIAG ? (ko <= cm) : true) && ((MODE == IXM_COLLECT || MODE == IXM_HIST0) ? true : act);
        if (MODE == IXM_HIST0) {
            const int t = (int)((u >> IX_SH) & 0xfffu);
            int m1; asm("v_med3_i32 %0, %1, 1, %2" : "=v"(m1) : "v"(t - (IX_E0 - 2)), "s"(514));
            m1 = (int)min((unsigned)m1, u << 1);
            const int sm = (int)(((unsigned)((int)u >> 31) << 3) | 4u);
            unsigned hpa; asm("v_mad_i32_i24 %0, %1, %2, %3" : "=v"(hpa) : "v"(m1), "v"(sm), "v"((unsigned)(uintptr_t)hc));
            LAS unsigned* hp = (LAS unsigned*)(uintptr_t)hpa;
            if (DIAG) { if (ok) __hip_atomic_fetch_add(hp, hval, __ATOMIC_RELAXED, __HIP_MEMORY_SCOPE_WORKGROUP); nzs += ok ? (unsigned)min(m1, 1) : 1u; }
            else { __hip_atomic_fetch_add(hp, hval, __ATOMIC_RELAXED, __HIP_MEMORY_SCOPE_WORKGROUP); nzs += (unsigned)min(m1, 1); }
        } else if (MODE == IXM_COUNT) {
            cnt += (ok && ordkey(sc) > st.cmpkey) ? 1u : 0u;
        } else if (MODE == IXM_TIES) {
            if (ok && ordkey(sc) == st.cmpkey) __hip_atomic_fetch_add(&zh[grp >> 2], 1u << (8 * (grp & 3)), __ATOMIC_RELAXED, __HIP_MEMORY_SCOPE_WORKGROUP);
        } else {
            const unsigned long long Gm = __builtin_amdgcn_ballot_w64(sc > thif), Em = __builtin_amdgcn_ballot_w64(sc >= tlof);
            const bool gt = __builtin_amdgcn_inverse_ballot_w64(Gm); bool isc = __builtin_amdgcn_inverse_ballot_w64(Em & ~Gm);
            bool sel = gt;
            sel = sel && ok; isc = isc && ok;
            if (isc) { LAS unsigned* ccnt = (LAS unsigned*)(L + IXL_CCNT) + c; const unsigned pos = __hip_atomic_fetch_add(ccnt, 1u, __ATOMIC_RELAXED, __HIP_MEMORY_SCOPE_WORKGROUP);
                { const unsigned pos_ = pos; const unsigned pos = min(pos_, (unsigned)IX_CAP - 1u);
                  ((LAS unsigned*)(L + IXL_CANDK) + c * IX_CAP)[pos] = __float_as_uint(sc);     ((LAS unsigned short*)(L + IXL_CANDI) + c * IX_CAP)[pos] = (unsigned short)(32 * ks + ko + 4 * hi); } }
            mybits |= sel ? (1u << ko) : 0u;
        }
        __builtin_amdgcn_sched_barrier(0);
    }
    if (MODE == IXM_HIST0) { const unsigned nz = act ? 16u - nzs : 0u; if (nz) __hip_atomic_fetch_add(&zh[grp >> 2], nz << (8 * (grp & 3)), __ATOMIC_RELAXED, __HIP_MEMORY_SCOPE_WORKGROUP); }
    if (MODE == IXM_COLLECT) { mybits <<= 4 * hi; const unsigned word = mybits | (unsigned)__shfl_xor((int)mybits, 32);
        if (hi == 0) ((LAS unsigned*)(L + IXL_IMG))[(((ks >> 1) * 32 + c) << 1) + (ks & 1)] = word; }
}

template <int MODE>
__device__ __forceinline__ void ix_pass(LAS unsigned char* L, const half8 (&qf)[4][4], const f32x4 w4, const unsigned short* KI, int qg, int wv, int lane, const IxLane st) {
    const int c = lane & 31, hi = lane >> 5;
    unsigned cnt = 0u;
    const bool act = (MODE == IXM_COUNT) ? ((st.flags & IXF_OVF) != 0u) : (MODE == IXM_TIES) ? ((st.flags & IXF_NEEDTIE) != 0u) : true;
    const unsigned short* kp = KI + (size_t)c * 64 + 32 * hi;
    IxLane sv = st;
    for (int ks = wv; ks <= qg; ks += 8) {
        half8 a[4];
#pragma unroll
        for (int s = 0; s < 4; ++s) a[s] = *(const GAS half8*)(kp + (size_t)ks * 2048 + 8 * s);
        f32x16 acc[4];
#pragma unroll
        for (int h = 0; h < 4; ++h) { acc[h] = (f32x16){};
#pragma unroll
            for (int s = 0; s < 4; ++s) acc[h] = __builtin_amdgcn_mfma_f32_32x32x16_f16(a[s], qf[h][s], acc[h], 0, 0, 0); }
        if (ks == qg) ix_tile<MODE, true>(L, acc, w4, ks, c, hi, sv, act, cnt);
        else ix_tile<MODE, false>(L, acc, w4, ks, c, hi, sv, act, cnt);
    }
    if (MODE == IXM_COUNT) { if (act && cnt) __hip_atomic_fetch_add((LAS unsigned*)(L + IXL_CNT) + c, cnt, __ATOMIC_RELAXED, __HIP_MEMORY_SCOPE_WORKGROUP); }
}

__device__ __forceinline__ void indexer_fast(Frame& F, KArgs A) {
    unsigned char* ws = A->ws;
    const unsigned short* QI = (const unsigned short*)(ws + WS_QI); const unsigned short* KI = (const unsigned short*)(ws + WS_KI); const float* WI = (const float*)(ws + WS_WI);
    unsigned char* maskW = ws + WS_MASK;
    LAS unsigned char* L = F.lds;
    const int tid = F.tid, lane = F.lane, wv = F.wave, c = lane & 31, hi = lane >> 5;
    LAS unsigned* ST = (LAS unsigned*)(L + IXL_ST); LAS unsigned* ST2 = (LAS unsigned*)(L + IXL_ST2); LAS unsigned* CNT = (LAS unsigned*)(L + IXL_CNT);
    LAS unsigned* CCNT = (LAS unsigned*)(L + IXL_CCNT); LAS unsigned* FLAG = (LAS unsigned*)(L + IXL_FLAG);
#pragma unroll 1
    for (int it = 0; it < 2; ++it) {
        const int qg = it ? (int)blockIdx.x : 511 - (int)blockIdx.x;
        const int t = 32 * qg + c;
        half8 qf[4][4];
#pragma unroll
        for (int h = 0; h < 4; ++h)
#pragma unroll
            for (int s = 0; s < 4; ++s) qf[h][s] = *(const GAS half8*)(QI + (size_t)t * 256 + 64 * h + 32 * hi + 8 * s);
        const f32x4 w4 = *(const GAS f32x4*)(WI + (size_t)t * 4);
        __syncthreads();
        static_assert(IXL_END % 16 == 0, "");
        for (int u = tid; u < IXL_END / 16; u += NWAVES * 64) ((LAS v4u*)L)[u] = (v4u){0u, 0u, 0u, 0u};
        __syncthreads();
        IxLane st{0u, 0u, 0u, 0u, (unsigned)(-1024)};
#ifdef DIAG_TIME
#define TSTAMP(k) do { if (blockIdx.x == 0 && it == 0 && tid == 0) ((unsigned long long*)(ws + WS_CTL + 16384))[k] = __builtin_amdgcn_s_memrealtime(); } while (0)
#else
#define TSTAMP(k) do {} while (0)
#endif
        TSTAMP(0);
#ifndef REP_HIST
#define REP_HIST 1
#endif
#ifndef REP_COLL
#define REP_COLL 1
#endif
#pragma unroll 1
        for (int rep = 0; rep < REP_HIST; ++rep) {
            if (rep) { __syncthreads(); for (int u = tid; u < IXL_CANDK / 4; u += NWAVES * 64) ((LAS unsigned*)L)[u] = 0u; __syncthreads(); }
            ix_pass<IXM_HIST0>(L, qf, w4, KI, qg, wv, lane, st); }
        __syncthreads();
        TSTAMP(1);
#pragma unroll 1
        for (int qi = 0; qi < 4; ++qi) {
            const int q = 4 * wv + qi, n = 32 * qg + q + 1;
            if (n <= 256) { if (lane == 0) { ST[q * 8 + 0] = 0x007fffffu; ST[q * 8 + 1] = 0xff800000u; } continue; }
            unsigned B, cB, cab; (void)ix_scan_row(L, q, lane, B, cB, cab);
            const unsigned r = 256u - cab;
            unsigned flags = 0u, gz = 0u, rn = r, klo, khi;
            if (B == (unsigned)IX_CENTER) { klo = 0x7fffffffu; khi = 0x80000000u; } else ix_bin_range((int)B, klo, khi);
            if (cB > (unsigned)IX_CAP) {
                if (B == (unsigned)IX_CENTER) { unsigned before; ix_group_scan((LAS unsigned*)(L + IXL_ZH) + q * 32, r, lane, gz, before); rn = r - before; flags = IXF_TIE; }
                else { flags = IXF_OVF;
                    if (lane == 0) { ST2[q * 4 + 0] = klo - 1u; ST2[q * 4 + 1] = khi; ST2[q * 4 + 2] = cab + cB; ST2[q * 4 + 3] = cab; FLAG[0] = 1u; }
#ifdef DIAG_OVF
                    if (lane == 0) { unsigned* dg = (unsigned*)(ws + WS_CTL) + 2048; atomicAdd(dg + 0, 1u); atomicMax(dg + 1, cB); atomicMax(dg + 2, (cB << 16) | B); atomicMax(dg + 3, (cB << 16) | (unsigned)n); }
#endif
                    }
            }
            if (lane == 0) { ST[q * 8 + 0] = khi; ST[q * 8 + 1] = klo; ST[q * 8 + 2] = flags; ST[q * 8 + 3] = rn; ST[q * 8 + 4] = gz; }
        }
        __syncthreads();
        if (FLAG[0] != 0u) {
#pragma unroll 1
            for (int iter = 0; iter < 40; ++iter) {
                const unsigned fl = ST[c * 8 + 2], lo = ST2[c * 4 + 0], hh = ST2[c * 4 + 1];
                const bool actv = (fl & IXF_OVF) && (hh - lo > 1u);
                if (!__any(actv)) break;
                const unsigned mid = lo + ((hh - lo) >> 1);
                if (tid < 32) CNT[tid] = 0u;
                __syncthreads();
                IxLane sc{0u, 0u, actv ? (unsigned)IXF_OVF : 0u, 0u, mid};
                ix_pass<IXM_COUNT>(L, qf, w4, KI, qg, wv, lane, sc);
                __syncthreads();
                if (tid < 32 && actv) { const unsigned g = CNT[tid]; if (g >= 256u) { ST2[tid * 4 + 0] = mid; ST2[tid * 4 + 2] = g; } else { ST2[tid * 4 + 1] = mid; ST2[tid * 4 + 3] = g; } }
                __syncthreads();
            }
            if (tid < 32 && (ST[tid * 8 + 2] & IXF_OVF)) { const unsigned T = ST2[tid * 4 + 1], glo = ST2[tid * 4 + 2], ghi = ST2[tid * 4 + 3];
                ST[tid * 8 + 0] = T; ST[tid * 8 + 1] = T; ST[tid * 8 + 3] = 256u - ghi;
                const bool nt = (glo - ghi) > (unsigned)IX_CAP; ST[tid * 8 + 2] = (nt ? (unsigned)IXF_NEEDTIE : 0u);
                if (nt) { FLAG[1] = 1u; for (int k = 0; k < 32; ++k) ((LAS unsigned*)(L + IXL_ZH))[tid * 32 + k] = 0u; } }
            __syncthreads();
            if (FLAG[1] != 0u) {
                IxLane sc{0u, 0u, ST[c * 8 + 2], 0u, ST[c * 8 + 0]};
                ix_pass<IXM_TIES>(L, qf, w4, KI, qg, wv, lane, sc);
                __syncthreads();
#pragma unroll 1
                for (int qi = 0; qi < 4; ++qi) { const int q = 4 * wv + qi; const unsigned fl = ST[q * 8 + 2];
                    if (fl & IXF_NEEDTIE) { unsigned gz, before; ix_group_scan((LAS unsigned*)(L + IXL_ZH) + q * 32, ST[q * 8 + 3], lane, gz, before);
                        if (lane == 0) { ST[q * 8 + 3] -= before; ST[q * 8 + 4] = gz; ST[q * 8 + 2] = IXF_TIE; } } }
                __syncthreads();
            }
        }
        TSTAMP(2);
        const unsigned khi_ = ST[c * 8 + 0], klo_ = ST[c * 8 + 1];
        const IxLane sl{(khi_ & 0x80000000u) ? (khi_ & 0x7fffffffu) : ~khi_, (klo_ & 0x80000000u) ? (klo_ & 0x7fffffffu) : ~klo_, ST[c * 8 + 2], ST[c * 8 + 4], 0u};
#pragma unroll 1
        for (int rep = 0; rep < REP_COLL; ++rep) {
            __syncthreads();
            for (int u = tid; u < 65536 / 16; u += NWAVES * 64) ((LAS v4u*)(L + IXL_IMG))[u] = (v4u){0u, 0u, 0u, 0u};
            if (tid < 32) CCNT[tid] = 0u;
            __syncthreads();
            ix_pass<IXM_COLLECT>(L, qf, w4, KI, qg, wv, lane, sl); }
        __syncthreads();
        TSTAMP(3);
#pragma unroll 1
        for (int qi = 0; qi < 4; ++qi) { const int q = 4 * wv + qi; const int nc = (int)min(CCNT[q], (unsigned)IX_CAP); const unsigned rn = ST[q * 8 + 3];
            if (nc == 0 || rn == 0u) continue;
            const LAS unsigned* ckq = (const LAS unsigned*)(L + IXL_CANDK) + q * IX_CAP; const LAS unsigned short* ciq = (const LAS unsigned short*)(L + IXL_CANDI) + q * IX_CAP;
            unsigned kk[4], ii[4], rk[4];
#pragma unroll
            for (int m = 0; m < 4; ++m) { const int id = lane + 64 * m; const bool v = id < nc; kk[m] = v ? ordkey(__uint_as_float(ckq[id])) : 0u; ii[m] = v ? (unsigned)ciq[id] : 0xffffu; rk[m] = 0u; }
            if (nc <= 64) {
                const unsigned long long me0 = ((unsigned long long)kk[0] << 32) | (0xffffu - ii[0]);
#pragma unroll 2
                for (int jj = 0; jj < nc; ++jj) { const unsigned kj = (unsigned)__builtin_amdgcn_readlane((int)kk[0], jj), ij = (unsigned)__builtin_amdgcn_readlane((int)ii[0], jj);
                    rk[0] += ((((unsigned long long)kj << 32) | (0xffffu - ij)) > me0) ? 1u : 0u; }
            } else if (nc <= 128) {
#pragma unroll
                for (int ch = 0; ch < 2; ++ch) { const int cntc = min(64, nc - 64 * ch);
#pragma unroll 2
                    for (int jj = 0; jj < cntc; ++jj) { const unsigned kj = (unsigned)__builtin_amdgcn_readlane((int)kk[ch], jj), ij = (unsigned)__builtin_amdgcn_readlane((int)ii[ch], jj);
#pragma unroll
                        for (int m = 0; m < 2; ++m) rk[m] += ((((unsigned long long)kj << 32) | (0xffffu - ij)) > ((((unsigned long long)kk[m]) << 32) | (0xffffu - ii[m]))) ? 1u : 0u; } }
            } else {
#pragma unroll
            for (int ch = 0; ch < 4; ++ch) { const int cntc = min(64, nc - 64 * ch);
                if (cntc > 0) {
#pragma unroll 2
                    for (int jj = 0; jj < cntc; ++jj) { const unsigned kj = (unsigned)__builtin_amdgcn_readlane((int)kk[ch], jj), ij = (unsigned)__builtin_amdgcn_readlane((int)ii[ch], jj);
#pragma unroll
                        for (int m = 0; m < 4; ++m) rk[m] += ((((unsigned long long)kj << 32) | (0xffffu - ij)) > ((((unsigned long long)kk[m]) << 32) | (0xffffu - ii[m]))) ? 1u : 0u; } } }
            }
#pragma unroll
            for (int m = 0; m < 4; ++m) { const int id = lane + 64 * m; const unsigned mi = ii[m];
                if (id < nc && rk[m] < rn) __hip_atomic_fetch_or((LAS unsigned*)(L + IXL_IMG) + ((((mi >> 6) * 32 + (unsigned)q) << 1) + ((mi >> 5) & 1u)), 1u << (mi & 31u), __ATOMIC_RELAXED, __HIP_MEMORY_SCOPE_WORKGROUP); } }
        __syncthreads();
        TSTAMP(4);
        { const int ntile = 4 * (qg / 8 + 1);
          unsigned char* const mw_ = kargs()->ws + WS_MASK;
          int tq = tid; asm volatile("" : "+v"(tq));
          for (int tt = tq >> 4; tt < ntile; tt += NWAVES * 4) *(GAS v4u*)(mw_ + ((size_t)tt * M + 32 * qg) * 8 + (tq & 15) * 16) = *(const LAS v4u*)(L + IXL_IMG + tt * 256 + (tq & 15) * 16); }
        TSTAMP(5);
    }
    __syncthreads();
}

#include <hip/hip_bf16.h>
#include <cmath>
namespace attn_body {
using bf16=__hip_bfloat16;
using bf16x8=__attribute__((ext_vector_type(8)))short;
using s16x4=__attribute__((ext_vector_type(4)))short;
using f32x16=__attribute__((ext_vector_type(16)))float;
using u32x4=__attribute__((ext_vector_type(4)))unsigned;
constexpr int BATCH=1,NHEAD=8,SEQ=16384,D=64,DM=NHEAD*D;
constexpr int NW=8,QBLK=32,QB=QBLK*NW,KVBLK=64,NQB=SEQ/QB;
constexpr int ATTN_PITCH=DM, ATTN_UNIT_ROWS=QB;
__device__ __forceinline__ int crow(int r,int hi){return (r&3)+8*(r>>2)+4*hi;}
#define SBAR() __builtin_amdgcn_sched_barrier(0)
constexpr int NSLOT=3, SLOTB=8192;
constexpr int LDS_K=0, LDS_V=NSLOT*SLOTB, LDS_WS=2*NSLOT*SLOTB, LDS_OST=LDS_WS+NW*64*4, LDS_MK=LDS_OST+NW*4096, LDS_BT=LDS_MK+NW*768, LDS_BYTES=LDS_BT+512;
constexpr float C2=0.125f*1.4426950408889634f;
__device__ __forceinline__ void glds4(const void*gsrc,unsigned lds_dst){unsigned keep;
  asm volatile("s_mov_b32 %0, m0\n\ts_mov_b32 m0, %2\n\ts_nop 0\n\tglobal_load_lds_dword %1, off\n\ts_mov_b32 m0, %0":"=&s"(keep):"v"(gsrc),"s"(lds_dst):"memory");}
__device__ __forceinline__ void glds16(const void*gsrc,unsigned lds_dst){unsigned keep;
  asm volatile("s_mov_b32 %0, m0\n\ts_mov_b32 m0, %2\n\ts_nop 0\n\tglobal_load_lds_dwordx4 %1, off\n\ts_mov_b32 m0, %0":"=&s"(keep):"v"(gsrc),"s"(lds_dst):"memory");}
__device__ __forceinline__ float max3f(float a,float b,float c){float r;asm("v_max3_f32 %0, %1, %2, %3":"=v"(r):"v"(a),"v"(b),"v"(c));return r;}
__device__ __forceinline__ float max2f(float a,float b){float r;asm("v_max_f32_e32 %0, %1, %2":"=v"(r):"v"(a),"v"(b));return r;}
__device__ __forceinline__ float fadd_s(float a,float b){float r;asm("v_add_f32_e32 %0, %1, %2":"=v"(r):"v"(a),"v"(b));return r;}
__device__ __forceinline__ float fsub_s(float a,float b){float r;asm("v_sub_f32_e32 %0, %1, %2":"=v"(r):"v"(a),"v"(b));return r;}
typedef float f32x2_t __attribute__((ext_vector_type(2))); typedef __bf16 bf16x2_t __attribute__((ext_vector_type(2)));
__device__ __forceinline__ unsigned cvtpk_s(float lo,float hi){f32x2_t v={lo,hi};bf16x2_t b=__builtin_convertvector(v,bf16x2_t);return __builtin_bit_cast(unsigned,b);}
#define WAIT_BAR(N) asm volatile("s_waitcnt vmcnt(" #N ") lgkmcnt(0)\n\ts_barrier":::"memory")

__device__ __forceinline__ void qkt(f32x16&p0,f32x16&p1,const char*Kslot,const bf16x8*qr,const f32x16&negm,int r32,int hi){
  const char*kb=Kslot+hi*1024+r32*16;
  #pragma unroll
  for(int d0=0;d0<4;++d0){
    const bf16x8 b0=*reinterpret_cast<const bf16x8*>(kb+d0*2048);
    const bf16x8 b1=*reinterpret_cast<const bf16x8*>(kb+d0*2048+512);
    if(d0==0){p0=__builtin_amdgcn_mfma_f32_32x32x16_bf16(b0,qr[0],negm,0,0,0);p1=__builtin_amdgcn_mfma_f32_32x32x16_bf16(b1,qr[0],negm,0,0,0);}
    else{p0=__builtin_amdgcn_mfma_f32_32x32x16_bf16(b0,qr[d0],p0,0,0,0);p1=__builtin_amdgcn_mfma_f32_32x32x16_bf16(b1,qr[d0],p1,0,0,0);}}
}
typedef __attribute__((address_space(3))) const char* lds_cptr;
typedef short v4i16_t __attribute__((ext_vector_type(4)));
__device__ __forceinline__ void kload8(bf16x8*kf,lds_cptr kp){
  kf[0]=*(const __attribute__((address_space(3))) bf16x8*)(kp);      kf[1]=*(const __attribute__((address_space(3))) bf16x8*)(kp+512);
  kf[2]=*(const __attribute__((address_space(3))) bf16x8*)(kp+2048); kf[3]=*(const __attribute__((address_space(3))) bf16x8*)(kp+2560);
  kf[4]=*(const __attribute__((address_space(3))) bf16x8*)(kp+4096); kf[5]=*(const __attribute__((address_space(3))) bf16x8*)(kp+4608);
  kf[6]=*(const __attribute__((address_space(3))) bf16x8*)(kp+6144); kf[7]=*(const __attribute__((address_space(3))) bf16x8*)(kp+6656);
}
__device__ __forceinline__ void kload2(bf16x8*kf,lds_cptr kp,int j){ kf[2*j]=*(const __attribute__((address_space(3))) bf16x8*)(kp+j*2048); kf[2*j+1]=*(const __attribute__((address_space(3))) bf16x8*)(kp+j*2048+512); }
__device__ __forceinline__ s16x4 vtr(lds_cptr p){ return __builtin_bit_cast(s16x4,__builtin_amdgcn_ds_read_tr16_b64_v4i16((__attribute__((address_space(3))) v4i16_t*)p)); }
__device__ __forceinline__ float rowmax(const f32x16&p0,const f32x16&p1){
  float a=max3f(p0[0],p0[1],p1[0]),b=max3f(p0[2],p0[3],p1[1]);a=max3f(a,p1[2],p1[3]);
  #pragma unroll
  for(int r=4;r<16;r+=4){a=max3f(a,p0[r],p0[r+1]);b=max3f(b,p0[r+2],p0[r+3]);a=max3f(a,p1[r],p1[r+1]);b=max3f(b,p1[r+2],p1[r+3]);}
  const float m=max2f(a,b);
  auto rr=__builtin_amdgcn_permlane32_swap(__float_as_uint(m),__float_as_uint(m),false,false);
  return max2f(__uint_as_float(rr[0]),__uint_as_float(rr[1]));
}
__device__ __forceinline__ void pv(f32x16*o,int vb,bf16x8 pa0,bf16x8 pa1,bf16x8 pa2,bf16x8 pa3){
  #pragma unroll
  for(int d0=0;d0<2;++d0){s16x4 lo[4],hi[4];
    #pragma unroll
    for(int ks=0;ks<4;++ks){
      asm volatile("ds_read_b64_tr_b16 %0,%1 offset:%c2":"=&v"(lo[ks]):"v"(vb),"i"(d0*4096+ks*1024):"memory");
      asm volatile("ds_read_b64_tr_b16 %0,%1 offset:%c2":"=&v"(hi[ks]):"v"(vb),"i"(d0*4096+ks*1024+512):"memory");}
    asm volatile("s_waitcnt lgkmcnt(0)":::"memory");SBAR();
    #define PK(k) (bf16x8){lo[k][0],lo[k][1],lo[k][2],lo[k][3],hi[k][0],hi[k][1],hi[k][2],hi[k][3]}
    o[d0]=__builtin_amdgcn_mfma_f32_32x32x16_bf16(pa0,PK(0),o[d0],0,0,0);
    o[d0]=__builtin_amdgcn_mfma_f32_32x32x16_bf16(pa1,PK(1),o[d0],0,0,0);
    o[d0]=__builtin_amdgcn_mfma_f32_32x32x16_bf16(pa2,PK(2),o[d0],0,0,0);
    o[d0]=__builtin_amdgcn_mfma_f32_32x32x16_bf16(pa3,PK(3),o[d0],0,0,0);
    #undef PK
  }
}

#ifndef ATTN_STORE16
#define ATTN_STORE16(p,v) (*(u32x4*)(p)=(v))
#endif
__device__ __forceinline__ void attn_unit(int h,int qb,const bf16*Q,const bf16*__restrict__ K,const bf16*__restrict__ V,bf16*O,const unsigned char*maskT,char*shm,const int wid){
  const int lane=lane_now(),tid=wid*64+lane,r32=lane&31,hi=lane>>5;
  const long rowbase=0; const int q0=qb*QB;
  const bf16*Qw=Q+(rowbase+q0+wid*QBLK)*DM+h*D;
  const bf16*Kh=K+rowbase*DM+h*D,*Vh=V+rowbase*DM+h*D;
  const unsigned lds0=(unsigned)(uintptr_t)shm;
  float*wsf=(float*)(shm+LDS_WS)+wid*64;
  const bf16*ksrc=Kh+(long)lane*DM+wid*8;
  const bf16*vsrc=Vh+(long)(16*(wid&3)+(lane>>2))*DM+(wid>>2)*32+(lane&3)*8;
  const unsigned kdst=lds0+LDS_K+wid*1024, vdst=lds0+LDS_V+wid*1024;
  #define DMA_K(t,slot) glds16(ksrc+(long)(t)*KVBLK*DM,(unsigned)__builtin_amdgcn_readfirstlane(kdst+(slot)))
  #define DMA_V(t,slot) glds16(vsrc+(long)(t)*KVBLK*DM,(unsigned)__builtin_amdgcn_readfirstlane(vdst+(slot)))
  const int vb0=(int)(lds0+LDS_V)+((lane>>4)&1)*32+(lane&3)*8+(4*hi+((lane&15)>>2))*64;
  const char*Kbase=shm+LDS_K; bf16x8 kf[8];
  const lds_cptr shm3=(lds_cptr)shm; const lds_cptr kp0=shm3+LDS_K+hi*1024+r32*16; const lds_cptr vp0=shm3+LDS_V+((lane>>4)&1)*32+(lane&3)*8+(4*hi+((lane&15)>>2))*64;
  const int NT=(q0+QB)/KVBLK;
  const unsigned char*msrc=maskT+((size_t)(q0+wid*QBLK))*8+lane*4;
  const unsigned mdst=lds0+LDS_MK+wid*768;
  #define DMA_M(t,slot) glds4(msrc+(size_t)(t)*((size_t)SEQ*8),(unsigned)__builtin_amdgcn_readfirstlane(mdst+((slot)>>5)))
  const lds_cptr mp0=shm3+LDS_MK+wid*768+r32*8;
  const __attribute__((address_space(3))) float* bt3=(const __attribute__((address_space(3))) float*)(shm3+LDS_BT);
  const int qpos=q0+wid*QBLK+r32;
  unsigned m0=0u,m1=0u;
  #define MASKLD(slot) do{ const unsigned long long mw_=*(const __attribute__((address_space(3))) unsigned long long*)(mp0+((slot)>>5)); m0=((unsigned)mw_)>>(4*hi); m1=((unsigned)(mw_>>32))>>(4*hi); }while(0)
  #define MBIT(r) (((r)&3)+8*((r)>>2))
  #define MAND(x,mw,r) x=__uint_as_float(__float_as_uint(x)&(unsigned)(((int)((mw)<<(31-MBIT(r))))>>31))
  #define MANDA(x,mw,r) do{ int t_; float x_=(x); asm("v_bfe_i32 %1, %2, %3, 1\n\tv_and_b32 %0, %0, %1":"+v"(x_),"=&v"(t_):"v"(mw),"i"(MBIT(r))); (x)=x_; }while(0)
  #define BAND(P0,P1,t) do{ const int kb_=qpos-64*(t)-4*hi; \
      _Pragma("unroll") for(int r=0;r<16;++r){ const int d0_=kb_-MBIT(r); P0[r]+=bt3[min(max(d0_,0),127)]; P1[r]+=bt3[min(max(d0_-32,0),127)]; } }while(0)
  DMA_M(0,0);DMA_M(1,SLOTB);DMA_K(0,0);DMA_V(0,0);DMA_K(1,SLOTB);
  bf16x8 qr[4];
  #pragma unroll
  for(int d0=0;d0<4;++d0)qr[d0]=*reinterpret_cast<const bf16x8*>(&Qw[(long)r32*DM+d0*16+hi*8]);
  float l_reg=0.f;f32x16 o[2];o[0]=f32x16{};o[1]=f32x16{};const f32x16 negm=f32x16{};
  f32x16 pA0,pA1,pB0,pB1;
  int sl_prev=0,sl_cur=0,sl_next=SLOTB;
  #define ROT() do{sl_prev=sl_cur;sl_cur=sl_next;sl_next=(sl_next==(NSLOT-1)*SLOTB)?0:sl_next+SLOTB;}while(0)
  DMA_K(2,2*SLOTB);
  WAIT_BAR(3);
  qkt(pA0,pA1,Kbase,qr,negm,r32,hi);asm volatile("s_nop 15\n\ts_nop 7":"+v"(pA0),"+v"(pA1));
  if(NT<=6)BAND(pA0,pA1,0);
  MASKLD(0);
  _Pragma("unroll") for(int r=0;r<16;++r){pA0[r]=__builtin_amdgcn_exp2f(pA0[r]);MAND(pA0[r],m0,r);pA1[r]=__builtin_amdgcn_exp2f(pA1[r]);MAND(pA1[r],m1,r);}
  WAIT_BAR(0);
  DMA_M(2,2*SLOTB);DMA_K(3,0);DMA_V(1,SLOTB);
  ROT();
  kload8(kf,kp0+sl_cur);
  WAIT_BAR(3);
  s16x4 vlo[8],vhi[8]; u32x4 pw0,pw1,pw2,pw3;
  #define PKW(P,B) cvtpk_s(P[B],P[B+1])
  #define PAF(k) __builtin_bit_cast(bf16x8,pw##k)
  #define VFR(i) (bf16x8){vlo[i][0],vlo[i][1],vlo[i][2],vlo[i][3],vhi[i][0],vhi[i][1],vhi[i][2],vhi[i][3]}
  #define PIN(x) asm volatile("":"+v"(x))
  #define MX3(a,b,c) __builtin_fmaxf(__builtin_fmaxf((a),(b)),(c))
  #define GAPA(MF,A0,A1,A2,A3,W0,W1,PW) do{ MF; sacc+=A0; sacc+=A1; sacc+=A2; sacc+=A3; PIN(sacc); W0; W1; PIN(PW); SBAR(); }while(0)
  #define EX(v) __builtin_amdgcn_exp2f(v)
  #define GAPB(MF,X,B,MW) do{ MF; X[B]=EX(X[B]); X[B+1]=EX(X[B+1]); X[B+2]=EX(X[B+2]); X[B+3]=EX(X[B+3]); MANDA(X[B],MW,B); MANDA(X[B+1],MW,B+1); MANDA(X[B+2],MW,B+2); MANDA(X[B+3],MW,B+3); PIN(X); SBAR(); }while(0)
  #define VRD(i) do{ vlo[i]=vtr(vp_+(((i)>>2)*4096+((i)&3)*1024)); vhi[i]=vtr(vp_+(((i)>>2)*4096+((i)&3)*1024+512)); }while(0)
  #define KRD(G,j) do{ if(G){ kload2(kf,kp0+sl_next,j); SBAR(); } }while(0)
  #define STEP(C0,C1,P0,P1,t,GK,GV,GL,GM,BND) do{ SBAR(); \
    const lds_cptr vp_=vp0+sl_prev; \
    VRD(0); SBAR(); float sacc=(P0[0]+P0[1]); \
    GAPA(C0=__builtin_amdgcn_mfma_f32_32x32x16_bf16(kf[0],qr[0],negm,0,0,0), P0[2],P0[3],P0[4],P0[5],     pw0[0]=PKW(P0,0), pw0[1]=PKW(P0,2), pw0); \
    VRD(4); SBAR(); GAPA(C1=__builtin_amdgcn_mfma_f32_32x32x16_bf16(kf[1],qr[0],negm,0,0,0), P0[6],P0[7],P0[8],P0[9],     pw0[2]=PKW(P0,4), pw0[3]=PKW(P0,6), pw0); \
    VRD(1); SBAR(); GAPA(C0=__builtin_amdgcn_mfma_f32_32x32x16_bf16(kf[2],qr[1],C0,0,0,0),   P0[10],P0[11],P0[12],P0[13], pw1[0]=PKW(P0,8), pw1[1]=PKW(P0,10), pw1); \
    VRD(5); SBAR(); GAPA(C1=__builtin_amdgcn_mfma_f32_32x32x16_bf16(kf[3],qr[1],C1,0,0,0),   P0[14],P0[15],P1[0],P1[1],   pw1[2]=PKW(P0,12),pw1[3]=PKW(P0,14), pw1); \
    VRD(2); SBAR(); GAPA(C0=__builtin_amdgcn_mfma_f32_32x32x16_bf16(kf[4],qr[2],C0,0,0,0),   P1[2],P1[3],P1[4],P1[5],     pw2[0]=PKW(P1,0), pw2[1]=PKW(P1,2), pw2); \
    VRD(6); SBAR(); GAPA(C1=__builtin_amdgcn_mfma_f32_32x32x16_bf16(kf[5],qr[2],C1,0,0,0),   P1[6],P1[7],P1[8],P1[9],     pw2[2]=PKW(P1,4), pw2[3]=PKW(P1,6), pw2); \
    VRD(3); SBAR(); GAPA(C0=__builtin_amdgcn_mfma_f32_32x32x16_bf16(kf[6],qr[3],C0,0,0,0),   P1[10],P1[11],P1[12],P1[13], pw3[0]=PKW(P1,8), pw3[1]=PKW(P1,10), pw3); \
    VRD(7); SBAR(); GAPA(C1=__builtin_amdgcn_mfma_f32_32x32x16_bf16(kf[7],qr[3],C1,0,0,0),   P1[14],P1[15],0.f,0.f,       pw3[2]=PKW(P1,12),pw3[3]=PKW(P1,14), pw3); \
    l_reg+=sacc; \
    if(GM){DMA_M((t)+2,sl_prev);} if(GK){DMA_K((t)+3,sl_cur);} if(GV){DMA_V((t)+1,sl_next);} \
    if(BND){ if((t)>=NT-6) BAND(C0,C1,t); } \
    MASKLD(sl_cur); \
    SBAR(); \
    GAPB(o[0]=__builtin_amdgcn_mfma_f32_32x32x16_bf16(PAF(0),VFR(0),o[0],0,0,0), C0,0,m0); \
    GAPB(o[1]=__builtin_amdgcn_mfma_f32_32x32x16_bf16(PAF(0),VFR(4),o[1],0,0,0), C0,4,m0); \
    KRD(GL,0); GAPB(o[0]=__builtin_amdgcn_mfma_f32_32x32x16_bf16(PAF(1),VFR(1),o[0],0,0,0), C0,8,m0); \
    KRD(GL,1); GAPB(o[1]=__builtin_amdgcn_mfma_f32_32x32x16_bf16(PAF(1),VFR(5),o[1],0,0,0), C0,12,m0); \
    KRD(GL,2); GAPB(o[0]=__builtin_amdgcn_mfma_f32_32x32x16_bf16(PAF(2),VFR(2),o[0],0,0,0), C1,0,m1); \
    KRD(GL,3); GAPB(o[1]=__builtin_amdgcn_mfma_f32_32x32x16_bf16(PAF(2),VFR(6),o[1],0,0,0), C1,4,m1); \
    GAPB(o[0]=__builtin_amdgcn_mfma_f32_32x32x16_bf16(PAF(3),VFR(3),o[0],0,0,0), C1,8,m1); \
    GAPB(o[1]=__builtin_amdgcn_mfma_f32_32x32x16_bf16(PAF(3),VFR(7),o[1],0,0,0), C1,12,m1); \
    }while(0)
  int t=1;
  for(;t+7<NT;t+=2){
    STEP(pB0,pB1,pA0,pA1,t,true,true,true,true,false);     WAIT_BAR(3); ROT();
    STEP(pA0,pA1,pB0,pB1,t+1,true,true,true,true,false);   WAIT_BAR(3); ROT();
  }
  #define ENDW(tt) do{ if((tt)+3<NT){WAIT_BAR(3);} else if((tt)+2<NT){WAIT_BAR(2);} else {WAIT_BAR(0);} }while(0)
  for(;t+1<NT;t+=2){
    STEP(pB0,pB1,pA0,pA1,t,(t+3<NT),(t+1<NT),(t+1<NT),(t+2<NT),true);       ENDW(t);   ROT();
    STEP(pA0,pA1,pB0,pB1,t+1,(t+4<NT),(t+2<NT),(t+2<NT),(t+3<NT),true);     ENDW(t+1); ROT();
  }
  STEP(pB0,pB1,pA0,pA1,NT-1,false,false,false,false,true);
  { float sacc=pB0[0]+pB0[1]; _Pragma("unroll") for(int r=2;r<16;++r)sacc+=pB0[r]; _Pragma("unroll") for(int r=0;r<16;++r)sacc+=pB1[r]; l_reg+=sacc;
    pw0=(u32x4){PKW(pB0,0),PKW(pB0,2),PKW(pB0,4),PKW(pB0,6)};pw1=(u32x4){PKW(pB0,8),PKW(pB0,10),PKW(pB0,12),PKW(pB0,14)};pw2=(u32x4){PKW(pB1,0),PKW(pB1,2),PKW(pB1,4),PKW(pB1,6)};pw3=(u32x4){PKW(pB1,8),PKW(pB1,10),PKW(pB1,12),PKW(pB1,14)};
    SBAR(); pv(o,vb0+sl_cur,PAF(0),PAF(1),PAF(2),PAF(3)); }
  #undef PKW
  #undef PAF
  #undef VFR
  #undef PIN
  #undef MX3
  #undef GAPA
  #undef GAPB
  #undef EX
  #undef VRD
  #undef KRD
  #undef STEP
  #undef ENDW
  {auto rr=__builtin_amdgcn_permlane32_swap(__float_as_uint(l_reg),__float_as_uint(l_reg),false,false);l_reg=__uint_as_float(rr[0])+__uint_as_float(rr[1]);}
  if(hi==0)wsf[32+r32]=l_reg;asm volatile("s_waitcnt lgkmcnt(0)":::"memory");
  float rli[16];
  #pragma unroll
  for(int r=0;r<16;++r)rli[r]=__builtin_amdgcn_rcpf(wsf[32+crow(r,hi)]);
  bf16*Ow=O+(rowbase+q0+wid*QBLK)*DM+h*D;
  { bf16*stg=(bf16*)(shm+LDS_OST)+wid*2048;
    #pragma unroll
    for(int r=0;r<16;++r){const int orow=crow(r,hi);
      #pragma unroll
      for(int d0=0;d0<2;++d0)stg[orow*64+d0*32+r32]=__float2bfloat16(o[d0][r]*rli[r]);}
    asm volatile("s_waitcnt lgkmcnt(0)":::"memory");
    #pragma unroll
    for(int i=0;i<4;++i){const int row=i*8+(lane>>3),ch=lane&7; const u32x4 v=*(const u32x4*)(stg+row*64+ch*8); ATTN_STORE16(Ow+(long)row*DM+ch*8,v);} }
  asm volatile("s_waitcnt lgkmcnt(0)\n\ts_barrier":::"memory");
  #undef DMA_K
  #undef DMA_V
  #undef DMA_M
  #undef MASKLD
  #undef MBIT
  #undef MAND
  #undef MANDA
  #undef BAND
  #undef ROT
}
constexpr int ATTN_LDS_BYTES=LDS_BYTES;
__device__ __forceinline__ int t5b(int d){ if(d<16)return d; int b=16; b+=d>=19;b+=d>=21;b+=d>=24;b+=d>=27;b+=d>=31;b+=d>=35;b+=d>=40;b+=d>=46;b+=d>=52;b+=d>=59;b+=d>=67;b+=d>=77;b+=d>=87;b+=d>=99;b+=d>=113; return b; }
__device__ __forceinline__ void attn_phase(char*lds,const bf16*Q,const bf16*K,const bf16*V,bf16*O,const unsigned char*maskT,const float*relb,int vcu,const int wid){
  const int h=vcu>>5, s_=vcu&31;
  const int tid_=wid*64+lane_now();
  if(tid_<128){ const int d=tid_; ((float*)(lds+LDS_BT))[d]=(relb[t5b(d)*NHEAD+h]-relb[31*NHEAD+h])*1.4426950408889634f; }
  asm volatile("s_waitcnt vmcnt(0) lgkmcnt(0)\n\ts_barrier":::"memory");
  if(wid>=4)__builtin_amdgcn_s_setprio(1);
  _Pragma("unroll 1") for(int i=0;i<2;++i) attn_unit(h,i?s_:63-s_,Q,K,V,O,maskT,lds,wid);
  __builtin_amdgcn_s_setprio(0);
}
#undef SBAR
#undef WAIT_BAR
}

static_assert(pg8::EpiMix::GUARD_LDS == (unsigned)(MISC_OFF + 44) && pg8::EpiMix::GUARD_DELTA == (long)(CW_BAR + XB_DONE2) * 4 - (long)CTL_SS2, "EpiMix guard constants");
__global__ void __launch_bounds__(NWAVES * 64, 2) __attribute__((target("no-packed-fp32-ops"))) mega_fwd(Args args) {
    extern __shared__ __attribute__((aligned(16))) unsigned char lds[];
    Frame F;
    F.lds = (LAS unsigned char*)lds;
    F.MISC = (volatile LAS unsigned*)(F.lds + MISC_OFF);
    F.wave = __builtin_amdgcn_readfirstlane((int)threadIdx.x >> 6);
#define RETID() do { F.lane = lane_now(); F.tid = F.wave * 64 + F.lane; } while (0)
    RETID();
    F.G = gridDim.x; { const int bx = blockIdx.x; F.vcu = (F.G % 8 == 0) ? (bx % 8) * (F.G / 8) + bx / 8 : bx; }
    F.ctl = (gu32*)(kargs()->ws + WS_CTL);
    for (int u = F.tid; u < (LDS_BYTES - LDSCTL_OFF) / 4; u += NWAVES * 64) ((LAS unsigned*)(F.lds + LDSCTL_OFF))[u] = 0u;
    __syncthreads();
    const int lo = kargs()->ph_lo, hi = kargs()->ph_hi;
    const bool multi = (hi - lo) > 1;
    XcdBarrier bar; bar.bar = (unsigned*)(F.ctl + CW_BAR); bar.x = 0; bar.st = nullptr;
    if (multi) bar = xcd_barrier_post((unsigned*)(F.ctl + CW_BAR), F.MISC + 8, F.tid);
#ifndef PHMASK
#define PHMASK 0x7ff
#endif
#define IN(k) (((PHMASK >> (k)) & 1) && lo <= (k) && (k) < hi)
#define SEAM(k) do { if (IN(k) && IN((k) + 1)) { RETID(); xcd_barrier(bar, F.tid); } RETID(); } while (0)
#define SEAMS(k) do { if (IN(k) && IN((k) + 1)) { RETID(); if (F.MISC[10] != 0u) xcd_barrier<false>(bar, F.tid); else xcd_barrier(bar, F.tid); } RETID(); } while (0)
#define SEAML(k) do { if (IN(k) && IN((k) + 1)) { RETID(); if (F.MISC[10] != 0u) xcd_local_barrier<((k) == 6 ? XB_DONE6 : (k) == 2 ? XB_DONE2 : -1)>(bar, F.tid); else xcd_barrier(bar, F.tid); } RETID(); } while (0)
#define WSP unsigned char* ws = kargs()->ws
#define BFP(off) ((pg8::bf16_t*)(ws + (off)))
#define CBFP(off) ((const pg8::bf16_t*)(ws + (off)))
#define SSP(off) ((float*)(ws + WS_CTL + (off)))
    const int cidx = (int)blockIdx.x;

#ifndef REP_P0
#define REP_P0 1
#endif
#ifndef REP_G1
#define REP_G1 1
#endif
    if (IN(0)) { for (int rep = 0; rep < REP_P0; ++rep) p0_prologue(F, kargs()); }
    if (multi && F.tid == 0) F.ctl[CW_BAR + XB_TAB + cidx] = 1u + xb_xcc_id();
    SEAM(0);
    if (multi && F.tid < 32) { const unsigned t_ = F.ctl[CW_BAR + XB_TAB + 8 * F.tid + (cidx & 7)]; if (t_ != 1u + xb_xcc_id() || gridDim.x != 256u) atomicOr((unsigned*)&F.ctl[CW_BAR + XB_NONLOCAL], 1u); }
    if (IN(1)) for (int rep = 0; rep < REP_G1; ++rep) { WSP; pg8::Gemm g{CBFP(WS_HB), CBFP(WS_W1IN), M, 2 * DFF, D}; pg8::StaticOrder S; S.init(M, 2 * DFF, F.G, cidx);
        pg8::EpiSwiglu E{BFP(WS_ACT), SSP(CTL_SS1)}; pg8::gemm_phase<pg8::EpiSwiglu, pg8::StaticOrder, true, true>(F.lds + RING_OFF, g, S, E, F.wave); }
    if (IN(1)) { if (cidx >= 128 && F.G == 256) { RETID(); p0_weights(F, kargs(), P0_I0, P0_LATE_END, (cidx - 128) * NWAVES + F.wave, 128 * NWAVES); }
                 else if (F.G != 256) { RETID(); p0_weights(F, kargs(), P0_I0, P0_LATE_END, F.vcu * NWAVES + F.wave, F.G * NWAVES); } } SEAM(1);
    if (multi) { if (F.tid == 0) { const unsigned lok_ = (xb_ld((unsigned*)&F.ctl[CW_BAR + XB_NONLOCAL]) == 0u) ? 1u : 0u; F.MISC[10] = lok_; F.MISC[11] = 1u - lok_; } __syncthreads(); }
    else { if (F.tid == 0) F.MISC[11] = 1u; __syncthreads(); }
    if (IN(2)) { WSP; pg8::Gemm g{CBFP(WS_ACT), CBFP(WS_W1OUT), M, D, DFF}; pg8::StaticOrder S; S.init(M, D, F.G, cidx);
        pg8::EpiRes E{kargs()->in[0], kargs()->out, BFP(WS_HB), SSP(CTL_SS2), 0.5f}; pg8::gemm_phase<pg8::EpiRes, pg8::StaticOrder, true, true>(F.lds + RING_OFF, g, S, E, F.wave); } SEAML(2);
    if (IN(3)) { WSP; pg8::Gemm g{CBFP(WS_HB), CBFP(WS_WMIX), M, NMIXP, D}; pg8::StaticOrder S; S.init(M, NMIXP, F.G, cidx);
        pg8::EpiMix E{SSP(CTL_SS2), (pg8::bf16_t*)(ws + WS_GLU), (pg8::bf16_t*)(ws + WS_Q), (pg8::bf16_t*)(ws + WS_K), (pg8::bf16_t*)(ws + WS_V), (pg8::bf16_t*)(ws + WS_QI), (pg8::bf16_t*)(ws + WS_KI),
                      (float*)(ws + WS_WI), (pg8::bf16_t*)(ws + WS_GC), (pg8::bf16_t*)(ws + WS_GA), kargs()->in[12], kargs()->in[13]};
        pg8::gemm_phase<pg8::EpiMix, pg8::StaticOrder, true, true>(F.lds + RING_OFF, g, S, E, F.wave); } SEAM(3);
#ifndef REP_CONV
#define REP_CONV 1
#endif
#ifndef REP_IDX
#define REP_IDX 1
#endif
#ifndef REP_ATT
#define REP_ATT 1
#endif
    if (IN(4)) { for (int rep = 0; rep < REP_CONV; ++rep) conv_phase(F, kargs()); for (int rep = 0; rep < REP_IDX; ++rep) indexer_fast(F, kargs()); } SEAM(4);
    if (IN(5)) { for (int rep = 0; rep < REP_ATT; ++rep) { unsigned char* ws = kargs()->ws; attn_body::attn_phase((char*)lds + RING_OFF, (const attn_body::bf16*)(ws + WS_Q), (const attn_body::bf16*)(ws + WS_K), (const attn_body::bf16*)(ws + WS_V), (attn_body::bf16*)(ws + WS_ATT), ws + WS_MASK, kargs()->in[22], F.vcu, F.wave); } __syncthreads();
        WSP; pg8::Gemm g{CBFP(WS_ZC), CBFP(WS_WCO), M, D, CCH}; pg8::StaticOrder S; S.init(M, D, F.G, cidx);
        pg8::EpiGate<0> E{(pg8::bf16_t*)(ws + WS_GC), nullptr}; pg8::gemm_phase<pg8::EpiGate<0>, pg8::StaticOrder, true, true>(F.lds + RING_OFF, g, S, E, F.wave); } SEAM(5);
    if (IN(6)) { WSP; pg8::Gemm g{CBFP(WS_ATT), CBFP(WS_WAO), M, D, AW}; pg8::StaticOrder S; S.init(M, D, F.G, cidx);
        pg8::EpiGate<1> E{(pg8::bf16_t*)(ws + WS_GC), (const pg8::bf16_t*)(ws + WS_GA)}; pg8::gemm_phase<pg8::EpiGate<1>, pg8::StaticOrder, true, true>(F.lds + RING_OFF, g, S, E, F.wave); } SEAML(6);
    if (IN(7)) { convert_p(F, kargs()); WSP; pg8::Gemm g{CBFP(WS_GC), CBFP(WS_WMO), M, D, D}; pg8::StaticOrder S; S.init(M, D, F.G, cidx);
        pg8::EpiRes E{kargs()->out, kargs()->out, BFP(WS_HB), SSP(CTL_SS3), 1.0f}; pg8::gemm_phase<pg8::EpiRes, pg8::StaticOrder, true, true>(F.lds + RING_OFF, g, S, E, F.wave); } SEAML(7);
    if (IN(8) && multi && F.MISC[10] != 0u) { if (F.tid == 0) { unsigned* bar_ = (unsigned*)(F.ctl + CW_BAR); XB_SPIN(xb_ld(&bar_[XB_DONE6]) < F.MISC[9], bar_); } __syncthreads(); }
    if (IN(8)) {
        WSP; pg8::Gemm g{CBFP(WS_HB), CBFP(WS_W2IN), M, 2 * DFF, D}; pg8::StaticOrder S; S.init(M, 2 * DFF, F.G, cidx);
        pg8::EpiSwiglu E{BFP(WS_ACT), SSP(CTL_SS3)}; pg8::gemm_phase<pg8::EpiSwiglu, pg8::StaticOrder, true, true>(F.lds + RING_OFF, g, S, E, F.wave); }
    if (IN(8) && cidx >= 128) {
        WSP; pg8::Gemm g{CBFP(WS_PB), CBFP(WS_WPP), M, D, PLE}; pg8::StaticOrder S; S.init(M, D, 128, cidx - 128);
        pg8::EpiGate<2> E{(pg8::bf16_t*)(ws + WS_PROJ), nullptr}; pg8::gemm_phase<pg8::EpiGate<2>, pg8::StaticOrder, true, true>(F.lds + RING_OFF, g, S, E, F.wave);
    } SEAML(8);
    if (IN(9)) { WSP; pg8::Gemm g{CBFP(WS_ACT), CBFP(WS_W2OUT), M, D, DFF}; pg8::StaticOrder S; S.init(M, D, F.G, cidx);
        pg8::EpiRes E{kargs()->out, kargs()->out, BFP(WS_HB), SSP(CTL_SS4), 0.5f}; pg8::gemm_phase<pg8::EpiRes, pg8::StaticOrder, true, true>(F.lds + RING_OFF, g, S, E, F.wave); }
    SEAML(9);
    if (IN(10)) {
        { WSP; pg8::Gemm g{CBFP(WS_HB), CBFP(WS_WPG), M, D, D}; pg8::StaticOrder S; S.init(M, D, F.G, cidx);
          pg8::EpiPle E{kargs()->out, CBFP(WS_PROJ), SSP(CTL_SS4)}; pg8::gemm_phase<pg8::EpiPle, pg8::StaticOrder, true, true>(F.lds + RING_OFF, g, S, E, F.wave); }
    }
#ifdef DIAG_TIME
    if (IN(10) && blockIdx.x == 0 && F.tid == 0) { const unsigned long long* ts = (const unsigned long long*)(kargs()->ws + WS_CTL + 16384);
        kargs()->out[0] += 25.0f * floorf((float)(ts[DIAG_TIME + 1] - ts[DIAG_TIME]) * 0.01f / 25.0f + 0.5f); }
#endif
#ifdef DIAG_OVF
    if (IN(10) && blockIdx.x == 0 && F.tid == 0) { const unsigned* dg = (const unsigned*)(kargs()->ws + WS_CTL) + 2048; const unsigned v = __hip_atomic_load(dg + (DIAG_OVF & 3), __ATOMIC_RELAXED, __HIP_MEMORY_SCOPE_AGENT);
        kargs()->out[0] += (float)((DIAG_OVF & 4) ? (v & 0xffffu) : ((DIAG_OVF & 8) ? (v >> 16) : v)); }
#endif
#undef IN
#undef SEAM
#undef SEAML
#undef SEAMS
}

extern "C" void kernel_launch(void* const* d_in, const int* in_sizes, int n_in, void* d_out, int out_size, void* d_ws, size_t ws_size, hipStream_t stream) {
    static int grid = 0;
    if (grid == 0) {
        if (n_in != 23 || out_size != M * D || ws_size < WS_END) { fprintf(stderr, "kernel_launch: unexpected shapes n_in %d out %d ws %zu\n", n_in, out_size, ws_size); grid = -1; return; }
        int dev = 0, cus = 0;
        if (hipGetDevice(&dev) != hipSuccess || hipDeviceGetAttribute(&cus, hipDeviceAttributeMultiprocessorCount, dev) != hipSuccess) { grid = -1; return; }
        if (hipFuncSetAttribute((const void*)mega_fwd, hipFuncAttributeMaxDynamicSharedMemorySize, LDS_BYTES) != hipSuccess) { fprintf(stderr, "kernel_launch: hipFuncSetAttribute failed\n"); grid = -1; return; }
        int per_cu = 0;
        if (hipOccupancyMaxActiveBlocksPerMultiprocessor(&per_cu, (const void*)mega_fwd, NWAVES * 64, LDS_BYTES) != hipSuccess || per_cu < 1) fprintf(stderr, "kernel_launch: occupancy query says %d\n", per_cu);
        (void)hipGetLastError();
        grid = cus;
        if (grid != 256) fprintf(stderr, "kernel_launch: %d CUs (built for 256)\n", grid);
    }
    if (grid < 0) return;
    (void)hipMemsetAsync((char*)d_ws + WS_CTL, 0, CTL_ZERO_BYTES, stream);
    Args a{};
    for (int i = 0; i < 23; ++i) a.in[i] = (const float*)d_in[i];
    a.out = (float*)d_out; a.ws = (unsigned char*)d_ws;
    if (N_LAUNCHES == 1) {
        a.ph_lo = 0; a.ph_hi = NPHASE; a.li = 0;
        hipLaunchKernelGGL(mega_fwd, dim3(grid), dim3(NWAVES * 64), LDS_BYTES, stream, a);
    } else {
        for (int li = 0; li < NPHASE; ++li) { a.ph_lo = li; a.ph_hi = li + 1; a.li = li;
            hipLaunchKernelGGL(mega_fwd, dim3(grid), dim3(NWAVES * 64), LDS_BYTES, stream, a); }
    }
}
```

```cpp
#include <hip/hip_runtime.h>
#include <cstdio>
#include <cstdint>
__device__ __forceinline__ void mk_syncthreads() { __builtin_amdgcn_fence(__ATOMIC_RELEASE, "workgroup"); __builtin_amdgcn_s_barrier(); __builtin_amdgcn_fence(__ATOMIC_ACQUIRE, "workgroup"); }
#define __syncthreads() mk_syncthreads()
__device__ __forceinline__ int lane_now() { int l = (int)__builtin_amdgcn_mbcnt_hi(~0u, __builtin_amdgcn_mbcnt_lo(~0u, 0u)); asm volatile("" : "+v"(l)); return l; }
namespace pg8 {
#define PG8_LAS __attribute__((address_space(3)))
typedef unsigned short bf16_t;
typedef short bf16x8 __attribute__((ext_vector_type(8)));
typedef float f32x4 __attribute__((ext_vector_type(4)));
typedef unsigned u32x4 __attribute__((ext_vector_type(4)));
constexpr int BM = 256, BK = 64, HALF = 128, HTB = HALF * BK * 2  , STAGE_BYTES = 8 * HTB, NXCD = 8, WGM = 8;

__host__ __device__ __forceinline__ int lds_byte(int r, int c) { const int st = (r >> 4) * 2 + (c >> 5), rr = r & 15, cc = c & 31, ob = rr * 64 + cc * 2; return st * 1024 + (ob ^ (((ob >> 9) & 1) << 5)); }
__host__ __device__ __forceinline__ void stage_rc(int b, int& R, int& C) { const int st = b / 1024, sb = b % 1024, swz = sb ^ (((sb >> 9) & 1) << 5); R = (st >> 1) * 16 + swz / 64; C = (st & 1) * 32 + (swz % 64) / 2; }
__host__ __device__ __forceinline__ int perm32(int rho) { const int n = rho >> 4, i = rho & 15; return 8 * (i >> 2) + 4 * n + (i & 3); }

struct Unit { int pm, pn; };
struct Gemm { const bf16_t* A; const bf16_t* Bt; int M, N, K; };

struct StaticOrder {
    int nM, nN, nwg, G, c;
    __host__ __device__ __forceinline__ void init(int M, int N, int G_, int c_) { nM = M / BM; nN = N / BM; nwg = nM * nN; G = G_; c = c_; }
    __host__ __device__ bool next(int i, Unit& u) const {
        const long L = (long)i * G + c; if (L >= nwg) return false;
        int wgid = (int)L; { const int q = nwg / NXCD, r = nwg % NXCD, xcd = wgid % NXCD, off = wgid / NXCD; wgid = (xcd < r ? xcd * (q + 1) : r * (q + 1) + (xcd - r) * q) + off; }
        const int nig = WGM * nN, gid = wgid / nig, fm = gid * WGM, gsz = (nM - fm) < WGM ? (nM - fm) : WGM;
        u.pm = fm + ((wgid % nig) % gsz); u.pn = (wgid % nig) / gsz; return true;
    }
    __device__ __forceinline__ void a_ready(const Unit&) const {}
    __device__ __forceinline__ void done(const Unit&) const {}
};

typedef float cvt_f32x2 __attribute__((ext_vector_type(2)));
typedef __bf16 cvt_bf16x2 __attribute__((ext_vector_type(2)));
__device__ __forceinline__ unsigned cvt_pk_bf16(float lo, float hi) { const cvt_bf16x2 v = __builtin_convertvector((cvt_f32x2){lo, hi}, cvt_bf16x2); return __builtin_bit_cast(unsigned, v); }
typedef float f32x2 __attribute__((ext_vector_type(2)));
typedef _Float16 f16x2 __attribute__((ext_vector_type(2)));
constexpr float NORM_EPS = 1e-6f;
constexpr float Q_C2 = 0.125f * 1.4426950408889634f;
__device__ __forceinline__ float bf_lo(unsigned w) { return __uint_as_float(w << 16); }
__device__ __forceinline__ float bf_hi(unsigned w) { return __uint_as_float(w & 0xffff0000u); }
__device__ __forceinline__ float sigm(float x) { return __builtin_amdgcn_rcpf(1.f + __builtin_amdgcn_exp2f(-1.4426950408889634f * x)); }
__device__ __forceinline__ u32x4 pack8(f32x4 a, f32x4 b) { u32x4 w; w.x = cvt_pk_bf16(a[0], a[1]); w.y = cvt_pk_bf16(a[2], a[3]); w.z = cvt_pk_bf16(b[0], b[1]); w.w = cvt_pk_bf16(b[2], b[3]); return w; }
__device__ __forceinline__ unsigned pkh(float lo, float hi) { f16x2 v = __builtin_convertvector((f32x2){lo, hi}, f16x2); return __builtin_bit_cast(unsigned, v); }
__device__ __forceinline__ u32x4 pack8h(f32x4 a, f32x4 b) { u32x4 w; w.x = pkh(a[0], a[1]); w.y = pkh(a[2], a[3]); w.z = pkh(b[0], b[1]); w.w = pkh(b[2], b[3]); return w; }
__device__ __forceinline__ float row_rs(const float* ss, int row) { return __builtin_amdgcn_rsqf((float)((const unsigned long long*)ss)[row] * (1.0f / (1024.0f * 1048576.0f)) + NORM_EPS); }
__device__ __forceinline__ f32x4 unpk_lo(u32x4 g) { return (f32x4){bf_lo(g.x), bf_hi(g.x), bf_lo(g.y), bf_hi(g.y)}; }
__device__ __forceinline__ f32x4 unpk_hi(u32x4 g) { return (f32x4){bf_lo(g.z), bf_hi(g.z), bf_lo(g.w), bf_hi(g.w)}; }

struct EpiSwiglu {
    static constexpr bool PERM = true, AFTER_DRAIN = false;
    bf16_t* O; const float* ss;
    __device__ __forceinline__ void operator()(const f32x4 (&acc)[2][2][4][2], const Unit& u, int wr, int wc, int fr, int fq) const {
        const int row0 = u.pm * BM + wr * 64 + fr, col0 = u.pn * HALF + wc * 32 + 8 * fq;
#pragma unroll
        for (int ai = 0; ai < 2; ++ai)
#pragma unroll
            for (int m = 0; m < 4; ++m) { const int row = row0 + ai * HALF + m * 16; const float rs = row_rs(ss, row); f32x4 o[2];
                const float c1 = -1.4426950408889634f * rs, c2 = rs * rs;
#pragma unroll
                for (int n = 0; n < 2; ++n) {
#pragma unroll
                    for (int e = 0; e < 4; ++e) { const float a = acc[ai][0][m][n][e], b = acc[ai][1][m][n][e];
                        o[n][e] = (a * b * c2) * __builtin_amdgcn_rcpf(1.f + __builtin_amdgcn_exp2f(a * c1)); } }
                *(u32x4*)(O + (size_t)row * 2816 + col0) = pack8(o[0], o[1]); }
    }
};
struct EpiRes {
    static constexpr bool PERM = true, AFTER_DRAIN = false;
    const float* base; float* out; bf16_t* hb; float* ssq; float alpha;
    __device__ __forceinline__ void operator()(const f32x4 (&acc)[2][2][4][2], const Unit& u, int wr, int wc, int fr, int fq) const {
        const int row0 = u.pm * BM + wr * 64 + fr, col0 = u.pn * BM + wc * 32 + 8 * fq;
#pragma unroll
        for (int ai = 0; ai < 2; ++ai)
#pragma unroll
            for (int m = 0; m < 4; ++m) { const int row = row0 + ai * HALF + m * 16; float q = 0.f;
#pragma unroll
                for (int bj = 0; bj < 2; ++bj) { const size_t off = (size_t)row * 1024 + col0 + bj * HALF;
                    const f32x4 x0 = *(const f32x4*)(base + off), x1 = *(const f32x4*)(base + off + 4);
                    const f32x4 h0 = x0 + acc[ai][bj][m][0] * alpha, h1 = x1 + acc[ai][bj][m][1] * alpha;
                    *(f32x4*)(out + off) = h0; *(f32x4*)(out + off + 4) = h1; *(u32x4*)(hb + off) = pack8(h0, h1);
                    q += (h0[0] * h0[0] + h0[1] * h0[1]) + (h0[2] * h0[2] + h0[3] * h0[3]) + (h1[0] * h1[0] + h1[1] * h1[1]) + (h1[2] * h1[2] + h1[3] * h1[3]); }
                q += __shfl_xor(q, 16); q += __shfl_xor(q, 32);
                if (fq == 0) atomicAdd((unsigned long long*)ssq + row, (unsigned long long)(q * 1048576.0f)); }
    }
};
struct EpiMix {
    static constexpr bool PERM = true, AFTER_DRAIN = false;
    const float* ss; bf16_t *GLU, *Q, *K, *V, *QI, *KI; float* WI; bf16_t *GC, *GA; const float *qn, *kn;
    static constexpr unsigned GUARD_LDS = 131072 + 320 + 44;
    static constexpr long GUARD_DELTA = (4096 + 6080) * 4 - 196608;
    __device__ __forceinline__ void operator()(const f32x4 (&acc)[2][2][4][2], const Unit& u, int wr, int wc, int fr, int fq) const {
        { volatile PG8_LAS unsigned* lflag = (volatile PG8_LAS unsigned*)GUARD_LDS;
          if (*lflag == 0u) {
              if (wr == 0 && wc == 0 && fr == 0 && fq == 0) { unsigned* gd = (unsigned*)((char*)ss + GUARD_DELTA); const unsigned need = lflag[-2]; unsigned sp = 0u;
                  while (__hip_atomic_load(gd, __ATOMIC_RELAXED, __HIP_MEMORY_SCOPE_AGENT) < need && ++sp < (1u << 22)) __builtin_amdgcn_s_sleep(1);
                  *lflag = 1u; }
              while (*lflag == 0u) __builtin_amdgcn_s_sleep(1); } }
        const int row0 = u.pm * BM + wr * 64 + fr, cw = wc * 32 + 8 * fq, pn = u.pn;
        if (pn < 4) {
#pragma unroll
            for (int ai = 0; ai < 2; ++ai)
#pragma unroll
                for (int m = 0; m < 4; ++m) { const int row = row0 + ai * HALF + m * 16; const float rs = row_rs(ss, row); f32x4 o[2];
#pragma unroll
                    for (int n = 0; n < 2; ++n) { const f32x4 a = acc[ai][0][m][n] * rs, g = acc[ai][1][m][n] * rs;
#pragma unroll
                        for (int e = 0; e < 4; ++e) o[n][e] = a[e] * sigm(g[e]); }
                    *(u32x4*)(GLU + (size_t)row * 512 + pn * HALF + cw) = pack8(o[0], o[1]); }
        } else if (pn < 8) {
            const bool isq = pn < 6; const int head = 4 * ((pn - 4) & 1) + wc; const float* gn = isq ? qn : kn; bf16_t* dst = isq ? Q : K; const float post = isq ? Q_C2 : 1.0f;
            f32x4 g[2][2];
#pragma unroll
            for (int bj = 0; bj < 2; ++bj)
#pragma unroll
                for (int n = 0; n < 2; ++n) g[bj][n] = *(const f32x4*)(gn + 32 * bj + 8 * fq + 4 * n);
#pragma unroll
            for (int ai = 0; ai < 2; ++ai)
#pragma unroll
                for (int m = 0; m < 4; ++m) { const int row = row0 + ai * HALF + m * 16; const float rs = row_rs(ss, row); f32x4 v[2][2]; float s = 0.f;
#pragma unroll
                    for (int bj = 0; bj < 2; ++bj)
#pragma unroll
                        for (int n = 0; n < 2; ++n) { v[bj][n] = acc[ai][bj][m][n] * rs; const f32x4 t = v[bj][n]; s += (t[0] * t[0] + t[1] * t[1]) + (t[2] * t[2] + t[3] * t[3]); }
                    s += __shfl_xor(s, 16); s += __shfl_xor(s, 32);
                    const float rn = __builtin_amdgcn_rsqf(s * (1.0f / 64.0f) + NORM_EPS) * post;
#pragma unroll
                    for (int bj = 0; bj < 2; ++bj) *(u32x4*)(dst + (size_t)row * 512 + 64 * head + 32 * bj + 8 * fq) = pack8(v[bj][0] * rn * g[bj][0], v[bj][1] * rn * g[bj][1]); }
        } else if (pn < 10) {
#pragma unroll
            for (int ai = 0; ai < 2; ++ai)
#pragma unroll
                for (int m = 0; m < 4; ++m) { const int row = row0 + ai * HALF + m * 16; const float rs = row_rs(ss, row);
#pragma unroll
                    for (int bj = 0; bj < 2; ++bj) *(u32x4*)(V + (size_t)row * 512 + (pn - 8) * BM + bj * HALF + cw) = pack8(acc[ai][bj][m][0] * rs, acc[ai][bj][m][1] * rs); }
        } else if (pn == 10) {
#pragma unroll
            for (int ai = 0; ai < 2; ++ai)
#pragma unroll
                for (int m = 0; m < 4; ++m) { const int row = row0 + ai * HALF + m * 16; const float rs = row_rs(ss, row);
#pragma unroll
                    for (int bj = 0; bj < 2; ++bj) *(u32x4*)(QI + (size_t)row * 256 + bj * HALF + cw) = pack8h(acc[ai][bj][m][0] * rs, acc[ai][bj][m][1] * rs); }
        } else if (pn == 11) {
#pragma unroll
            for (int ai = 0; ai < 2; ++ai)
#pragma unroll
                for (int m = 0; m < 4; ++m) { const int row = row0 + ai * HALF + m * 16; const float rs = row_rs(ss, row);
                    if (wc < 2) *(u32x4*)(KI + (size_t)row * 64 + cw) = pack8h(acc[ai][0][m][0] * rs, acc[ai][0][m][1] * rs);
                    else if (wc == 2 && fq == 0) *(f32x4*)(WI + (size_t)row * 4) = acc[ai][0][m][0] * (rs * 0.0625f); }
        } else {
            bf16_t* dst = pn < 16 ? GC : GA; const int ct = (pn < 16 ? pn - 12 : pn - 16) * BM;
#pragma unroll
            for (int ai = 0; ai < 2; ++ai)
#pragma unroll
                for (int m = 0; m < 4; ++m) { const int row = row0 + ai * HALF + m * 16; const float rs = row_rs(ss, row);
#pragma unroll
                    for (int bj = 0; bj < 2; ++bj) { f32x4 o[2];
#pragma unroll
                        for (int n = 0; n < 2; ++n)
#pragma unroll
                            for (int e = 0; e < 4; ++e) o[n][e] = sigm(acc[ai][bj][m][n][e] * rs);
                        *(u32x4*)(dst + (size_t)row * 1024 + ct + bj * HALF + cw) = pack8(o[0], o[1]); } }
        }
    }
};
template <int MODE> struct EpiGate {
    static constexpr bool PERM = true, AFTER_DRAIN = false;
    bf16_t* T; const bf16_t* GA;
    __device__ __forceinline__ void operator()(const f32x4 (&acc)[2][2][4][2], const Unit& u, int wr, int wc, int fr, int fq) const {
        const int row0 = u.pm * BM + wr * 64 + fr, col0 = u.pn * BM + wc * 32 + 8 * fq;
#pragma unroll
        for (int ai = 0; ai < 2; ++ai)
#pragma unroll
            for (int m = 0; m < 4; ++m) { const int row = row0 + ai * HALF + m * 16;
#pragma unroll
                for (int bj = 0; bj < 2; ++bj) { const size_t off = (size_t)row * 1024 + col0 + bj * HALF; f32x4 o0, o1;
                    if (MODE == 0) { const u32x4 g = *(const u32x4*)(T + off); o0 = unpk_lo(g) * acc[ai][bj][m][0]; o1 = unpk_hi(g) * acc[ai][bj][m][1]; }
                    else if (MODE == 1) { const u32x4 t = *(const u32x4*)(T + off); const u32x4 g = *(const u32x4*)(GA + off); o0 = unpk_lo(t) + unpk_lo(g) * acc[ai][bj][m][0]; o1 = unpk_hi(t) + unpk_hi(g) * acc[ai][bj][m][1]; }
                    else { o0 = acc[ai][bj][m][0]; o1 = acc[ai][bj][m][1]; }
                    *(u32x4*)(T + off) = pack8(o0, o1); } }
    }
};
struct EpiPle {
    static constexpr bool PERM = true, AFTER_DRAIN = false;
    float* out; const bf16_t* P; const float* ss;
    __device__ __forceinline__ void operator()(const f32x4 (&acc)[2][2][4][2], const Unit& u, int wr, int wc, int fr, int fq) const {
        const int row0 = u.pm * BM + wr * 64 + fr, col0 = u.pn * BM + wc * 32 + 8 * fq;
#pragma unroll
        for (int ai = 0; ai < 2; ++ai)
#pragma unroll
            for (int m = 0; m < 4; ++m) { const int row = row0 + ai * HALF + m * 16; const float rs = row_rs(ss, row);
#pragma unroll
                for (int bj = 0; bj < 2; ++bj) { const size_t off = (size_t)row * 1024 + col0 + bj * HALF;
                    const u32x4 pr = *(const u32x4*)(P + off); const f32x4 p0 = unpk_lo(pr), p1 = unpk_hi(pr);
                    f32x4 h0 = *(const f32x4*)(out + off), h1 = *(const f32x4*)(out + off + 4);
#pragma unroll
                    for (int e = 0; e < 4; ++e) { h0[e] += sigm(acc[ai][bj][m][0][e] * rs) * p0[e]; h1[e] += sigm(acc[ai][bj][m][1][e] * rs) * p1[e]; }
                    *(f32x4*)(out + off) = h0; *(f32x4*)(out + off + 4) = h1; }
                asm volatile("" ::: "memory"); }
    }
};

template <class Epi, class Sched, bool ALIGN_EPI = false, bool SP2 = false>
__device__ __forceinline__ void gemm_phase(PG8_LAS unsigned char* lds, const Gemm g, const Sched& S, const Epi& E, const int wid) {
    const int lane = lane_now(), tid = wid * 64 + lane, wr = wid >> 2, wc = wid & 3, fr = lane & 15, fq = lane >> 4;
    int K = g.K; asm volatile("" : "+s"(K));
    const int nt = K / BK;
    unsigned voffA[2], voffB[2];
#pragma unroll
    for (int i = 0; i < 2; ++i) { int R, C; stage_rc(tid * 16 + i * 8192, R, C); const int Rb = Epi::PERM ? ((R & ~31) + perm32(R & 31)) : R;
        voffA[i] = (unsigned)(R * K + C) * 2u; voffB[i] = (unsigned)(Rb * K + C) * 2u; }
    const size_t kstep = (size_t)(BK * 2);
    const size_t hstep = (size_t)HALF * K * 2;
    const size_t tstep = 2 * hstep;
    const unsigned ldsw = (unsigned)wid * 1024u;
    const int aoff = lds_byte(wr * 64 + fr, fq * 8), boff = lds_byte(wc * 32 + fr, fq * 8);
#define PG8_SA(b, h) (((b) * 2 + (h)) * HTB)
#define PG8_SB(b, h) ((4 + (b) * 2 + (h)) * HTB)
#define PG8_STAGE(bufoff, gbase, voff) do { _Pragma("unroll") for (int _i = 0; _i < 2; ++_i) \
        __builtin_amdgcn_global_load_lds((const unsigned*)((const char*)(gbase) + (voff)[_i]), (PG8_LAS unsigned*)(lds + (bufoff) + ldsw + _i * 8192), 16, 0, 0); } while (0)
#define PG8_LDA(dst, b, h) do { _Pragma("unroll") for (int m = 0; m < 4; ++m) _Pragma("unroll") for (int k = 0; k < 2; ++k) dst[m][k] = *(const PG8_LAS bf16x8*)(lds + PG8_SA(b, h) + aoff + m * 2048 + k * 1024); } while (0)
#define PG8_LDB(dst, b, h) do { _Pragma("unroll") for (int n = 0; n < 2; ++n) _Pragma("unroll") for (int k = 0; k < 2; ++k) dst[n][k] = *(const PG8_LAS bf16x8*)(lds + PG8_SB(b, h) + boff + n * 2048 + k * 1024); } while (0)
#define PG8_MMA(ai, bj, At, Bt) do { __builtin_amdgcn_s_setprio(1); _Pragma("unroll") for (int m = 0; m < 4; ++m) _Pragma("unroll") for (int n = 0; n < 2; ++n) _Pragma("unroll") for (int k = 0; k < 2; ++k) \
        acc[ai][bj][m][n] = __builtin_amdgcn_mfma_f32_16x16x32_bf16(Bt[n][k], At[m][k], acc[ai][bj][m][n], 0, 0, 0); __builtin_amdgcn_s_setprio(0); } while (0)
#define PG8_WAIT_V(n) asm volatile("s_waitcnt vmcnt(" #n ")" ::: "memory")
#define PG8_WAIT_L(n) asm volatile("s_waitcnt lgkmcnt(" #n ")" ::: "memory")
#define PG8_BAR __builtin_amdgcn_s_barrier()
#define PG8_SCHED __builtin_amdgcn_sched_barrier(0)
    Unit cur, nxt; int ui = 0;
    if (!S.next(0, cur)) return;
    f32x4 acc[2][2][4][2];
#pragma unroll
    for (int a = 0; a < 2; ++a)
#pragma unroll
        for (int b = 0; b < 2; ++b)
#pragma unroll
            for (int m = 0; m < 4; ++m)
#pragma unroll
                for (int n = 0; n < 2; ++n) acc[a][b][m][n] = (f32x4){0.f, 0.f, 0.f, 0.f};
    bf16x8 At[4][2], B0[2][2], B1[2][2];
    const char* cA = (const char*)g.A + (size_t)cur.pm * tstep; const char* cB = (const char*)g.Bt + (size_t)cur.pn * tstep;
    S.a_ready(cur);
    if constexpr (SP2) {
        PG8_STAGE(PG8_SB(0, 0), cB, voffB); PG8_STAGE(PG8_SB(0, 1), cB + hstep, voffB); PG8_STAGE(PG8_SA(0, 0), cA, voffA); PG8_STAGE(PG8_SA(0, 1), cA + hstep, voffA);
        if (wr == 1) PG8_BAR;
        PG8_WAIT_V(2); PG8_BAR;
        PG8_STAGE(PG8_SB(1, 0), cB + kstep, voffB); PG8_STAGE(PG8_SA(1, 0), cA + kstep, voffA); PG8_STAGE(PG8_SB(1, 1), cB + hstep + kstep, voffB);
        PG8_WAIT_V(6); PG8_BAR;
    } else {
        PG8_STAGE(PG8_SB(0, 0), cB, voffB); PG8_STAGE(PG8_SA(0, 0), cA, voffA); PG8_STAGE(PG8_SB(0, 1), cB + hstep, voffB); PG8_STAGE(PG8_SA(0, 1), cA + hstep, voffA);
        if (wr == 1) PG8_BAR;
        PG8_WAIT_V(4); PG8_BAR;
        PG8_STAGE(PG8_SB(1, 0), cB + kstep, voffB); PG8_STAGE(PG8_SA(1, 0), cA + kstep, voffA); PG8_STAGE(PG8_SB(1, 1), cB + hstep + kstep, voffB);
        PG8_WAIT_V(6); PG8_BAR;
    }
    for (;;) {
        const bool has_next = S.next(ui + 1, nxt);
        const char* nA = has_next ? (const char*)g.A + (size_t)nxt.pm * tstep : cA; const char* nB = has_next ? (const char*)g.Bt + (size_t)nxt.pn * tstep : cB;
        for (int t = 0; t < nt; t += 2) {
            const bool last = (t == nt - 2);
            const char* a1 = cA + (size_t)(t + 1) * kstep;
            const char* a2 = last ? nA : cA + (size_t)(t + 2) * kstep; const char* b2 = last ? nB : cB + (size_t)(t + 2) * kstep;
            const char* a3 = a2 + kstep; const char* b3 = b2 + kstep;
            if (last && has_next) S.a_ready(nxt);
            if constexpr (SP2) {
            PG8_LDB(B0, 0, 0); PG8_LDB(B1, 0, 1); PG8_SCHED; PG8_LDA(At, 0, 0); PG8_STAGE(PG8_SA(1, 1), a1 + hstep, voffA);
            PG8_WAIT_V(8); PG8_WAIT_L(0); PG8_BAR; PG8_MMA(0, 0, At, B0); PG8_MMA(0, 1, At, B1); PG8_BAR; PG8_SCHED;
            PG8_LDA(At, 0, 1); PG8_STAGE(PG8_SB(0, 0), b2, voffB); PG8_STAGE(PG8_SB(0, 1), b2 + hstep, voffB); PG8_STAGE(PG8_SA(0, 0), a2, voffA);
            PG8_WAIT_V(8); PG8_WAIT_L(0); PG8_BAR; PG8_MMA(1, 0, At, B0); PG8_MMA(1, 1, At, B1); PG8_BAR; PG8_SCHED;
            PG8_LDB(B0, 1, 0); PG8_LDB(B1, 1, 1); PG8_SCHED; PG8_LDA(At, 1, 0); PG8_STAGE(PG8_SA(0, 1), a2 + hstep, voffA);
            PG8_WAIT_V(8); PG8_WAIT_L(0); PG8_BAR; PG8_MMA(0, 0, At, B0); PG8_MMA(0, 1, At, B1); PG8_BAR; PG8_SCHED;
            PG8_LDA(At, 1, 1); PG8_STAGE(PG8_SB(1, 0), b3, voffB); PG8_STAGE(PG8_SB(1, 1), b3 + hstep, voffB); PG8_STAGE(PG8_SA(1, 0), a3, voffA);
            PG8_WAIT_V(8); PG8_WAIT_L(0); PG8_BAR; PG8_MMA(1, 0, At, B0); PG8_MMA(1, 1, At, B1); PG8_BAR; PG8_SCHED;
            } else {
            PG8_LDB(B0, 0, 0); PG8_SCHED; PG8_LDA(At, 0, 0); PG8_STAGE(PG8_SA(1, 1), a1 + hstep, voffA);
            PG8_WAIT_L(8); PG8_BAR; PG8_WAIT_L(0); PG8_MMA(0, 0, At, B0); PG8_BAR; PG8_SCHED;
            PG8_LDB(B1, 0, 1); PG8_STAGE(PG8_SB(0, 0), b2, voffB);
            PG8_BAR; PG8_WAIT_L(0); PG8_MMA(0, 1, At, B1); PG8_BAR;
            PG8_LDA(At, 0, 1); PG8_STAGE(PG8_SA(0, 0), a2, voffA);
            PG8_BAR; PG8_WAIT_L(0); PG8_MMA(1, 0, At, B0); PG8_BAR; PG8_SCHED;
            PG8_STAGE(PG8_SB(0, 1), b2 + hstep, voffB);
            PG8_WAIT_V(6); PG8_BAR; PG8_MMA(1, 1, At, B1); PG8_BAR;
            PG8_LDB(B0, 1, 0); PG8_SCHED; PG8_LDA(At, 1, 0); PG8_STAGE(PG8_SA(0, 1), a2 + hstep, voffA);
            PG8_WAIT_L(8); PG8_BAR; PG8_WAIT_L(0); PG8_MMA(0, 0, At, B0); PG8_BAR; PG8_SCHED;
            PG8_LDB(B1, 1, 1); PG8_STAGE(PG8_SB(1, 0), b3, voffB);
            PG8_BAR; PG8_WAIT_L(0); PG8_MMA(0, 1, At, B1); PG8_BAR;
            PG8_LDA(At, 1, 1); PG8_STAGE(PG8_SA(1, 0), a3, voffA);
            PG8_BAR; PG8_WAIT_L(0); PG8_MMA(1, 0, At, B0); PG8_BAR; PG8_SCHED;
            PG8_STAGE(PG8_SB(1, 1), b3 + hstep, voffB);
            PG8_WAIT_V(6); PG8_BAR; PG8_MMA(1, 1, At, B1); PG8_BAR;
            }
        }
        if constexpr (ALIGN_EPI) { if (wr == 0) PG8_BAR; }
        if constexpr (!Epi::AFTER_DRAIN) { E(acc, cur, wr, wc, fr, fq); S.done(cur); }
        if (!has_next) break;
#pragma unroll
        for (int a = 0; a < 2; ++a)
#pragma unroll
            for (int b = 0; b < 2; ++b)
#pragma unroll
                for (int m = 0; m < 4; ++m)
#pragma unroll
                    for (int n = 0; n < 2; ++n) acc[a][b][m][n] = (f32x4){0.f, 0.f, 0.f, 0.f};
        cur = nxt; cA = nA; cB = nB; ++ui;
        if constexpr (ALIGN_EPI) { if (wr == 1) PG8_BAR; }
    }
    PG8_WAIT_V(0);
    if constexpr (!ALIGN_EPI) { if (wr == 0) PG8_BAR; }
    PG8_BAR;
    if constexpr (Epi::AFTER_DRAIN) { E.fused(acc, cur, wr, wc, fr, fq, lds, wid, lane); S.done(cur); }
#undef PG8_SA
#undef PG8_SB
#undef PG8_STAGE
#undef PG8_LDA
#undef PG8_LDB
#undef PG8_MMA
#undef PG8_WAIT_V
#undef PG8_WAIT_L
#undef PG8_BAR
#undef PG8_SCHED
}
}
constexpr int NWAVES = 8;
constexpr int NPHASE = 11;
#ifndef MK_N_LAUNCHES
#define MK_N_LAUNCHES 1
#endif
constexpr int N_LAUNCHES = MK_N_LAUNCHES;

constexpr int M = 16384, D = 1024, DFF = 2816, NMIXP = 5120, CCH = 512, AW = 512, NH = 8, HD = 64, PLE = 256, CONVW = 31;
constexpr float EPS = 1e-6f;
constexpr float LOG2E = 1.4426950408889634f;

constexpr size_t MiB = 1u << 20;
constexpr size_t WS_CTL = 0, CTL_ZERO_BYTES = 1 * MiB;
constexpr size_t WS_W1IN = 1 * MiB;
constexpr size_t WS_W1OUT = 12 * MiB;
constexpr size_t WS_WMIX = 18 * MiB;
constexpr size_t WS_WCO = 28 * MiB;
constexpr size_t WS_WAO = 29 * MiB;
constexpr size_t WS_WMO = 30 * MiB;
constexpr size_t WS_W2IN = 32 * MiB;
constexpr size_t WS_W2OUT = 43 * MiB;
constexpr size_t WS_WPG = 49 * MiB;
constexpr size_t WS_WPP = 51 * MiB;
constexpr size_t WS_HB = 52 * MiB;
constexpr size_t WS_MASK = WS_HB;
constexpr size_t WS_ACT = 84 * MiB;
constexpr size_t WS_GLU = WS_ACT;
constexpr size_t WS_ATT = WS_ACT;
constexpr size_t WS_Q = WS_ACT + 16 * MiB, WS_K = WS_ACT + 32 * MiB, WS_V = WS_ACT + 48 * MiB;
constexpr size_t WS_QI = WS_ACT + 64 * MiB;
constexpr size_t WS_KI = WS_ACT + 72 * MiB;
constexpr size_t WS_WI = WS_ACT + 74 * MiB;
constexpr size_t WS_GC = 172 * MiB;
constexpr size_t WS_GA = 204 * MiB;
constexpr size_t WS_PB = 236 * MiB;
constexpr size_t WS_PROJ = WS_GA;
constexpr size_t WS_ZC = 236 * MiB;
constexpr size_t WS_END = 252 * MiB;
constexpr int CW_TMO = 0, CW_CODE = 1;
constexpr int CW_BAR = 4096;
constexpr size_t CTL_SS1 = 64 * 1024, CTL_SS2 = 192 * 1024, CTL_SS3 = 320 * 1024, CTL_SS4 = 448 * 1024;

constexpr int RING_OFF = 0, RING_BYTES = 131072;
constexpr int LDSCTL_OFF = RING_BYTES, MISC_OFF = LDSCTL_OFF + 320;
constexpr int LDS_BYTES = 147456;

#define GAS __attribute__((address_space(1)))
#define LAS __attribute__((address_space(3)))
typedef unsigned short bf16;
typedef unsigned v4u __attribute__((ext_vector_type(4)));
typedef float f32x4 __attribute__((ext_vector_type(4)));
typedef short bf16x8 __attribute__((ext_vector_type(8)));
typedef GAS unsigned gu32;
typedef GAS unsigned long long gu64;
#define RLX_AGENT __ATOMIC_RELAXED, __HIP_MEMORY_SCOPE_AGENT
#define LDS_WAIT() asm volatile("s_waitcnt lgkmcnt(0)" ::: "memory")
#define VM_WAIT() asm volatile("s_waitcnt vmcnt(0)" ::: "memory")
__device__ __forceinline__ unsigned long long rt() { return __builtin_amdgcn_s_memrealtime(); }
__device__ __forceinline__ unsigned f2bf(float f) { unsigned u = __builtin_bit_cast(unsigned, f); return (u + 0x7fffu + ((u >> 16) & 1u)) >> 16; }
__device__ __forceinline__ unsigned pk2(float lo, float hi) { return f2bf(lo) | (f2bf(hi) << 16); }

#define XB_TMO      128
#define XB_XCNT(j)  (256  + 64 * (j))
#define XB_XSUB(j)  (1280 + 64 * (j))
#define XB_XGEN(j)  (2304 + 64 * (j))
#define XB_TOP      3328
#define XB_TOPGEN   3392
#define XCD_BAR_WORDS 3456
#define XB_LSUB(j)  (3520 + 64 * (j))
#define XB_LGEN(j)  (4544 + 64 * (j))
#define XB_TAB      5632
#define XB_DONE2    6080
#define XB_DONE6    6016
#define XB_NONLOCAL 5952
#define XB_SPIN_CAP (1u << 18)

__device__ __forceinline__ unsigned xb_ld(unsigned* p)              { return __hip_atomic_load(p, __ATOMIC_RELAXED, __HIP_MEMORY_SCOPE_AGENT); }
__device__ __forceinline__ unsigned xb_add(unsigned* p, unsigned v) { return __hip_atomic_fetch_add(p, v, __ATOMIC_RELAXED, __HIP_MEMORY_SCOPE_AGENT); }
__device__ __forceinline__ unsigned xb_xcc_id() { return (unsigned)__builtin_amdgcn_s_getreg((3 << 11) | 20) & 0xFu; }
#define XB_SPIN(cond, bar) do { unsigned _sp = 0; while (cond) { __builtin_amdgcn_s_sleep(1); \
    if ((++_sp & 255u) == 0u) { if (xb_ld(&(bar)[XB_TMO])) break; if (_sp > XB_SPIN_CAP) { atomicAdd(&(bar)[XB_TMO], 1u); break; } } } } while (0)

struct XcdBarrier {
    unsigned* bar; unsigned x;
    volatile LAS unsigned* st;
};

__device__ __forceinline__ XcdBarrier xcd_barrier_post(unsigned* bar, volatile LAS unsigned* st, const int tid) {
    XcdBarrier b; b.bar = bar; b.x = xb_xcc_id(); b.st = st;
    if (tid == 0) (void)xb_add(&bar[XB_XCNT(b.x)], 1u);
    return b;
}
__device__ __forceinline__ void xcd_barrier_complete(unsigned* bar, unsigned x, unsigned& nloc, unsigned& nx) {
    const unsigned G = gridDim.x * gridDim.y * gridDim.z;
    unsigned sum, cnt, mine, sp = 0u;
    for (;;) {
        sum = 0u; cnt = 0u; mine = 0u;
#pragma unroll
        for (unsigned j = 0; j < 16; ++j) { const unsigned c = xb_ld(&bar[XB_XCNT(j)]); sum += c; cnt += (c > 0u) ? 1u : 0u; mine = (j == x) ? c : mine; }
        if (sum == G) break;
        __builtin_amdgcn_s_sleep(1);
        if ((++sp & 255u) == 0u) { if (xb_ld(&bar[XB_TMO])) break; if (sp > XB_SPIN_CAP) { atomicAdd(&bar[XB_TMO], 1u); break; } }
    }
    nloc = mine > 0u ? mine : 1u; nx = cnt > 0u ? cnt : 1u;
}

template <bool FLUSH = true>
__device__ __forceinline__ void xcd_barrier(const XcdBarrier& b, const int tid) {
    asm volatile("s_waitcnt vmcnt(0)" ::: "memory");
    __syncthreads();
    if (tid == 0) {
        unsigned* bar = b.bar;
        __builtin_amdgcn_s_waitcnt(0);
        unsigned nloc = b.st[0], nx = b.st[1];
        if (nloc == 0u) { xcd_barrier_complete(bar, b.x, nloc, nx); b.st[0] = nloc; b.st[1] = nx; }
        const unsigned old = xb_add(&bar[XB_XSUB(b.x)], 1u);
        const unsigned gen = old / nloc;
        if (old + 1u == (gen + 1u) * nloc) {
            if (FLUSH) __builtin_amdgcn_fence(__ATOMIC_RELEASE, "agent");
            asm volatile("s_waitcnt vmcnt(0)" ::: "memory");
            const unsigned og = xb_add(&bar[XB_TOP], 1u);
            const unsigned tg = og / nx;
            __builtin_amdgcn_fence(__ATOMIC_ACQUIRE, "agent");
            if (og + 1u == (tg + 1u) * nx) xb_add(&bar[XB_TOPGEN], 1u);
            else XB_SPIN(xb_ld(&bar[XB_TOPGEN]) == tg, bar);
            xb_add(&bar[XB_XGEN(b.x)], 1u);
            asm volatile("s_waitcnt vmcnt(0)" ::: "memory");
        } else {
            __builtin_amdgcn_fence(__ATOMIC_ACQUIRE, "agent");
            XB_SPIN(xb_ld(&bar[XB_XGEN(b.x)]) == gen, bar);
            asm volatile("s_waitcnt vmcnt(0)" ::: "memory");
        }
    }
    __syncthreads();
}

template <int POST = -1>
__device__ __forceinline__ void xcd_local_barrier(const XcdBarrier& b, const int tid) {
    asm volatile("s_waitcnt vmcnt(0)" ::: "memory");
    __syncthreads();
    if (tid == 0) {
        unsigned* bar = b.bar;
        __builtin_amdgcn_s_waitcnt(0);
        const unsigned nloc = b.st[0];
        const unsigned old = xb_add(&bar[XB_LSUB(b.x)], 1u);
        const unsigned gen = old / nloc;
        __builtin_amdgcn_fence(__ATOMIC_ACQUIRE, "agent");
        if (old + 1u == (gen + 1u) * nloc) { xb_add(&bar[XB_LGEN(b.x)], 1u); if (POST >= 0) xb_add(&bar[POST], 1u); }
        else XB_SPIN(xb_ld(&bar[XB_LGEN(b.x)]) == gen, bar);
        asm volatile("s_waitcnt vmcnt(0)" ::: "memory");
    }
    __syncthreads();
}

struct Frame {
    LAS unsigned char* lds;
    volatile LAS unsigned* MISC;
    gu32* ctl;
    int tid, lane, wave;
    int vcu, G;
};
__device__ __forceinline__ float wave_sum(float v) {
#pragma unroll
    for (int o = 1; o < 64; o <<= 1) v += __shfl_xor(v, o);
    return v;
}
__device__ __forceinline__ float wave_max(float v) {
#pragma unroll
    for (int o = 1; o < 64; o <<= 1) v = fmaxf(v, __shfl_xor(v, o));
    return v;
}
__device__ __forceinline__ float bflo(unsigned w) { return __uint_as_float(w << 16); }
__device__ __forceinline__ float bfhi(unsigned w) { return __uint_as_float(w & 0xffff0000u); }
__device__ __forceinline__ float sigm_f(float x) { return __builtin_amdgcn_rcpf(1.f + __builtin_amdgcn_exp2f(-LOG2E * x)); }

__device__ __forceinline__ int wmap(int kind, int n0, int& nv) {
    nv = 32;
    if (kind == 0) return n0;
    const int T = n0 >> 8, rem = n0 & 255;
    if (kind == 1) return (rem >> 7) * DFF + 128 * T + (rem & 127);
    if (T < 4) return (rem >> 7) * 512 + 128 * T + (rem & 127);
    if (T < 8) { const int base = T < 6 ? 1024 : 1536, Tq = (T - 4) & 1, bj = rem >> 7, wc = (rem & 127) >> 5; return base + 64 * (4 * Tq + wc) + 32 * bj; }
    if (T < 10) return 2048 + 256 * (T - 8) + rem;
    if (T == 10) return 2560 + rem;
    if (T == 11) { if (rem < 64) return 2816 + rem; if (rem == 64) { nv = 4; return 2880; } nv = 0; return 0; }
    return 2884 + 256 * (T - 12) + rem;
}
__device__ __forceinline__ void p0_transpose_item(const float* W, int K, int Nsrc, bf16* WT, int ng, int kind, const float* gain, LAS float* scr, int item, int lane) {
    const int kb = item / ng, nb = item % ng, k0 = 64 * kb, n0 = 32 * nb;
    int nv; const int sc = wmap(kind, n0, nv);
    const int n4 = 4 * (lane & 7), kr = lane >> 3;
    const bool ok = n4 < nv;
#pragma unroll
    for (int i = 0; i < 8; ++i) { const int kk = 8 * i + kr;
        f32x4 v = ok ? *(const GAS f32x4*)(W + (size_t)(k0 + kk) * Nsrc + sc + n4) : (f32x4){0.f, 0.f, 0.f, 0.f};
        if (gain) v = v * gain[k0 + kk];
        *(LAS f32x4*)(scr + kk * 36 + n4) = v; }
    LDS_WAIT(); asm volatile("" ::: "memory");
    const int c = lane & 7;
#pragma unroll
    for (int j = 0; j < 4; ++j) { const int n = (lane >> 3) + 8 * j; const LAS float* s = scr + (8 * c) * 36 + n;
        v4u o; o.x = pk2(s[0 * 36], s[1 * 36]); o.y = pk2(s[2 * 36], s[3 * 36]); o.z = pk2(s[4 * 36], s[5 * 36]); o.w = pk2(s[6 * 36], s[7 * 36]);
        *(GAS v4u*)(WT + (size_t)(n0 + n) * K + k0 + 8 * c) = o; }
    LDS_WAIT(); asm volatile("" ::: "memory");
}
struct Args { const float* in[23]; float* out; unsigned char* ws; int ph_lo, ph_hi, li, pad; };
typedef const __attribute__((address_space(4))) Args* KArgs;
__device__ __forceinline__ KArgs kargs() { KArgs p = (KArgs)__builtin_amdgcn_kernarg_segment_ptr(); asm volatile("" : "+s"(p)); return p; }

constexpr int P0_I0 = 16 * 176, P0_LATE_END = P0_I0 + 44 * 32 + 16 * 160 + 8 * 32 + 8 * 32 + 16 * 32;
__device__ __forceinline__ void p0_weights(Frame& F, KArgs A, const int it_lo, const int it_hi, const int gw, const int NGW) {
    LAS float* scr = (LAS float*)(F.lds + RING_OFF + F.wave * 16384);
    unsigned char* ws = A->ws;
    constexpr int I0 = 16 * 176, I1 = 44 * 32, I2 = 16 * 160, I3 = 8 * 32, I4 = 8 * 32, I5 = 16 * 32, I6 = 16 * 176, I7 = 44 * 32, I8 = 16 * 32, I9 = 4 * 32;
    constexpr int NITEMS = I0 + I1 + I2 + I3 + I4 + I5 + I6 + I7 + I8 + I9;
    static_assert(I0 == P0_I0, "");
    const int hi_ = it_hi < 0 ? NITEMS : it_hi;
    for (int it = it_lo + gw; it < hi_; it += NGW) {
        int r = it;
        if (r < I0) { p0_transpose_item(A->in[3], 1024, 5632, (bf16*)(ws + WS_W1IN), 176, 1, A->in[2], scr, r, F.lane); continue; } r -= I0;
        if (r < I1) { p0_transpose_item(A->in[4], 2816, 1024, (bf16*)(ws + WS_W1OUT), 32, 0, nullptr, scr, r, F.lane); continue; } r -= I1;
        if (r < I2) { p0_transpose_item(A->in[6], 1024, 4932, (bf16*)(ws + WS_WMIX), 160, 2, A->in[5], scr, r, F.lane); continue; } r -= I2;
        if (r < I3) { p0_transpose_item(A->in[11], 512, 1024, (bf16*)(ws + WS_WCO), 32, 0, nullptr, scr, r, F.lane); continue; } r -= I3;
        if (r < I4) { p0_transpose_item(A->in[14], 512, 1024, (bf16*)(ws + WS_WAO), 32, 0, nullptr, scr, r, F.lane); continue; } r -= I4;
        if (r < I5) { p0_transpose_item(A->in[15], 1024, 1024, (bf16*)(ws + WS_WMO), 32, 0, nullptr, scr, r, F.lane); continue; } r -= I5;
        if (r < I6) { p0_transpose_item(A->in[17], 1024, 5632, (bf16*)(ws + WS_W2IN), 176, 1, A->in[16], scr, r, F.lane); continue; } r -= I6;
        if (r < I7) { p0_transpose_item(A->in[18], 2816, 1024, (bf16*)(ws + WS_W2OUT), 32, 0, nullptr, scr, r, F.lane); continue; } r -= I7;
        if (r < I8) { p0_transpose_item(A->in[20], 1024, 1024, (bf16*)(ws + WS_WPG), 32, 0, A->in[19], scr, r, F.lane); continue; } r -= I8;
        p0_transpose_item(A->in[21], 256, 1024, (bf16*)(ws + WS_WPP), 32, 0, nullptr, scr, r, F.lane);
    }
}
__device__ __forceinline__ void p0_prologue(Frame& F, KArgs A) {
    const int gw = F.vcu * NWAVES + F.wave, NGW = F.G * NWAVES;
    unsigned char* ws = A->ws;
    p0_weights(F, A, 0, P0_I0, gw, NGW);
    p0_weights(F, A, P0_LATE_END, -1, gw, NGW);
    const float* x = A->in[0]; bf16* xb = (bf16*)(ws + WS_HB); float* ss1 = (float*)(ws + WS_CTL + CTL_SS1);
    for (int m = gw; m < M; m += NGW) {
        const GAS f32x4* xr = (const GAS f32x4*)(x + (size_t)m * D) + F.lane;
        f32x4 v[4]; float s = 0.f;
#pragma unroll
        for (int j = 0; j < 4; ++j) { v[j] = xr[64 * j]; s += (v[j].x * v[j].x + v[j].y * v[j].y) + (v[j].z * v[j].z + v[j].w * v[j].w); }
        s = wave_sum(s);
        if (F.lane == 0) ((unsigned long long*)ss1)[m] = (unsigned long long)(s * 1048576.0f);
        GAS unsigned long long* o8 = (GAS unsigned long long*)(xb + (size_t)m * D) + F.lane;
#pragma unroll
        for (int j = 0; j < 4; ++j) o8[64 * j] = (unsigned long long)pk2(v[j].x, v[j].y) | ((unsigned long long)pk2(v[j].z, v[j].w) << 32);
    }
}
__device__ __forceinline__ void convert_p(Frame& F, KArgs A) {
    const float* p = A->in[1]; bf16* pb = (bf16*)(A->ws + WS_PB);
    const int g = F.vcu >> 5, gtl = (F.vcu & 31) * (NWAVES * 64) + F.tid;
    for (int k = 0; k < 4; ++k) { const int i = 65536 * g + gtl + 16384 * k;
        const f32x4 a = *(const GAS f32x4*)(p + (size_t)i * 8), b = *(const GAS f32x4*)(p + (size_t)i * 8 + 4);
        v4u o; o.x = pk2(a.x, a.y); o.y = pk2(a.z, a.w); o.z = pk2(b.x, b.y); o.w = pk2(b.z, b.w);
        *(GAS v4u*)(pb + (size_t)i * 8) = o;
    }
}

__device__ __forceinline__ void conv_phase(Frame& F, KArgs A) {
    const bf16* glu = (const bf16*)(A->ws + WS_GLU); bf16* zc = (bf16*)(A->ws + WS_ZC);
    const float* dw = A->in[7]; const float* db = A->in[8]; const float* lg = A->in[9]; const float* lb = A->in[10];
    LAS unsigned char* L = F.lds; constexpr int WT_OFF = 0, GL_OFF = 63488;
    const int tid = F.tid, lane = F.lane, wv = F.wave, c0 = 8 * lane;
    __syncthreads();
    for (int i = tid; i < CONVW * 128; i += NWAVES * 64) { const int w = i >> 7, q4 = i & 127;
        *(LAS f32x4*)(L + WT_OFF + ((q4 & 1) * CONVW + w) * 1024 + (q4 >> 1) * 16) = *(const GAS f32x4*)(dw + w * CCH + 4 * q4); }
    const f32x4 b0 = *(const GAS f32x4*)(db + c0), b1 = *(const GAS f32x4*)(db + c0 + 4);
    const f32x4 g0 = *(const GAS f32x4*)(lg + c0), g1 = *(const GAS f32x4*)(lg + c0 + 4);
    const f32x4 e0 = *(const GAS f32x4*)(lb + c0), e1 = *(const GAS f32x4*)(lb + c0 + 4);
    for (int bt = 0; bt < 2; ++bt) {
        const int t0 = 64 * F.vcu + 32 * bt;
        __syncthreads();
        for (int i = tid; i < 62 * 64; i += NWAVES * 64) { const int r = i >> 6, tt = t0 - 30 + r;
            *(LAS v4u*)(L + GL_OFF + i * 16) = tt >= 0 ? *(const GAS v4u*)(glu + (size_t)tt * CCH + 8 * (i & 63)) : (v4u){0u, 0u, 0u, 0u}; }
        __syncthreads();
        f32x4 a0[4], a1[4];
#pragma unroll
        for (int r = 0; r < 4; ++r) { a0[r] = b0; a1[r] = b1; }
#pragma unroll 4
        for (int w = 0; w < CONVW; ++w) {
            const f32x4 w0 = *(const LAS f32x4*)(L + WT_OFF + w * 1024 + lane * 16), w1 = *(const LAS f32x4*)(L + WT_OFF + (CONVW + w) * 1024 + lane * 16);
#pragma unroll
            for (int r = 0; r < 4; ++r) { const v4u z = *(const LAS v4u*)(L + GL_OFF + ((4 * wv + r + w) * 64 + lane) * 16);
                a0[r] += (f32x4){bflo(z.x), bfhi(z.x), bflo(z.y), bfhi(z.y)} * w0; a1[r] += (f32x4){bflo(z.z), bfhi(z.z), bflo(z.w), bfhi(z.w)} * w1; } }
#pragma unroll
        for (int r = 0; r < 4; ++r) { const int t = t0 + 4 * wv + r; f32x4 x0 = a0[r], x1 = a1[r];
            const float mean = wave_sum((x0.x + x0.y) + (x0.z + x0.w) + (x1.x + x1.y) + (x1.z + x1.w)) * (1.0f / CCH);
            x0 = x0 - mean; x1 = x1 - mean;
            const float var = wave_sum((x0.x * x0.x + x0.y * x0.y) + (x0.z * x0.z + x0.w * x0.w) + (x1.x * x1.x + x1.y * x1.y) + (x1.z * x1.z + x1.w * x1.w)) * (1.0f / CCH);
            const float rstd = __builtin_amdgcn_rsqf(var + EPS);
            f32x4 y0 = x0 * rstd * g0 + e0, y1 = x1 * rstd * g1 + e1;
#pragma unroll
            for (int e = 0; e < 4; ++e) { y0[e] = y0[e] * sigm_f(y0[e]); y1[e] = y1[e] * sigm_f(y1[e]); }
            v4u o; o.x = pk2(y0.x, y0.y); o.y = pk2(y0.z, y0.w); o.z = pk2(y1.x, y1.y); o.w = pk2(y1.z, y1.w);
            *(GAS v4u*)(zc + (size_t)t * CCH + c0) = o; }
    }
    __syncthreads();
}

__device__ __forceinline__ unsigned ordkey(float s) { unsigned u = __float_as_uint(s); if (s == 0.f) u = 0u; return (u & 0x80000000u) ? ~u : (u | 0x80000000u); }
__device__ __forceinline__ float h2f(unsigned short h) { return (float)__builtin_bit_cast(_Float16, h); }

__device__ __forceinline__ void indexer_simple(Frame& F, KArgs A) {
    const unsigned short* QI = (const unsigned short*)(A->ws + WS_QI); const unsigned short* KI = (const unsigned short*)(A->ws + WS_KI); const float* WI = (const float*)(A->ws + WS_WI);
    unsigned* mask32 = (unsigned*)(A->ws + WS_MASK);
    LAS unsigned* skey = (LAS unsigned*)(F.lds);
    LAS float* qif = (LAS float*)(F.lds + 65536);
    LAS unsigned* hist = (LAS unsigned*)(F.lds + 65536 + 1024);
    LAS unsigned* cnt = (LAS unsigned*)(F.lds + 65536 + 2048);
    LAS unsigned* wtot = (LAS unsigned*)(F.lds + 65536 + 4096);
    LAS unsigned* res = (LAS unsigned*)(F.lds + 65536 + 4160);
    const int tid = F.tid, lane = F.lane, wv = F.wave, w = (int)blockIdx.x;
    for (int jj = 0; jj < 64; ++jj) {
        const int j = jj >> 1; const int t = 512 * j + ((jj & 1) ? (511 - w) : w);
        const int n = t + 1;
        __syncthreads();
        if (tid < 256) qif[tid] = h2f(QI[(size_t)t * 256 + tid]);
        const f32x4 w4 = *(const GAS f32x4*)(WI + (size_t)t * 4);
        __syncthreads();
        for (int s = tid; s < n; s += 512) {
            float dot[4] = {0.f, 0.f, 0.f, 0.f};
#pragma unroll 1
            for (int c = 0; c < 8; ++c) { asm volatile("" ::: "memory"); const v4u kv = *(const GAS v4u*)(KI + (size_t)s * 64 + 8 * c);
                const unsigned kw[4] = {kv.x, kv.y, kv.z, kv.w};
#pragma unroll
                for (int e = 0; e < 4; ++e) { const float k0 = h2f((unsigned short)(kw[e] & 0xffffu)), k1 = h2f((unsigned short)(kw[e] >> 16));
#pragma unroll
                    for (int h = 0; h < 4; ++h) { dot[h] += k0 * qif[64 * h + 8 * c + 2 * e]; dot[h] += k1 * qif[64 * h + 8 * c + 2 * e + 1]; } } }
            float sc = w4.x * fmaxf(dot[0], 0.f); sc += w4.y * fmaxf(dot[1], 0.f); sc += w4.z * fmaxf(dot[2], 0.f); sc += w4.w * fmaxf(dot[3], 0.f);
            skey[s] = ordkey(sc);
        }
        __syncthreads();
        unsigned T = 0u, r = 0u;
        if (n > 256) {
            unsigned prefix = 0u, pmask = 0u, remaining = 256u;
            for (int pass = 0; pass < 4; ++pass) { const int shift = 24 - 8 * pass;
                if (tid < 256) hist[tid] = 0u;
                __syncthreads();
                for (int s = tid; s < n; s += 512) { const unsigned k = skey[s]; if ((k & pmask) == prefix) __hip_atomic_fetch_add(&hist[(k >> shift) & 255u], 1u, __ATOMIC_RELAXED, __HIP_MEMORY_SCOPE_WORKGROUP); }
                __syncthreads();
                if (wv == 0) {
                    const unsigned c0 = hist[4 * lane], c1 = hist[4 * lane + 1], c2 = hist[4 * lane + 2], c3 = hist[4 * lane + 3];
                    const unsigned tl = c0 + c1 + c2 + c3; unsigned suf = tl;
#pragma unroll
                    for (int o = 1; o < 64; o <<= 1) { const unsigned v = __shfl_down(suf, o); if (lane + o < 64) suf += v; }
                    const unsigned above = suf - tl;
                    if (above < remaining && remaining <= suf) {
                        unsigned a = above; int d;
                        if (a + c3 >= remaining) d = 3; else { a += c3; if (a + c2 >= remaining) d = 2; else { a += c2; if (a + c1 >= remaining) d = 1; else { a += c1; d = 0; } } }
                        res[0] = (unsigned)(4 * lane + d); res[1] = remaining - a; }
                }
                __syncthreads();
                prefix |= res[0] << shift; pmask |= 255u << shift; remaining = res[1];
                __syncthreads();
            }
            T = prefix; r = remaining;
        }
        const int s0 = 32 * tid; unsigned eqc = 0u;
        for (int i = 0; i < 32; ++i) { const int s = s0 + i; if (s < n && skey[s] == T) ++eqc; }
        unsigned inc = eqc;
#pragma unroll
        for (int o = 1; o < 64; o <<= 1) { const unsigned v = __shfl_up(inc, o); if (lane >= o) inc += v; }
        if (lane == 63) wtot[wv] = inc;
        __syncthreads();
        unsigned run = inc - eqc;
        for (int v = 0; v < wv; ++v) run += wtot[v];
        unsigned word = 0u;
        for (int i = 0; i < 32; ++i) { const int s = s0 + i; if (s < n) { const unsigned k = skey[s]; if (k > T) word |= 1u << i; else if (k == T) { if (run < r) word |= 1u << i; ++run; } } }
        const int nchunk = 8 * ((t >> 8) + 1);
        if (tid < nchunk) mask32[((size_t)(tid >> 1) * M + t) * 2 + (tid & 1)] = word;
    }
}

__device__ __forceinline__ int t5_bucket(int d) {
    if (d < 16) return d;
    int b = 16;
    b += d >= 19; b += d >= 21; b += d >= 24; b += d >= 27; b += d >= 31; b += d >= 35; b += d >= 40; b += d >= 46;
    b += d >= 52; b += d >= 59; b += d >= 67; b += d >= 77; b += d >= 87; b += d >= 99; b += d >= 113;
    return b;
}
__device__ __forceinline__ void attn_simple(Frame& F, KArgs A) {
    const bf16* Q = (const bf16*)(A->ws + WS_Q); const bf16* K = (const bf16*)(A->ws + WS_K); const bf16* V = (const bf16*)(A->ws + WS_V); bf16* O = (bf16*)(A->ws + WS_ATT);
    const unsigned long long* mask = (const unsigned long long*)(A->ws + WS_MASK); const float* relb = A->in[22];
    LAS unsigned char* base = F.lds + F.wave * 4096;
    LAS unsigned short* list = (LAS unsigned short*)base;
    LAS float* pbuf = (LAS float*)(base + 512);
    LAS float* qf = (LAS float*)(base + 1536);
    const int lane = F.lane, gw = (int)blockIdx.x * NWAVES + F.wave;
    for (int j = 0; j < 8; ++j) {
        const int t = 2048 * j + ((j & 1) ? (2047 - gw) : gw);
        { const v4u qv = *(const GAS v4u*)(Q + (size_t)t * AW + 8 * lane);
          qf[8 * lane + 0] = bflo(qv.x); qf[8 * lane + 1] = bfhi(qv.x); qf[8 * lane + 2] = bflo(qv.y); qf[8 * lane + 3] = bfhi(qv.y);
          qf[8 * lane + 4] = bflo(qv.z); qf[8 * lane + 5] = bfhi(qv.z); qf[8 * lane + 6] = bflo(qv.w); qf[8 * lane + 7] = bfhi(qv.w); }
        const int qg = t >> 5, cq = t & 31;
        const unsigned long long* mw = mask + (size_t)qg * 512 * 16;
        unsigned pc = 0u;
        for (int i = 0; i < 8; ++i) { const int ks = lane + 64 * i; if (ks <= qg) {
            for (int r = 0; r < 16; ++r) { const unsigned long long w = mw[ks * 16 + r]; pc += (unsigned)((w >> cq) & 1ull) + (unsigned)((w >> (cq + 32)) & 1ull); } } }
        unsigned inc = pc;
#pragma unroll
        for (int o = 1; o < 64; o <<= 1) { const unsigned v = __shfl_up(inc, o); if (lane >= o) inc += v; }
        const int cnt = (int)__shfl(inc, 63);
        unsigned pos = inc - pc;
        for (int i = 0; i < 8; ++i) { const int ks = lane + 64 * i; if (ks <= qg) {
            for (int r = 0; r < 16; ++r) { const unsigned long long w = mw[ks * 16 + r];
                for (int h2 = 0; h2 < 2; ++h2) if ((w >> (cq + 32 * h2)) & 1ull) { if (pos < 256u) list[pos] = (unsigned short)(32 * ks + (r & 3) + 8 * (r >> 2) + 4 * h2); ++pos; } } } }
        LDS_WAIT(); asm volatile("" ::: "memory");
        const int ncl = cnt < 256 ? cnt : 256;
        for (int h = 0; h < NH; ++h) {
            float lg[4]; float mx = -INFINITY;
#pragma unroll
            for (int i = 0; i < 4; ++i) { const int e = lane + 64 * i; lg[i] = -INFINITY;
                if (e < ncl) { const int key = list[e]; const bf16* kr = K + (size_t)key * AW + 64 * h; float dot = 0.f;
#pragma unroll
                    for (int c = 0; c < 8; ++c) { const v4u kv = *(const GAS v4u*)(kr + 8 * c); const LAS float* qq = qf + 64 * h + 8 * c;
                        dot += bflo(kv.x) * qq[0]; dot += bfhi(kv.x) * qq[1]; dot += bflo(kv.y) * qq[2]; dot += bfhi(kv.y) * qq[3];
                        dot += bflo(kv.z) * qq[4]; dot += bfhi(kv.z) * qq[5]; dot += bflo(kv.w) * qq[6]; dot += bfhi(kv.w) * qq[7]; }
                    lg[i] = dot + relb[t5_bucket(t - key) * NH + h] * LOG2E; }
                mx = fmaxf(mx, lg[i]); }
            mx = wave_max(mx);
            float sm = 0.f;
#pragma unroll
            for (int i = 0; i < 4; ++i) { const int e = lane + 64 * i; const float p = (e < ncl) ? __builtin_amdgcn_exp2f(lg[i] - mx) : 0.f; sm += p; if (e < ncl) pbuf[e] = p; }
            sm = wave_sum(sm);
            LDS_WAIT(); asm volatile("" ::: "memory");
            float acc = 0.f;
            for (int e = 0; e < ncl; ++e) { const int key = list[e]; acc += pbuf[e] * __uint_as_float((unsigned)V[(size_t)key * AW + 64 * h + lane] << 16); }
            O[(size_t)t * AW + 64 * h + lane] = (bf16)f2bf(acc / sm);
            LDS_WAIT(); asm volatile("" ::: "memory");
        }
    }
}


typedef _Float16 half8 __attribute__((ext_vector_type(8)));
typedef float f32x16 __attribute__((ext_vector_type(16)));
constexpr int IX_NBW = 515, IX_CENTER = 515, IX_TOPBIN = 1029, IX_CAP = 256, IX_SH = 19, IX_E0 = (127 - 28) * 16;
constexpr int IX_CHUNK = 32;
constexpr int IX_ROW = 64 + 1030;
constexpr int IXL_HIST = 0, IXL_IMG = 0, IXL_ZH = 70144, IXL_CANDK = 74240, IXL_CANDI = 107008, IXL_CCNT = 123392, IXL_ST = 123520, IXL_CNT = 124544, IXL_ST2 = 124672, IXL_FLAG = 125184, IXL_END = 125248;
enum { IXF_USEKEY = 1, IXF_TIE = 2, IXF_OVF = 4, IXF_NEEDTIE = 8 };
enum { IXM_HIST0 = 0, IXM_COUNT = 1, IXM_TIES = 2, IXM_COLLECT = 3 };

__device__ __forceinline__ int ix_bin(float s) {
    const unsigned u = __float_as_uint(s), a = u & 0x7fffffffu;
    int mi = (int)(a >> IX_SH) - IX_E0;
    mi = min(max(mi, -1), 512) + 1;
    const int b = (u >> 31) ? (IX_CENTER - 1 - mi) : (IX_CENTER + 1 + mi);
    return a == 0u ? IX_CENTER : b;
}
__device__ __forceinline__ void ix_bin_range(int b, unsigned& klo, unsigned& khi) {
    const bool pos = b > IX_CENTER; const int mi = pos ? b - IX_CENTER - 1 : IX_CENTER - 1 - b;
    const unsigned alo = mi == 0 ? 1u : ((unsigned)(mi - 1 + IX_E0) << IX_SH);
    const unsigned ahi = mi == 0 ? (((unsigned)IX_E0 << IX_SH) - 1u) : (mi == 513 ? 0x7fffffffu : alo + (1u << IX_SH) - 1u);
    if (pos) { klo = alo | 0x80000000u; khi = ahi | 0x80000000u; } else { klo = 0x7fffffffu - ahi; khi = 0x7fffffffu - alo; }
}
__device__ __forceinline__ unsigned wave_incl_scan(unsigned v, int lane) {
#pragma unroll
    for (int o = 1; o < 64; o <<= 1) { const unsigned t = __shfl_up(v, o); if (lane >= o) v += t; }
    return v;
}
__device__ __forceinline__ bool ix_scan_row(LAS unsigned char* L, int q, int lane, unsigned& B, unsigned& cB, unsigned& cab) {
    LAS unsigned* hq = (LAS unsigned*)(L + IXL_HIST) + (q & 15) * IX_ROW + (64 + IX_TOPBIN - 16) - 17 * lane; const int hsh = 16 * (q >> 4);
    unsigned cj[17]; unsigned tl = 0u;
#pragma unroll
    for (int j = 0; j < 17; ++j) { const unsigned v = (hq[16 - j] >> hsh) & 0xffffu; cj[j] = v; tl += v; }
    const unsigned inc = wave_incl_scan(tl, lane), above = inc - tl;
    const bool cross = above < 256u && 256u <= inc;
    unsigned b_ = 0u, c_ = 0u, a_ = 0u; { unsigned a = above; bool done = false;
#pragma unroll
        for (int j = 0; j < 17; ++j) { if (!done && a + cj[j] >= 256u) { b_ = (unsigned)(IX_TOPBIN - (17 * lane + j)); c_ = cj[j]; a_ = a; done = true; } a += cj[j]; } }
    const unsigned long long bal = __ballot(cross); const int src = bal ? (__ffsll((long long)bal) - 1) : 0;
    B = (unsigned)__shfl((int)b_, src); cB = (unsigned)__shfl((int)c_, src); cab = (unsigned)__shfl((int)a_, src);
    return bal != 0ull;
}
__device__ __forceinline__ void ix_group_scan(LAS unsigned* zhq, unsigned need, int lane, unsigned& gz, unsigned& before) {
    const unsigned w = zhq[lane >> 1]; const unsigned z0 = (w >> (16 * (lane & 1))) & 0xffu, z1 = (w >> (16 * (lane & 1) + 8)) & 0xffu;
    const unsigned tl = z0 + z1, inc = wave_incl_scan(tl, lane), bef = inc - tl;
    const bool cross = bef < need && need <= inc;
    const unsigned g = (bef + z0 >= need) ? (unsigned)(2 * lane) : (unsigned)(2 * lane + 1), b = (bef + z0 >= need) ? bef : bef + z0;
    const unsigned long long bal = __ballot(cross); const int src = bal ? (__ffsll((long long)bal) - 1) : 0;
    gz = (unsigned)__shfl((int)g, src); before = (unsigned)__shfl((int)b, src);
}

struct IxLane { unsigned thi, tlo, flags, gz, cmpkey; };
__device__ __forceinline__ float ix_relu(float x) { return __builtin_bit_cast(float, max(__builtin_bit_cast(int, x), 0)); }

template <int MODE, bool DIAG>
__device__ __forceinline__ void ix_tile(LAS unsigned char* L, f32x16 (&acc)[4], const f32x4 w4, int ks, int c, int hi, const IxLane st, bool act, unsigned& cnt) {
    LAS unsigned* hc = (LAS unsigned*)(L + IXL_HIST) + (c & 15) * IX_ROW + 64 + IX_CENTER;
    const unsigned hval = 1u << (16 * (c >> 4));
    LAS unsigned* zh = (LAS unsigned*)(L + IXL_ZH) + c * 32;
    const unsigned grp = (unsigned)ks >> 2;
    int cm = c - 4 * hi;
    if (DIAG) asm volatile("" : "+v"(cm));
    const bool tieLt = (st.flags & IXF_TIE) ? (grp < st.gz) : false, tieEq = (st.flags & IXF_TIE) ? (grp == st.gz) : true;

    float thif = __uint_as_float(st.thi), tlof = __uint_as_float(st.tlo);
    if (MODE == IXM_COLLECT) { thif = tieLt ? __uint_as_float(0x80000001u) : thif;
        tlof = (tieEq && !tieLt) ? tlof : __uint_as_float(0x7fc00000u); }
    unsigned mybits = 0u, nzs = 0u;
    typedef float f32x2i __attribute__((ext_vector_type(2)));
    const f32x2i wx = {w4.x, w4.x}, wy = {w4.y, w4.y}, wz = {w4.z, w4.z}, ww = {w4.w, w4.w};
#pragma unroll
    for (int r = 0; r < 16; ++r) {
        const int ko = (r & 3) + 8 * (r >> 2);
        f32x2i t2_;
        if ((r & 1) == 0) {
            { float s0 = ix_relu(acc[0][r]) * w4.x, s1 = ix_relu(acc[0][r + 1]) * w4.x;
              s0 = __builtin_fmaf(ix_relu(acc[1][r]), w4.y, s0); s1 = __builtin_fmaf(ix_relu(acc[1][r + 1]), w4.y, s1);
              s0 = __builtin_fmaf(ix_relu(acc[2][r]), w4.z, s0); s1 = __builtin_fmaf(ix_relu(acc[2][r + 1]), w4.z, s1);
              s0 = __builtin_fmaf(ix_relu(acc[3][r]), w4.w, s0); s1 = __builtin_fmaf(ix_relu(acc[3][r + 1]), w4.w, s1);
              asm volatile("" : "+v"(s0), "+v"(s1));
              t2_ = (f32x2i){s0, s1}; }
            acc[0][r + 1] = t2_.y; }
        const float sc = (r & 1) ? acc[0][r] : t2_.x;
        const unsigned u = __float_as_uint(sc);
        const bool ok = (DIAG ? (ko <= cm) : true) && ((MODE == IXM_COLLECT || MODE == IXM_HIST0) ? true : act);
        if (MODE == IXM_HIST0) {
            const int t = (int)((u >> IX_SH) & 0xfffu);
            int m1; asm("v_med3_i32 %0, %1, 1, %2" : "=v"(m1) : "v"(t - (IX_E0 - 2)), "s"(514));
            m1 = (int)min((unsigned)m1, u << 1);
            const int sm = (int)(((unsigned)((int)u >> 31) << 3) | 4u);
            unsigned hpa; asm("v_mad_i32_i24 %0, %1, %2, %3" : "=v"(hpa) : "v"(m1), "v"(sm), "v"((unsigned)(uintptr_t)hc));
            LAS unsigned* hp = (LAS unsigned*)(uintptr_t)hpa;
            if (DIAG) { if (ok) __hip_atomic_fetch_add(hp, hval, __ATOMIC_RELAXED, __HIP_MEMORY_SCOPE_WORKGROUP); nzs += ok ? (unsigned)min(m1, 1) : 1u; }
            else { __hip_atomic_fetch_add(hp, hval, __ATOMIC_RELAXED, __HIP_MEMORY_SCOPE_WORKGROUP); nzs += (unsigned)min(m1, 1); }
        } else if (MODE == IXM_COUNT) {
            cnt += (ok && ordkey(sc) > st.cmpkey) ? 1u : 0u;
        } else if (MODE == IXM_TIES) {
            if (ok && ordkey(sc) == st.cmpkey) __hip_atomic_fetch_add(&zh[grp >> 2], 1u << (8 * (grp & 3)), __ATOMIC_RELAXED, __HIP_MEMORY_SCOPE_WORKGROUP);
        } else {
            const unsigned long long Gm = __builtin_amdgcn_ballot_w64(sc > thif), Em = __builtin_amdgcn_ballot_w64(sc >= tlof);
            const bool gt = __builtin_amdgcn_inverse_ballot_w64(Gm); bool isc = __builtin_amdgcn_inverse_ballot_w64(Em & ~Gm);
            bool sel = gt;
            sel = sel && ok; isc = isc && ok;
            if (isc) { LAS unsigned* ccnt = (LAS unsigned*)(L + IXL_CCNT) + c; const unsigned pos = __hip_atomic_fetch_add(ccnt, 1u, __ATOMIC_RELAXED, __HIP_MEMORY_SCOPE_WORKGROUP);
                { const unsigned pos_ = pos; const unsigned pos = min(pos_, (unsigned)IX_CAP - 1u);
                  ((LAS unsigned*)(L + IXL_CANDK) + c * IX_CAP)[pos] = __float_as_uint(sc);     ((LAS unsigned short*)(L + IXL_CANDI) + c * IX_CAP)[pos] = (unsigned short)(32 * ks + ko + 4 * hi); } }
            mybits |= sel ? (1u << ko) : 0u;
        }
        if (r & 1) __builtin_amdgcn_sched_barrier(0);
    }
    if (MODE == IXM_HIST0) { const unsigned nz = act ? 16u - nzs : 0u; if (nz) __hip_atomic_fetch_add(&zh[grp >> 2], nz << (8 * (grp & 3)), __ATOMIC_RELAXED, __HIP_MEMORY_SCOPE_WORKGROUP); }
    if (MODE == IXM_COLLECT) { mybits <<= 4 * hi; const unsigned word = mybits | (unsigned)__shfl_xor((int)mybits, 32);
        if (hi == 0) ((LAS unsigned*)(L + IXL_IMG))[(((ks >> 1) * 32 + c) << 1) + (ks & 1)] = word; }
}

template <int MODE>
__device__ __forceinline__ void ix_pass(LAS unsigned char* L, const half8 (&qf)[4][4], const f32x4 w4, const unsigned short* KI, int qg, int wv, int lane, const IxLane st) {
    const int c = lane & 31, hi = lane >> 5;
    unsigned cnt = 0u;
    const bool act = (MODE == IXM_COUNT) ? ((st.flags & IXF_OVF) != 0u) : (MODE == IXM_TIES) ? ((st.flags & IXF_NEEDTIE) != 0u) : true;
    const unsigned short* kp = KI + (size_t)c * 64 + 32 * hi;
    IxLane sv = st;
    for (int ks = wv; ks <= qg; ks += 8) {
        half8 a[4];
#pragma unroll
        for (int s = 0; s < 4; ++s) a[s] = *(const GAS half8*)(kp + (size_t)ks * 2048 + 8 * s);
        f32x16 acc[4];
#pragma unroll
        for (int h = 0; h < 4; ++h) { acc[h] = (f32x16){};
#pragma unroll
            for (int s = 0; s < 4; ++s) acc[h] = __builtin_amdgcn_mfma_f32_32x32x16_f16(a[s], qf[h][s], acc[h], 0, 0, 0); }
        if (ks == qg) ix_tile<MODE, true>(L, acc, w4, ks, c, hi, sv, act, cnt);
        else ix_tile<MODE, false>(L, acc, w4, ks, c, hi, sv, act, cnt);
    }
    if (MODE == IXM_COUNT) { if (act && cnt) __hip_atomic_fetch_add((LAS unsigned*)(L + IXL_CNT) + c, cnt, __ATOMIC_RELAXED, __HIP_MEMORY_SCOPE_WORKGROUP); }
}

__device__ __forceinline__ void indexer_fast(Frame& F, KArgs A) {
    unsigned char* ws = A->ws;
    const unsigned short* QI = (const unsigned short*)(ws + WS_QI); const unsigned short* KI = (const unsigned short*)(ws + WS_KI); const float* WI = (const float*)(ws + WS_WI);
    unsigned char* maskW = ws + WS_MASK;
    LAS unsigned char* L = F.lds;
    const int tid = F.tid, lane = F.lane, wv = F.wave, c = lane & 31, hi = lane >> 5;
    LAS unsigned* ST = (LAS unsigned*)(L + IXL_ST); LAS unsigned* ST2 = (LAS unsigned*)(L + IXL_ST2); LAS unsigned* CNT = (LAS unsigned*)(L + IXL_CNT);
    LAS unsigned* CCNT = (LAS unsigned*)(L + IXL_CCNT); LAS unsigned* FLAG = (LAS unsigned*)(L + IXL_FLAG);
#pragma unroll 1
    for (int it = 0; it < 2; ++it) {
        const int qg = it ? (int)blockIdx.x : 511 - (int)blockIdx.x;
        const int t = 32 * qg + c;
        half8 qf[4][4];
#pragma unroll
        for (int h = 0; h < 4; ++h)
#pragma unroll
            for (int s = 0; s < 4; ++s) qf[h][s] = *(const GAS half8*)(QI + (size_t)t * 256 + 64 * h + 32 * hi + 8 * s);
        const f32x4 w4 = *(const GAS f32x4*)(WI + (size_t)t * 4);
        __syncthreads();
        static_assert(IXL_END % 16 == 0, "");
        for (int u = tid; u < IXL_END / 16; u += NWAVES * 64) ((LAS v4u*)L)[u] = (v4u){0u, 0u, 0u, 0u};
        __syncthreads();
        IxLane st{0u, 0u, 0u, 0u, (unsigned)(-1024)};
#ifdef DIAG_TIME
#define TSTAMP(k) do { if (blockIdx.x == 0 && it == 0 && tid == 0) ((unsigned long long*)(ws + WS_CTL + 16384))[k] = __builtin_amdgcn_s_memrealtime(); } while (0)
#else
#define TSTAMP(k) do {} while (0)
#endif
        TSTAMP(0);
#ifndef REP_HIST
#define REP_HIST 1
#endif
#ifndef REP_COLL
#define REP_COLL 1
#endif
#pragma unroll 1
        for (int rep = 0; rep < REP_HIST; ++rep) {
            if (rep) { __syncthreads(); for (int u = tid; u < IXL_CANDK / 4; u += NWAVES * 64) ((LAS unsigned*)L)[u] = 0u; __syncthreads(); }
            ix_pass<IXM_HIST0>(L, qf, w4, KI, qg, wv, lane, st); }
        __syncthreads();
        TSTAMP(1);
#pragma unroll 1
        for (int qi = 0; qi < 4; ++qi) {
            const int q = 4 * wv + qi, n = 32 * qg + q + 1;
            if (n <= 256) { if (lane == 0) { ST[q * 8 + 0] = 0x007fffffu; ST[q * 8 + 1] = 0xff800000u; } continue; }
            unsigned B, cB, cab; (void)ix_scan_row(L, q, lane, B, cB, cab);
            const unsigned r = 256u - cab;
            unsigned flags = 0u, gz = 0u, rn = r, klo, khi;
            if (B == (unsigned)IX_CENTER) { klo = 0x7fffffffu; khi = 0x80000000u; } else ix_bin_range((int)B, klo, khi);
            if (cB > (unsigned)IX_CAP) {
                if (B == (unsigned)IX_CENTER) { unsigned before; ix_group_scan((LAS unsigned*)(L + IXL_ZH) + q * 32, r, lane, gz, before); rn = r - before; flags = IXF_TIE; }
                else { flags = IXF_OVF;
                    if (lane == 0) { ST2[q * 4 + 0] = klo - 1u; ST2[q * 4 + 1] = khi; ST2[q * 4 + 2] = cab + cB; ST2[q * 4 + 3] = cab; FLAG[0] = 1u; }
#ifdef DIAG_OVF
                    if (lane == 0) { unsigned* dg = (unsigned*)(ws + WS_CTL) + 2048; atomicAdd(dg + 0, 1u); atomicMax(dg + 1, cB); atomicMax(dg + 2, (cB << 16) | B); atomicMax(dg + 3, (cB << 16) | (unsigned)n); }
#endif
                    }
            }
            if (lane == 0) { ST[q * 8 + 0] = khi; ST[q * 8 + 1] = klo; ST[q * 8 + 2] = flags; ST[q * 8 + 3] = rn; ST[q * 8 + 4] = gz; }
        }
        __syncthreads();
        if (FLAG[0] != 0u) {
#pragma unroll 1
            for (int iter = 0; iter < 40; ++iter) {
                const unsigned fl = ST[c * 8 + 2], lo = ST2[c * 4 + 0], hh = ST2[c * 4 + 1];
                const bool actv = (fl & IXF_OVF) && (hh - lo > 1u);
                if (!__any(actv)) break;
                const unsigned mid = lo + ((hh - lo) >> 1);
                if (tid < 32) CNT[tid] = 0u;
                __syncthreads();
                IxLane sc{0u, 0u, actv ? (unsigned)IXF_OVF : 0u, 0u, mid};
                ix_pass<IXM_COUNT>(L, qf, w4, KI, qg, wv, lane, sc);
                __syncthreads();
                if (tid < 32 && actv) { const unsigned g = CNT[tid]; if (g >= 256u) { ST2[tid * 4 + 0] = mid; ST2[tid * 4 + 2] = g; } else { ST2[tid * 4 + 1] = mid; ST2[tid * 4 + 3] = g; } }
                __syncthreads();
            }
            if (tid < 32 && (ST[tid * 8 + 2] & IXF_OVF)) { const unsigned T = ST2[tid * 4 + 1], glo = ST2[tid * 4 + 2], ghi = ST2[tid * 4 + 3];
                ST[tid * 8 + 0] = T; ST[tid * 8 + 1] = T; ST[tid * 8 + 3] = 256u - ghi;
                const bool nt = (glo - ghi) > (unsigned)IX_CAP; ST[tid * 8 + 2] = (nt ? (unsigned)IXF_NEEDTIE : 0u);
                if (nt) { FLAG[1] = 1u; for (int k = 0; k < 32; ++k) ((LAS unsigned*)(L + IXL_ZH))[tid * 32 + k] = 0u; } }
            __syncthreads();
            if (FLAG[1] != 0u) {
                IxLane sc{0u, 0u, ST[c * 8 + 2], 0u, ST[c * 8 + 0]};
                ix_pass<IXM_TIES>(L, qf, w4, KI, qg, wv, lane, sc);
                __syncthreads();
#pragma unroll 1
                for (int qi = 0; qi < 4; ++qi) { const int q = 4 * wv + qi; const unsigned fl = ST[q * 8 + 2];
                    if (fl & IXF_NEEDTIE) { unsigned gz, before; ix_group_scan((LAS unsigned*)(L + IXL_ZH) + q * 32, ST[q * 8 + 3], lane, gz, before);
                        if (lane == 0) { ST[q * 8 + 3] -= before; ST[q * 8 + 4] = gz; ST[q * 8 + 2] = IXF_TIE; } } }
                __syncthreads();
            }
        }
        TSTAMP(2);
        const unsigned khi_ = ST[c * 8 + 0], klo_ = ST[c * 8 + 1];
        const IxLane sl{(khi_ & 0x80000000u) ? (khi_ & 0x7fffffffu) : ~khi_, (klo_ & 0x80000000u) ? (klo_ & 0x7fffffffu) : ~klo_, ST[c * 8 + 2], ST[c * 8 + 4], 0u};
#pragma unroll 1
        for (int rep = 0; rep < REP_COLL; ++rep) {
            __syncthreads();
            for (int u = tid; u < 65536 / 16; u += NWAVES * 64) ((LAS v4u*)(L + IXL_IMG))[u] = (v4u){0u, 0u, 0u, 0u};
            if (tid < 32) CCNT[tid] = 0u;
            __syncthreads();
            ix_pass<IXM_COLLECT>(L, qf, w4, KI, qg, wv, lane, sl); }
        __syncthreads();
        TSTAMP(3);
#pragma unroll 1
        for (int qi = 0; qi < 4; ++qi) { const int q = 4 * wv + qi; const int nc = (int)min(CCNT[q], (unsigned)IX_CAP); const unsigned rn = ST[q * 8 + 3];
            if (nc == 0 || rn == 0u) continue;
            const LAS unsigned* ckq = (const LAS unsigned*)(L + IXL_CANDK) + q * IX_CAP; const LAS unsigned short* ciq = (const LAS unsigned short*)(L + IXL_CANDI) + q * IX_CAP;
            unsigned kk[4], ii[4], rk[4];
#pragma unroll
            for (int m = 0; m < 4; ++m) { const int id = lane + 64 * m; const bool v = id < nc; kk[m] = v ? ordkey(__uint_as_float(ckq[id])) : 0u; ii[m] = v ? (unsigned)ciq[id] : 0xffffu; rk[m] = 0u; }
            if (nc <= 64) {
                const unsigned long long me0 = ((unsigned long long)kk[0] << 32) | (0xffffu - ii[0]);
#pragma unroll 2
                for (int jj = 0; jj < nc; ++jj) { const unsigned kj = (unsigned)__builtin_amdgcn_readlane((int)kk[0], jj), ij = (unsigned)__builtin_amdgcn_readlane((int)ii[0], jj);
                    rk[0] += ((((unsigned long long)kj << 32) | (0xffffu - ij)) > me0) ? 1u : 0u; }
            } else if (nc <= 128) {
#pragma unroll
                for (int ch = 0; ch < 2; ++ch) { const int cntc = min(64, nc - 64 * ch);
#pragma unroll 2
                    for (int jj = 0; jj < cntc; ++jj) { const unsigned kj = (unsigned)__builtin_amdgcn_readlane((int)kk[ch], jj), ij = (unsigned)__builtin_amdgcn_readlane((int)ii[ch], jj);
#pragma unroll
                        for (int m = 0; m < 2; ++m) rk[m] += ((((unsigned long long)kj << 32) | (0xffffu - ij)) > ((((unsigned long long)kk[m]) << 32) | (0xffffu - ii[m]))) ? 1u : 0u; } }
            } else {
#pragma unroll
            for (int ch = 0; ch < 4; ++ch) { const int cntc = min(64, nc - 64 * ch);
                if (cntc > 0) {
#pragma unroll 2
                    for (int jj = 0; jj < cntc; ++jj) { const unsigned kj = (unsigned)__builtin_amdgcn_readlane((int)kk[ch], jj), ij = (unsigned)__builtin_amdgcn_readlane((int)ii[ch], jj);
#pragma unroll
                        for (int m = 0; m < 4; ++m) rk[m] += ((((unsigned long long)kj << 32) | (0xffffu - ij)) > ((((unsigned long long)kk[m]) << 32) | (0xffffu - ii[m]))) ? 1u : 0u; } } }
            }
#pragma unroll
            for (int m = 0; m < 4; ++m) { const int id = lane + 64 * m; const unsigned mi = ii[m];
                if (id < nc && rk[m] < rn) __hip_atomic_fetch_or((LAS unsigned*)(L + IXL_IMG) + ((((mi >> 6) * 32 + (unsigned)q) << 1) + ((mi >> 5) & 1u)), 1u << (mi & 31u), __ATOMIC_RELAXED, __HIP_MEMORY_SCOPE_WORKGROUP); } }
        __syncthreads();
        TSTAMP(4);
        { const int ntile = 4 * (qg / 8 + 1);
          unsigned char* const mw_ = kargs()->ws + WS_MASK;
          int tq = tid; asm volatile("" : "+v"(tq));
          for (int tt = tq >> 4; tt < ntile; tt += NWAVES * 4) *(GAS v4u*)(mw_ + ((size_t)tt * M + 32 * qg) * 8 + (tq & 15) * 16) = *(const LAS v4u*)(L + IXL_IMG + tt * 256 + (tq & 15) * 16); }
        TSTAMP(5);
    }
    __syncthreads();
}

#include <hip/hip_bf16.h>
#include <cmath>
namespace attn_body {
using bf16=__hip_bfloat16;
using bf16x8=__attribute__((ext_vector_type(8)))short;
using s16x4=__attribute__((ext_vector_type(4)))short;
using f32x16=__attribute__((ext_vector_type(16)))float;
using u32x4=__attribute__((ext_vector_type(4)))unsigned;
constexpr int BATCH=1,NHEAD=8,SEQ=16384,D=64,DM=NHEAD*D;
constexpr int NW=8,QBLK=32,QB=QBLK*NW,KVBLK=64,NQB=SEQ/QB;
constexpr int ATTN_PITCH=DM, ATTN_UNIT_ROWS=QB;
__device__ __forceinline__ int crow(int r,int hi){return (r&3)+8*(r>>2)+4*hi;}
#define SBAR() __builtin_amdgcn_sched_barrier(0)
constexpr int NSLOT=3, SLOTB=8192;
constexpr int LDS_K=0, LDS_V=NSLOT*SLOTB, LDS_WS=2*NSLOT*SLOTB, LDS_OST=LDS_WS+NW*64*4, LDS_MK=LDS_OST+NW*4096, LDS_BT=LDS_MK+NW*768, LDS_BYTES=LDS_BT+512;
constexpr float C2=0.125f*1.4426950408889634f;
__device__ __forceinline__ void glds4(const void*gsrc,unsigned lds_dst){unsigned keep;
  asm volatile("s_mov_b32 %0, m0\n\ts_mov_b32 m0, %2\n\ts_nop 0\n\tglobal_load_lds_dword %1, off\n\ts_mov_b32 m0, %0":"=&s"(keep):"v"(gsrc),"s"(lds_dst):"memory");}
__device__ __forceinline__ void glds16(const void*gsrc,unsigned lds_dst){unsigned keep;
  asm volatile("s_mov_b32 %0, m0\n\ts_mov_b32 m0, %2\n\ts_nop 0\n\tglobal_load_lds_dwordx4 %1, off\n\ts_mov_b32 m0, %0":"=&s"(keep):"v"(gsrc),"s"(lds_dst):"memory");}
__device__ __forceinline__ float max3f(float a,float b,float c){float r;asm("v_max3_f32 %0, %1, %2, %3":"=v"(r):"v"(a),"v"(b),"v"(c));return r;}
__device__ __forceinline__ float max2f(float a,float b){float r;asm("v_max_f32_e32 %0, %1, %2":"=v"(r):"v"(a),"v"(b));return r;}
__device__ __forceinline__ float fadd_s(float a,float b){float r;asm("v_add_f32_e32 %0, %1, %2":"=v"(r):"v"(a),"v"(b));return r;}
__device__ __forceinline__ float fsub_s(float a,float b){float r;asm("v_sub_f32_e32 %0, %1, %2":"=v"(r):"v"(a),"v"(b));return r;}
typedef float f32x2_t __attribute__((ext_vector_type(2))); typedef __bf16 bf16x2_t __attribute__((ext_vector_type(2)));
__device__ __forceinline__ unsigned cvtpk_s(float lo,float hi){f32x2_t v={lo,hi};bf16x2_t b=__builtin_convertvector(v,bf16x2_t);return __builtin_bit_cast(unsigned,b);}
#define WAIT_BAR(N) asm volatile("s_waitcnt vmcnt(" #N ") lgkmcnt(0)\n\ts_barrier":::"memory")

__device__ __forceinline__ void qkt(f32x16&p0,f32x16&p1,const char*Kslot,const bf16x8*qr,const f32x16&negm,int r32,int hi){
  const char*kb=Kslot+hi*1024+r32*16;
  #pragma unroll
  for(int d0=0;d0<4;++d0){
    const bf16x8 b0=*reinterpret_cast<const bf16x8*>(kb+d0*2048);
    const bf16x8 b1=*reinterpret_cast<const bf16x8*>(kb+d0*2048+512);
    if(d0==0){p0=__builtin_amdgcn_mfma_f32_32x32x16_bf16(b0,qr[0],negm,0,0,0);p1=__builtin_amdgcn_mfma_f32_32x32x16_bf16(b1,qr[0],negm,0,0,0);}
    else{p0=__builtin_amdgcn_mfma_f32_32x32x16_bf16(b0,qr[d0],p0,0,0,0);p1=__builtin_amdgcn_mfma_f32_32x32x16_bf16(b1,qr[d0],p1,0,0,0);}}
}
typedef __attribute__((address_space(3))) const char* lds_cptr;
typedef short v4i16_t __attribute__((ext_vector_type(4)));
__device__ __forceinline__ void kload8(bf16x8*kf,lds_cptr kp){
  kf[0]=*(const __attribute__((address_space(3))) bf16x8*)(kp);      kf[1]=*(const __attribute__((address_space(3))) bf16x8*)(kp+512);
  kf[2]=*(const __attribute__((address_space(3))) bf16x8*)(kp+2048); kf[3]=*(const __attribute__((address_space(3))) bf16x8*)(kp+2560);
  kf[4]=*(const __attribute__((address_space(3))) bf16x8*)(kp+4096); kf[5]=*(const __attribute__((address_space(3))) bf16x8*)(kp+4608);
  kf[6]=*(const __attribute__((address_space(3))) bf16x8*)(kp+6144); kf[7]=*(const __attribute__((address_space(3))) bf16x8*)(kp+6656);
}
__device__ __forceinline__ void kload2(bf16x8*kf,lds_cptr kp,int j){ kf[2*j]=*(const __attribute__((address_space(3))) bf16x8*)(kp+j*2048); kf[2*j+1]=*(const __attribute__((address_space(3))) bf16x8*)(kp+j*2048+512); }
__device__ __forceinline__ s16x4 vtr(lds_cptr p){ return __builtin_bit_cast(s16x4,__builtin_amdgcn_ds_read_tr16_b64_v4i16((__attribute__((address_space(3))) v4i16_t*)p)); }
__device__ __forceinline__ float rowmax(const f32x16&p0,const f32x16&p1){
  float a=max3f(p0[0],p0[1],p1[0]),b=max3f(p0[2],p0[3],p1[1]);a=max3f(a,p1[2],p1[3]);
  #pragma unroll
  for(int r=4;r<16;r+=4){a=max3f(a,p0[r],p0[r+1]);b=max3f(b,p0[r+2],p0[r+3]);a=max3f(a,p1[r],p1[r+1]);b=max3f(b,p1[r+2],p1[r+3]);}
  const float m=max2f(a,b);
  auto rr=__builtin_amdgcn_permlane32_swap(__float_as_uint(m),__float_as_uint(m),false,false);
  return max2f(__uint_as_float(rr[0]),__uint_as_float(rr[1]));
}
__device__ __forceinline__ void pv(f32x16*o,int vb,bf16x8 pa0,bf16x8 pa1,bf16x8 pa2,bf16x8 pa3){
  #pragma unroll
  for(int d0=0;d0<2;++d0){s16x4 lo[4],hi[4];
    #pragma unroll
    for(int ks=0;ks<4;++ks){
      asm volatile("ds_read_b64_tr_b16 %0,%1 offset:%c2":"=&v"(lo[ks]):"v"(vb),"i"(d0*4096+ks*1024):"memory");
      asm volatile("ds_read_b64_tr_b16 %0,%1 offset:%c2":"=&v"(hi[ks]):"v"(vb),"i"(d0*4096+ks*1024+512):"memory");}
    asm volatile("s_waitcnt lgkmcnt(0)":::"memory");SBAR();
    #define PK(k) (bf16x8){lo[k][0],lo[k][1],lo[k][2],lo[k][3],hi[k][0],hi[k][1],hi[k][2],hi[k][3]}
    o[d0]=__builtin_amdgcn_mfma_f32_32x32x16_bf16(pa0,PK(0),o[d0],0,0,0);
    o[d0]=__builtin_amdgcn_mfma_f32_32x32x16_bf16(pa1,PK(1),o[d0],0,0,0);
    o[d0]=__builtin_amdgcn_mfma_f32_32x32x16_bf16(pa2,PK(2),o[d0],0,0,0);
    o[d0]=__builtin_amdgcn_mfma_f32_32x32x16_bf16(pa3,PK(3),o[d0],0,0,0);
    #undef PK
  }
}

#ifndef ATTN_STORE16
#define ATTN_STORE16(p,v) (*(u32x4*)(p)=(v))
#endif
__device__ __forceinline__ void attn_unit(int h,int qb,const bf16*Q,const bf16*__restrict__ K,const bf16*__restrict__ V,bf16*O,const unsigned char*maskT,char*shm,const int wid){
  const int lane=lane_now(),tid=wid*64+lane,r32=lane&31,hi=lane>>5;
  const long rowbase=0; const int q0=qb*QB;
  const bf16*Qw=Q+(rowbase+q0+wid*QBLK)*DM+h*D;
  const bf16*Kh=K+rowbase*DM+h*D,*Vh=V+rowbase*DM+h*D;
  const unsigned lds0=(unsigned)(uintptr_t)shm;
  float*wsf=(float*)(shm+LDS_WS)+wid*64;
  const bf16*ksrc=Kh+(long)lane*DM+wid*8;
  const bf16*vsrc=Vh+(long)(16*(wid&3)+(lane>>2))*DM+(wid>>2)*32+(lane&3)*8;
  const unsigned kdst=lds0+LDS_K+wid*1024, vdst=lds0+LDS_V+wid*1024;
  #define DMA_K(t,slot) glds16(ksrc+(long)(t)*KVBLK*DM,(unsigned)__builtin_amdgcn_readfirstlane(kdst+(slot)))
  #define DMA_V(t,slot) glds16(vsrc+(long)(t)*KVBLK*DM,(unsigned)__builtin_amdgcn_readfirstlane(vdst+(slot)))
  const int vb0=(int)(lds0+LDS_V)+((lane>>4)&1)*32+(lane&3)*8+(4*hi+((lane&15)>>2))*64;
  const char*Kbase=shm+LDS_K; bf16x8 kf[8];
  const lds_cptr shm3=(lds_cptr)shm; const lds_cptr kp0=shm3+LDS_K+hi*1024+r32*16; const lds_cptr vp0=shm3+LDS_V+((lane>>4)&1)*32+(lane&3)*8+(4*hi+((lane&15)>>2))*64;
  const int NT=(q0+QB)/KVBLK;
  const unsigned char*msrc=maskT+((size_t)(q0+wid*QBLK))*8+lane*4;
  const unsigned mdst=lds0+LDS_MK+wid*768;
  #define DMA_M(t,slot) glds4(msrc+(size_t)(t)*((size_t)SEQ*8),(unsigned)__builtin_amdgcn_readfirstlane(mdst+((slot)>>5)))
  const lds_cptr mp0=shm3+LDS_MK+wid*768+r32*8;
  const __attribute__((address_space(3))) float* bt3=(const __attribute__((address_space(3))) float*)(shm3+LDS_BT);
  const int qpos=q0+wid*QBLK+r32;
  unsigned m0=0u,m1=0u;
  #define MASKLD(slot) do{ const unsigned long long mw_=*(const __attribute__((address_space(3))) unsigned long long*)(mp0+((slot)>>5)); m0=((unsigned)mw_)>>(4*hi); m1=((unsigned)(mw_>>32))>>(4*hi); }while(0)
  #define MBIT(r) (((r)&3)+8*((r)>>2))
  #define MAND(x,mw,r) x=__uint_as_float(__float_as_uint(x)&(unsigned)(((int)((mw)<<(31-MBIT(r))))>>31))
  #define MANDA(x,mw,r) do{ int t_; float x_=(x); asm("v_bfe_i32 %1, %2, %3, 1\n\tv_and_b32 %0, %0, %1":"+v"(x_),"=&v"(t_):"v"(mw),"i"(MBIT(r))); (x)=x_; }while(0)
  #define BAND(P0,P1,t) do{ const int kb_=qpos-64*(t)-4*hi; \
      _Pragma("unroll") for(int r=0;r<16;++r){ const int d0_=kb_-MBIT(r); P0[r]+=bt3[min(max(d0_,0),127)]; P1[r]+=bt3[min(max(d0_-32,0),127)]; } }while(0)
  DMA_M(0,0);DMA_M(1,SLOTB);DMA_K(0,0);DMA_V(0,0);DMA_K(1,SLOTB);
  bf16x8 qr[4];
  #pragma unroll
  for(int d0=0;d0<4;++d0)qr[d0]=*reinterpret_cast<const bf16x8*>(&Qw[(long)r32*DM+d0*16+hi*8]);
  float l_reg=0.f;f32x16 o[2];o[0]=f32x16{};o[1]=f32x16{};const f32x16 negm=f32x16{};
  f32x16 pA0,pA1,pB0,pB1;
  int sl_prev=0,sl_cur=0,sl_next=SLOTB;
  #define ROT() do{sl_prev=sl_cur;sl_cur=sl_next;sl_next=(sl_next==(NSLOT-1)*SLOTB)?0:sl_next+SLOTB;}while(0)
  DMA_K(2,2*SLOTB);
  WAIT_BAR(3);
  qkt(pA0,pA1,Kbase,qr,negm,r32,hi);asm volatile("s_nop 15\n\ts_nop 7":"+v"(pA0),"+v"(pA1));
  if(NT<=6)BAND(pA0,pA1,0);
  MASKLD(0);
  _Pragma("unroll") for(int r=0;r<16;++r){pA0[r]=__builtin_amdgcn_exp2f(pA0[r]);MAND(pA0[r],m0,r);pA1[r]=__builtin_amdgcn_exp2f(pA1[r]);MAND(pA1[r],m1,r);}
  WAIT_BAR(0);
  DMA_M(2,2*SLOTB);DMA_K(3,0);DMA_V(1,SLOTB);
  ROT();
  kload8(kf,kp0+sl_cur);
  WAIT_BAR(3);
  s16x4 vlo[8],vhi[8]; u32x4 pw0,pw1,pw2,pw3;
  #define PKW(P,B) cvtpk_s(P[B],P[B+1])
  #define PAF(k) __builtin_bit_cast(bf16x8,pw##k)
  #define VFR(i) (bf16x8){vlo[i][0],vlo[i][1],vlo[i][2],vlo[i][3],vhi[i][0],vhi[i][1],vhi[i][2],vhi[i][3]}
  #define PIN(x) asm volatile("":"+v"(x))
  #define MX3(a,b,c) __builtin_fmaxf(__builtin_fmaxf((a),(b)),(c))
  #define GAPA(MF,A0,A1,A2,A3,W0,W1,PW) do{ MF; sacc+=A0; sacc+=A1; sacc+=A2; sacc+=A3; PIN(sacc); W0; W1; PIN(PW); SBAR(); }while(0)
  #define EX(v) __builtin_amdgcn_exp2f(v)
  #define GAPB(MF,X,B,MW) do{ MF; X[B]=EX(X[B]); X[B+1]=EX(X[B+1]); X[B+2]=EX(X[B+2]); X[B+3]=EX(X[B+3]); MANDA(X[B],MW,B); MANDA(X[B+1],MW,B+1); MANDA(X[B+2],MW,B+2); MANDA(X[B+3],MW,B+3); PIN(X); SBAR(); }while(0)
  #define VRD(i) do{ vlo[i]=vtr(vp_+(((i)>>2)*4096+((i)&3)*1024)); vhi[i]=vtr(vp_+(((i)>>2)*4096+((i)&3)*1024+512)); }while(0)
  #define KRD(G,j) do{ if(G){ kload2(kf,kp0+sl_next,j); SBAR(); } }while(0)
  #define STEP(C0,C1,P0,P1,t,GK,GV,GL,GM,BND) do{ SBAR(); \
    const lds_cptr vp_=vp0+sl_prev; \
    VRD(0); SBAR(); float sacc=(P0[0]+P0[1]); \
    GAPA(C0=__builtin_amdgcn_mfma_f32_32x32x16_bf16(kf[0],qr[0],negm,0,0,0), P0[2],P0[3],P0[4],P0[5],     pw0[0]=PKW(P0,0), pw0[1]=PKW(P0,2), pw0); \
    VRD(4); SBAR(); GAPA(C1=__builtin_amdgcn_mfma_f32_32x32x16_bf16(kf[1],qr[0],negm,0,0,0), P0[6],P0[7],P0[8],P0[9],     pw0[2]=PKW(P0,4), pw0[3]=PKW(P0,6), pw0); \
    VRD(1); SBAR(); GAPA(C0=__builtin_amdgcn_mfma_f32_32x32x16_bf16(kf[2],qr[1],C0,0,0,0),   P0[10],P0[11],P0[12],P0[13], pw1[0]=PKW(P0,8), pw1[1]=PKW(P0,10), pw1); \
    VRD(5); SBAR(); GAPA(C1=__builtin_amdgcn_mfma_f32_32x32x16_bf16(kf[3],qr[1],C1,0,0,0),   P0[14],P0[15],P1[0],P1[1],   pw1[2]=PKW(P0,12),pw1[3]=PKW(P0,14), pw1); \
    VRD(2); SBAR(); GAPA(C0=__builtin_amdgcn_mfma_f32_32x32x16_bf16(kf[4],qr[2],C0,0,0,0),   P1[2],P1[3],P1[4],P1[5],     pw2[0]=PKW(P1,0), pw2[1]=PKW(P1,2), pw2); \
    VRD(6); SBAR(); GAPA(C1=__builtin_amdgcn_mfma_f32_32x32x16_bf16(kf[5],qr[2],C1,0,0,0),   P1[6],P1[7],P1[8],P1[9],     pw2[2]=PKW(P1,4), pw2[3]=PKW(P1,6), pw2); \
    VRD(3); SBAR(); GAPA(C0=__builtin_amdgcn_mfma_f32_32x32x16_bf16(kf[6],qr[3],C0,0,0,0),   P1[10],P1[11],P1[12],P1[13], pw3[0]=PKW(P1,8), pw3[1]=PKW(P1,10), pw3); \
    VRD(7); SBAR(); GAPA(C1=__builtin_amdgcn_mfma_f32_32x32x16_bf16(kf[7],qr[3],C1,0,0,0),   P1[14],P1[15],0.f,0.f,       pw3[2]=PKW(P1,12),pw3[3]=PKW(P1,14), pw3); \
    l_reg+=sacc; \
    if(GM){DMA_M((t)+2,sl_prev);} if(GK){DMA_K((t)+3,sl_cur);} if(GV){DMA_V((t)+1,sl_next);} \
    if(BND){ if((t)>=NT-6) BAND(C0,C1,t); } \
    MASKLD(sl_cur); \
    SBAR(); \
    GAPB(o[0]=__builtin_amdgcn_mfma_f32_32x32x16_bf16(PAF(0),VFR(0),o[0],0,0,0), C0,0,m0); \
    GAPB(o[1]=__builtin_amdgcn_mfma_f32_32x32x16_bf16(PAF(0),VFR(4),o[1],0,0,0), C0,4,m0); \
    KRD(GL,0); GAPB(o[0]=__builtin_amdgcn_mfma_f32_32x32x16_bf16(PAF(1),VFR(1),o[0],0,0,0), C0,8,m0); \
    KRD(GL,1); GAPB(o[1]=__builtin_amdgcn_mfma_f32_32x32x16_bf16(PAF(1),VFR(5),o[1],0,0,0), C0,12,m0); \
    KRD(GL,2); GAPB(o[0]=__builtin_amdgcn_mfma_f32_32x32x16_bf16(PAF(2),VFR(2),o[0],0,0,0), C1,0,m1); \
    KRD(GL,3); GAPB(o[1]=__builtin_amdgcn_mfma_f32_32x32x16_bf16(PAF(2),VFR(6),o[1],0,0,0), C1,4,m1); \
    GAPB(o[0]=__builtin_amdgcn_mfma_f32_32x32x16_bf16(PAF(3),VFR(3),o[0],0,0,0), C1,8,m1); \
    GAPB(o[1]=__builtin_amdgcn_mfma_f32_32x32x16_bf16(PAF(3),VFR(7),o[1],0,0,0), C1,12,m1); \
    }while(0)
  int t=1;
  for(;t+7<NT;t+=2){
    STEP(pB0,pB1,pA0,pA1,t,true,true,true,true,false);     WAIT_BAR(3); ROT();
    STEP(pA0,pA1,pB0,pB1,t+1,true,true,true,true,false);   WAIT_BAR(3); ROT();
  }
  #define ENDW(tt) do{ if((tt)+3<NT){WAIT_BAR(3);} else if((tt)+2<NT){WAIT_BAR(2);} else {WAIT_BAR(0);} }while(0)
  for(;t+1<NT;t+=2){
    STEP(pB0,pB1,pA0,pA1,t,(t+3<NT),(t+1<NT),(t+1<NT),(t+2<NT),true);       ENDW(t);   ROT();
    STEP(pA0,pA1,pB0,pB1,t+1,(t+4<NT),(t+2<NT),(t+2<NT),(t+3<NT),true);     ENDW(t+1); ROT();
  }
  STEP(pB0,pB1,pA0,pA1,NT-1,false,false,false,false,true);
  { float sacc=pB0[0]+pB0[1]; _Pragma("unroll") for(int r=2;r<16;++r)sacc+=pB0[r]; _Pragma("unroll") for(int r=0;r<16;++r)sacc+=pB1[r]; l_reg+=sacc;
    pw0=(u32x4){PKW(pB0,0),PKW(pB0,2),PKW(pB0,4),PKW(pB0,6)};pw1=(u32x4){PKW(pB0,8),PKW(pB0,10),PKW(pB0,12),PKW(pB0,14)};pw2=(u32x4){PKW(pB1,0),PKW(pB1,2),PKW(pB1,4),PKW(pB1,6)};pw3=(u32x4){PKW(pB1,8),PKW(pB1,10),PKW(pB1,12),PKW(pB1,14)};
    SBAR(); pv(o,vb0+sl_cur,PAF(0),PAF(1),PAF(2),PAF(3)); }
  #undef PKW
  #undef PAF
  #undef VFR
  #undef PIN
  #undef MX3
  #undef GAPA
  #undef GAPB
  #undef EX
  #undef VRD
  #undef KRD
  #undef STEP
  #undef ENDW
  {auto rr=__builtin_amdgcn_permlane32_swap(__float_as_uint(l_reg),__float_as_uint(l_reg),false,false);l_reg=__uint_as_float(rr[0])+__uint_as_float(rr[1]);}
  if(hi==0)wsf[32+r32]=l_reg;asm volatile("s_waitcnt lgkmcnt(0)":::"memory");
  float rli[16];
  #pragma unroll
  for(int r=0;r<16;++r)rli[r]=__builtin_amdgcn_rcpf(wsf[32+crow(r,hi)]);
  bf16*Ow=O+(rowbase+q0+wid*QBLK)*DM+h*D;
  { bf16*stg=(bf16*)(shm+LDS_OST)+wid*2048;
    #pragma unroll
    for(int r=0;r<16;++r){const int orow=crow(r,hi);
      #pragma unroll
      for(int d0=0;d0<2;++d0)stg[orow*64+d0*32+r32]=__float2bfloat16(o[d0][r]*rli[r]);}
    asm volatile("s_waitcnt lgkmcnt(0)":::"memory");
    #pragma unroll
    for(int i=0;i<4;++i){const int row=i*8+(lane>>3),ch=lane&7; const u32x4 v=*(const u32x4*)(stg+row*64+ch*8); ATTN_STORE16(Ow+(long)row*DM+ch*8,v);} }
  asm volatile("s_waitcnt lgkmcnt(0)\n\ts_barrier":::"memory");
  #undef DMA_K
  #undef DMA_V
  #undef DMA_M
  #undef MASKLD
  #undef MBIT
  #undef MAND
  #undef MANDA
  #undef BAND
  #undef ROT
}
constexpr int ATTN_LDS_BYTES=LDS_BYTES;
__device__ __forceinline__ int t5b(int d){ if(d<16)return d; int b=16; b+=d>=19;b+=d>=21;b+=d>=24;b+=d>=27;b+=d>=31;b+=d>=35;b+=d>=40;b+=d>=46;b+=d>=52;b+=d>=59;b+=d>=67;b+=d>=77;b+=d>=87;b+=d>=99;b+=d>=113; return b; }
__device__ __forceinline__ void attn_phase(char*lds,const bf16*Q,const bf16*K,const bf16*V,bf16*O,const unsigned char*maskT,const float*relb,int vcu,const int wid){
  const int h=vcu>>5, s_=vcu&31;
  const int tid_=wid*64+lane_now();
  if(tid_<128){ const int d=tid_; ((float*)(lds+LDS_BT))[d]=(relb[t5b(d)*NHEAD+h]-relb[31*NHEAD+h])*1.4426950408889634f; }
  asm volatile("s_waitcnt vmcnt(0) lgkmcnt(0)\n\ts_barrier":::"memory");
  if(wid>=4)__builtin_amdgcn_s_setprio(1);
  _Pragma("unroll 1") for(int i=0;i<2;++i) attn_unit(h,i?s_:63-s_,Q,K,V,O,maskT,lds,wid);
  __builtin_amdgcn_s_setprio(0);
}
#undef SBAR
#undef WAIT_BAR
}

static_assert(pg8::EpiMix::GUARD_LDS == (unsigned)(MISC_OFF + 44) && pg8::EpiMix::GUARD_DELTA == (long)(CW_BAR + XB_DONE2) * 4 - (long)CTL_SS2, "EpiMix guard constants");
__global__ void __launch_bounds__(NWAVES * 64, 2) __attribute__((target("no-packed-fp32-ops"))) mega_fwd(Args args) {
    extern __shared__ __attribute__((aligned(16))) unsigned char lds[];
    Frame F;
    F.lds = (LAS unsigned char*)lds;
    F.MISC = (volatile LAS unsigned*)(F.lds + MISC_OFF);
    F.wave = __builtin_amdgcn_readfirstlane((int)threadIdx.x >> 6);
#define RETID() do { F.lane = lane_now(); F.tid = F.wave * 64 + F.lane; } while (0)
    RETID();
    F.G = gridDim.x; { const int bx = blockIdx.x; F.vcu = (F.G % 8 == 0) ? (bx % 8) * (F.G / 8) + bx / 8 : bx; }
    F.ctl = (gu32*)(kargs()->ws + WS_CTL);
    for (int u = F.tid; u < (LDS_BYTES - LDSCTL_OFF) / 4; u += NWAVES * 64) ((LAS unsigned*)(F.lds + LDSCTL_OFF))[u] = 0u;
    __syncthreads();
    const int lo = kargs()->ph_lo, hi = kargs()->ph_hi;
    const bool multi = (hi - lo) > 1;
    XcdBarrier bar; bar.bar = (unsigned*)(F.ctl + CW_BAR); bar.x = 0; bar.st = nullptr;
    if (multi) bar = xcd_barrier_post((unsigned*)(F.ctl + CW_BAR), F.MISC + 8, F.tid);
#ifndef PHMASK
#define PHMASK 0x7ff
#endif
#define IN(k) (((PHMASK >> (k)) & 1) && lo <= (k) && (k) < hi)
#define SEAM(k) do { if (IN(k) && IN((k) + 1)) { RETID(); xcd_barrier(bar, F.tid); } RETID(); } while (0)
#define SEAMS(k) do { if (IN(k) && IN((k) + 1)) { RETID(); if (F.MISC[10] != 0u) xcd_barrier<false>(bar, F.tid); else xcd_barrier(bar, F.tid); } RETID(); } while (0)
#define SEAML(k) do { if (IN(k) && IN((k) + 1)) { RETID(); if (F.MISC[10] != 0u) xcd_local_barrier<((k) == 6 ? XB_DONE6 : (k) == 2 ? XB_DONE2 : -1)>(bar, F.tid); else xcd_barrier(bar, F.tid); } RETID(); } while (0)
#define WSP unsigned char* ws = kargs()->ws
#define BFP(off) ((pg8::bf16_t*)(ws + (off)))
#define CBFP(off) ((const pg8::bf16_t*)(ws + (off)))
#define SSP(off) ((float*)(ws + WS_CTL + (off)))
    const int cidx = (int)blockIdx.x;

#ifndef REP_P0
#define REP_P0 1
#endif
#ifndef REP_G1
#define REP_G1 1
#endif
    if (IN(0)) { for (int rep = 0; rep < REP_P0; ++rep) p0_prologue(F, kargs()); }
    if (multi && F.tid == 0) F.ctl[CW_BAR + XB_TAB + cidx] = 1u + xb_xcc_id();
    SEAM(0);
    if (multi && F.tid < 32) { const unsigned t_ = F.ctl[CW_BAR + XB_TAB + 8 * F.tid + (cidx & 7)]; if (t_ != 1u + xb_xcc_id() || gridDim.x != 256u) atomicOr((unsigned*)&F.ctl[CW_BAR + XB_NONLOCAL], 1u); }
    if (IN(1)) for (int rep = 0; rep < REP_G1; ++rep) { WSP; pg8::Gemm g{CBFP(WS_HB), CBFP(WS_W1IN), M, 2 * DFF, D}; pg8::StaticOrder S; S.init(M, 2 * DFF, F.G, cidx);
        pg8::EpiSwiglu E{BFP(WS_ACT), SSP(CTL_SS1)}; pg8::gemm_phase<pg8::EpiSwiglu, pg8::StaticOrder, true, true>(F.lds + RING_OFF, g, S, E, F.wave); }
    if (IN(1)) { if (cidx >= 128 && F.G == 256) { RETID(); p0_weights(F, kargs(), P0_I0, P0_LATE_END, (cidx - 128) * NWAVES + F.wave, 128 * NWAVES); }
                 else if (F.G != 256) { RETID(); p0_weights(F, kargs(), P0_I0, P0_LATE_END, F.vcu * NWAVES + F.wave, F.G * NWAVES); } } SEAM(1);
    if (multi) { if (F.tid == 0) { const unsigned lok_ = (xb_ld((unsigned*)&F.ctl[CW_BAR + XB_NONLOCAL]) == 0u) ? 1u : 0u; F.MISC[10] = lok_; F.MISC[11] = 1u - lok_; } __syncthreads(); }
    else { if (F.tid == 0) F.MISC[11] = 1u; __syncthreads(); }
    if (IN(2)) { WSP; pg8::Gemm g{CBFP(WS_ACT), CBFP(WS_W1OUT), M, D, DFF}; pg8::StaticOrder S; S.init(M, D, F.G, cidx);
        pg8::EpiRes E{kargs()->in[0], kargs()->out, BFP(WS_HB), SSP(CTL_SS2), 0.5f}; pg8::gemm_phase<pg8::EpiRes, pg8::StaticOrder, true, true>(F.lds + RING_OFF, g, S, E, F.wave); } SEAML(2);
    if (IN(3)) { WSP; pg8::Gemm g{CBFP(WS_HB), CBFP(WS_WMIX), M, NMIXP, D}; pg8::StaticOrder S; S.init(M, NMIXP, F.G, cidx);
        pg8::EpiMix E{SSP(CTL_SS2), (pg8::bf16_t*)(ws + WS_GLU), (pg8::bf16_t*)(ws + WS_Q), (pg8::bf16_t*)(ws + WS_K), (pg8::bf16_t*)(ws + WS_V), (pg8::bf16_t*)(ws + WS_QI), (pg8::bf16_t*)(ws + WS_KI),
                      (float*)(ws + WS_WI), (pg8::bf16_t*)(ws + WS_GC), (pg8::bf16_t*)(ws + WS_GA), kargs()->in[12], kargs()->in[13]};
        pg8::gemm_phase<pg8::EpiMix, pg8::StaticOrder, true, true>(F.lds + RING_OFF, g, S, E, F.wave); } SEAM(3);
#ifndef REP_CONV
#define REP_CONV 1
#endif
#ifndef REP_IDX
#define REP_IDX 1
#endif
#ifndef REP_ATT
#define REP_ATT 1
#endif
    if (IN(4)) { for (int rep = 0; rep < REP_CONV; ++rep) conv_phase(F, kargs()); for (int rep = 0; rep < REP_IDX; ++rep) indexer_fast(F, kargs()); } SEAM(4);
    if (IN(5)) { for (int rep = 0; rep < REP_ATT; ++rep) { unsigned char* ws = kargs()->ws; attn_body::attn_phase((char*)lds + RING_OFF, (const attn_body::bf16*)(ws + WS_Q), (const attn_body::bf16*)(ws + WS_K), (const attn_body::bf16*)(ws + WS_V), (attn_body::bf16*)(ws + WS_ATT), ws + WS_MASK, kargs()->in[22], F.vcu, F.wave); } __syncthreads();
        WSP; pg8::Gemm g{CBFP(WS_ZC), CBFP(WS_WCO), M, D, CCH}; pg8::StaticOrder S; S.init(M, D, F.G, cidx);
        pg8::EpiGate<0> E{(pg8::bf16_t*)(ws + WS_GC), nullptr}; pg8::gemm_phase<pg8::EpiGate<0>, pg8::StaticOrder, true, true>(F.lds + RING_OFF, g, S, E, F.wave); } SEAM(5);
    if (IN(6)) { WSP; pg8::Gemm g{CBFP(WS_ATT), CBFP(WS_WAO), M, D, AW}; pg8::StaticOrder S; S.init(M, D, F.G, cidx);
        pg8::EpiGate<1> E{(pg8::bf16_t*)(ws + WS_GC), (const pg8::bf16_t*)(ws + WS_GA)}; pg8::gemm_phase<pg8::EpiGate<1>, pg8::StaticOrder, true, true>(F.lds + RING_OFF, g, S, E, F.wave); } SEAML(6);
    if (IN(7)) { convert_p(F, kargs()); WSP; pg8::Gemm g{CBFP(WS_GC), CBFP(WS_WMO), M, D, D}; pg8::StaticOrder S; S.init(M, D, F.G, cidx);
        pg8::EpiRes E{kargs()->out, kargs()->out, BFP(WS_HB), SSP(CTL_SS3), 1.0f}; pg8::gemm_phase<pg8::EpiRes, pg8::StaticOrder, true, true>(F.lds + RING_OFF, g, S, E, F.wave); } SEAML(7);
    if (IN(8) && multi && F.MISC[10] != 0u) { if (F.tid == 0) { unsigned* bar_ = (unsigned*)(F.ctl + CW_BAR); XB_SPIN(xb_ld(&bar_[XB_DONE6]) < F.MISC[9], bar_); } __syncthreads(); }
    if (IN(8)) {
        WSP; pg8::Gemm g{CBFP(WS_HB), CBFP(WS_W2IN), M, 2 * DFF, D}; pg8::StaticOrder S; S.init(M, 2 * DFF, F.G, cidx);
        pg8::EpiSwiglu E{BFP(WS_ACT), SSP(CTL_SS3)}; pg8::gemm_phase<pg8::EpiSwiglu, pg8::StaticOrder, true, true>(F.lds + RING_OFF, g, S, E, F.wave); }
    if (IN(8) && cidx >= 128) {
        WSP; pg8::Gemm g{CBFP(WS_PB), CBFP(WS_WPP), M, D, PLE}; pg8::StaticOrder S; S.init(M, D, 128, cidx - 128);
        pg8::EpiGate<2> E{(pg8::bf16_t*)(ws + WS_PROJ), nullptr}; pg8::gemm_phase<pg8::EpiGate<2>, pg8::StaticOrder, true, true>(F.lds + RING_OFF, g, S, E, F.wave);
    } SEAML(8);
    if (IN(9)) { WSP; pg8::Gemm g{CBFP(WS_ACT), CBFP(WS_W2OUT), M, D, DFF}; pg8::StaticOrder S; S.init(M, D, F.G, cidx);
        pg8::EpiRes E{kargs()->out, kargs()->out, BFP(WS_HB), SSP(CTL_SS4), 0.5f}; pg8::gemm_phase<pg8::EpiRes, pg8::StaticOrder, true, true>(F.lds + RING_OFF, g, S, E, F.wave); }
    SEAML(9);
    if (IN(10)) {
        { WSP; pg8::Gemm g{CBFP(WS_HB), CBFP(WS_WPG), M, D, D}; pg8::StaticOrder S; S.init(M, D, F.G, cidx);
          pg8::EpiPle E{kargs()->out, CBFP(WS_PROJ), SSP(CTL_SS4)}; pg8::gemm_phase<pg8::EpiPle, pg8::StaticOrder, true, true>(F.lds + RING_OFF, g, S, E, F.wave); }
    }
#ifdef DIAG_TIME
    if (IN(10) && blockIdx.x == 0 && F.tid == 0) { const unsigned long long* ts = (const unsigned long long*)(kargs()->ws + WS_CTL + 16384);
        kargs()->out[0] += 25.0f * floorf((float)(ts[DIAG_TIME + 1] - ts[DIAG_TIME]) * 0.01f / 25.0f + 0.5f); }
#endif
#ifdef DIAG_OVF
    if (IN(10) && blockIdx.x == 0 && F.tid == 0) { const unsigned* dg = (const unsigned*)(kargs()->ws + WS_CTL) + 2048; const unsigned v = __hip_atomic_load(dg + (DIAG_OVF & 3), __ATOMIC_RELAXED, __HIP_MEMORY_SCOPE_AGENT);
        kargs()->out[0] += (float)((DIAG_OVF & 4) ? (v & 0xffffu) : ((DIAG_OVF & 8) ? (v >> 16) : v)); }
#endif
#undef IN
#undef SEAM
#undef SEAML
#undef SEAMS
}

extern "C" void kernel_launch(void* const* d_in, const int* in_sizes, int n_in, void* d_out, int out_size, void* d_ws, size_t ws_size, hipStream_t stream) {
    static int grid = 0;
    if (grid == 0) {
        if (n_in != 23 || out_size != M * D || ws_size < WS_END) { fprintf(stderr, "kernel_launch: unexpected shapes n_in %d out %d ws %zu\n", n_in, out_size, ws_size); grid = -1; return; }
        int dev = 0, cus = 0;
        if (hipGetDevice(&dev) != hipSuccess || hipDeviceGetAttribute(&cus, hipDeviceAttributeMultiprocessorCount, dev) != hipSuccess) { grid = -1; return; }
        if (hipFuncSetAttribute((const void*)mega_fwd, hipFuncAttributeMaxDynamicSharedMemorySize, LDS_BYTES) != hipSuccess) { fprintf(stderr, "kernel_launch: hipFuncSetAttribute failed\n"); grid = -1; return; }
        int per_cu = 0;
        if (hipOccupancyMaxActiveBlocksPerMultiprocessor(&per_cu, (const void*)mega_fwd, NWAVES * 64, LDS_BYTES) != hipSuccess || per_cu < 1) fprintf(stderr, "kernel_launch: occupancy query says %d\n", per_cu);
        (void)hipGetLastError();
        grid = cus;
        if (grid != 256) fprintf(stderr, "kernel_launch: %d CUs (built for 256)\n", grid);
    }
    if (grid < 0) return;
    (void)hipMemsetAsync((char*)d_ws + WS_CTL, 0, CTL_ZERO_BYTES, stream);
    Args a{};
    for (int i = 0; i < 23; ++i) a.in[i] = (const float*)d_in[i];
    a.out = (float*)d_out; a.ws = (unsigned char*)d_ws;
    if (N_LAUNCHES == 1) {
        a.ph_lo = 0; a.ph_hi = NPHASE; a.li = 0;
        hipLaunchKernelGGL(mega_fwd, dim3(grid), dim3(NWAVES * 64), LDS_BYTES, stream, a);
    } else {
        for (int li = 0; li < NPHASE; ++li) { a.ph_lo = li; a.ph_hi = li + 1; a.li = li;
            hipLaunchKernelGGL(mega_fwd, dim3(grid), dim3(NWAVES * 64), LDS_BYTES, stream, a); }
    }
}
```

```cpp
#include <hip/hip_runtime.h>
#include <cstdio>
#include <cstdint>
__device__ __forceinline__ void mk_syncthreads() { __builtin_amdgcn_fence(__ATOMIC_RELEASE, "workgroup"); __builtin_amdgcn_s_barrier(); __builtin_amdgcn_fence(__ATOMIC_ACQUIRE, "workgroup"); }
#define __syncthreads() mk_syncthreads()
__device__ __forceinline__ int lane_now() { int l = (int)__builtin_amdgcn_mbcnt_hi(~0u, __builtin_amdgcn_mbcnt_lo(~0u, 0u)); asm volatile("" : "+v"(l)); return l; }
namespace pg8 {
#define PG8_LAS __attribute__((address_space(3)))
typedef unsigned short bf16_t;
typedef short bf16x8 __attribute__((ext_vector_type(8)));
typedef float f32x4 __attribute__((ext_vector_type(4)));
typedef unsigned u32x4 __attribute__((ext_vector_type(4)));
constexpr int BM = 256, BK = 64, HALF = 128, HTB = HALF * BK * 2  , STAGE_BYTES = 8 * HTB, NXCD = 8, WGM = 8;

__host__ __device__ __forceinline__ int lds_byte(int r, int c) { const int st = (r >> 4) * 2 + (c >> 5), rr = r & 15, cc = c & 31, ob = rr * 64 + cc * 2; return st * 1024 + (ob ^ (((ob >> 9) & 1) << 5)); }
__host__ __device__ __forceinline__ void stage_rc(int b, int& R, int& C) { const int st = b / 1024, sb = b % 1024, swz = sb ^ (((sb >> 9) & 1) << 5); R = (st >> 1) * 16 + swz / 64; C = (st & 1) * 32 + (swz % 64) / 2; }
__host__ __device__ __forceinline__ int perm32(int rho) { const int n = rho >> 4, i = rho & 15; return 8 * (i >> 2) + 4 * n + (i & 3); }

struct Unit { int pm, pn; };
struct Gemm { const bf16_t* A; const bf16_t* Bt; int M, N, K; };

struct StaticOrder {
    int nM, nN, nwg, G, c;
    __host__ __device__ __forceinline__ void init(int M, int N, int G_, int c_) { nM = M / BM; nN = N / BM; nwg = nM * nN; G = G_; c = c_; }
    __host__ __device__ bool next(int i, Unit& u) const {
        const long L = (long)i * G + c; if (L >= nwg) return false;
        int wgid = (int)L; { const int q = nwg / NXCD, r = nwg % NXCD, xcd = wgid % NXCD, off = wgid / NXCD; wgid = (xcd < r ? xcd * (q + 1) : r * (q + 1) + (xcd - r) * q) + off; }
        const int nig = WGM * nN, gid = wgid / nig, fm = gid * WGM, gsz = (nM - fm) < WGM ? (nM - fm) : WGM;
        u.pm = fm + ((wgid % nig) % gsz); u.pn = (wgid % nig) / gsz; return true;
    }
    __device__ __forceinline__ void a_ready(const Unit&) const {}
    __device__ __forceinline__ void done(const Unit&) const {}
};

typedef float cvt_f32x2 __attribute__((ext_vector_type(2)));
typedef __bf16 cvt_bf16x2 __attribute__((ext_vector_type(2)));
__device__ __forceinline__ unsigned cvt_pk_bf16(float lo, float hi) { const cvt_bf16x2 v = __builtin_convertvector((cvt_f32x2){lo, hi}, cvt_bf16x2); return __builtin_bit_cast(unsigned, v); }
typedef float f32x2 __attribute__((ext_vector_type(2)));
typedef _Float16 f16x2 __attribute__((ext_vector_type(2)));
constexpr float NORM_EPS = 1e-6f;
constexpr float Q_C2 = 0.125f * 1.4426950408889634f;
__device__ __forceinline__ float bf_lo(unsigned w) { return __uint_as_float(w << 16); }
__device__ __forceinline__ float bf_hi(unsigned w) { return __uint_as_float(w & 0xffff0000u); }
__device__ __forceinline__ float sigm(float x) { return __builtin_amdgcn_rcpf(1.f + __builtin_amdgcn_exp2f(-1.4426950408889634f * x)); }
__device__ __forceinline__ float sigm_k(float x, float k) { return __builtin_amdgcn_rcpf(1.f + __builtin_amdgcn_exp2f(x * k)); }
__device__ __forceinline__ u32x4 pack8(f32x4 a, f32x4 b) { u32x4 w; w.x = cvt_pk_bf16(a[0], a[1]); w.y = cvt_pk_bf16(a[2], a[3]); w.z = cvt_pk_bf16(b[0], b[1]); w.w = cvt_pk_bf16(b[2], b[3]); return w; }
__device__ __forceinline__ unsigned pkh(float lo, float hi) { f16x2 v = __builtin_convertvector((f32x2){lo, hi}, f16x2); return __builtin_bit_cast(unsigned, v); }
__device__ __forceinline__ u32x4 pack8h(f32x4 a, f32x4 b) { u32x4 w; w.x = pkh(a[0], a[1]); w.y = pkh(a[2], a[3]); w.z = pkh(b[0], b[1]); w.w = pkh(b[2], b[3]); return w; }
__device__ __forceinline__ float row_rs(const float* ss, int row) { return __builtin_amdgcn_rsqf((float)((const unsigned long long*)ss)[row] * (1.0f / (1024.0f * 1048576.0f)) + NORM_EPS); }
__device__ __forceinline__ f32x4 unpk_lo(u32x4 g) { return (f32x4){bf_lo(g.x), bf_hi(g.x), bf_lo(g.y), bf_hi(g.y)}; }
__device__ __forceinline__ f32x4 unpk_hi(u32x4 g) { return (f32x4){bf_lo(g.z), bf_hi(g.z), bf_lo(g.w), bf_hi(g.w)}; }

struct EpiSwiglu {
    static constexpr bool PERM = true, AFTER_DRAIN = false;
    bf16_t* O; const float* ss;
    __device__ __forceinline__ void operator()(const f32x4 (&acc)[2][2][4][2], const Unit& u, int wr, int wc, int fr, int fq) const {
        const int row0 = u.pm * BM + wr * 64 + fr, col0 = u.pn * HALF + wc * 32 + 8 * fq;
        float rsv[2][4];
#pragma unroll
        for (int ai = 0; ai < 2; ++ai)
#pragma unroll
            for (int m = 0; m < 4; ++m) rsv[ai][m] = row_rs(ss, row0 + ai * HALF + m * 16);
#pragma unroll
        for (int ai = 0; ai < 2; ++ai)
#pragma unroll
            for (int m = 0; m < 4; ++m) { const int row = row0 + ai * HALF + m * 16; const float rs = rsv[ai][m]; f32x4 o[2];
                const float kk = -1.4426950408889634f * rs, rs2 = rs * rs;
#pragma unroll
                for (int n = 0; n < 2; ++n) { const f32x4 a = acc[ai][0][m][n], b = acc[ai][1][m][n];
#pragma unroll
                    for (int e = 0; e < 4; ++e) o[n][e] = (a[e] * b[e]) * (rs2 * sigm_k(a[e], kk)); }
                *(u32x4*)(O + (size_t)row * 2816 + col0) = pack8(o[0], o[1]); }
    }
};
template <int BASE> struct EpiRes {
    static constexpr bool PERM = true, AFTER_DRAIN = false;
    const float* base; const bf16_t* bb; bf16_t* hb; bf16_t* hb2; float* ssq; float alpha;
    __device__ __forceinline__ void operator()(const f32x4 (&acc)[2][2][4][2], const Unit& u, int wr, int wc, int fr, int fq) const {
        const int row0 = u.pm * BM + wr * 64 + fr, col0 = u.pn * BM + wc * 32 + 8 * fq;
        u32x4 xb[2][4][2];
        if (BASE == 1) {
#pragma unroll
            for (int ai = 0; ai < 2; ++ai)
#pragma unroll
                for (int m = 0; m < 4; ++m)
#pragma unroll
                    for (int bj = 0; bj < 2; ++bj) xb[ai][m][bj] = *(const u32x4*)(bb + (size_t)(row0 + ai * HALF + m * 16) * 1024 + col0 + bj * HALF); }
#pragma unroll
        for (int ai = 0; ai < 2; ++ai)
#pragma unroll
            for (int m = 0; m < 4; ++m) { const int row = row0 + ai * HALF + m * 16; float q = 0.f;
#pragma unroll
                for (int bj = 0; bj < 2; ++bj) { const size_t off = (size_t)row * 1024 + col0 + bj * HALF;
                    f32x4 x0, x1;
                    if (BASE == 0) { x0 = *(const f32x4*)(base + off); x1 = *(const f32x4*)(base + off + 4); }
                    else { const u32x4 b = xb[ai][m][bj]; x0 = unpk_lo(b); x1 = unpk_hi(b); }
                    const f32x4 h0 = x0 + acc[ai][bj][m][0] * alpha, h1 = x1 + acc[ai][bj][m][1] * alpha;
                    const u32x4 hp = pack8(h0, h1);
                    *(u32x4*)(hb + off) = hp; if (BASE == 0) *(u32x4*)(hb2 + off) = hp;
                    q += (h0[0] * h0[0] + h0[1] * h0[1]) + (h0[2] * h0[2] + h0[3] * h0[3]) + (h1[0] * h1[0] + h1[1] * h1[1]) + (h1[2] * h1[2] + h1[3] * h1[3]); }
                q += __shfl_xor(q, 16); q += __shfl_xor(q, 32);
                if (fq == 0) atomicAdd((unsigned long long*)ssq + row, (unsigned long long)(q * 1048576.0f)); }
    }
};
struct EpiMix {
    static constexpr bool PERM = true, AFTER_DRAIN = false;
    const float* ss; bf16_t *GLU, *Q, *K, *V, *QI, *KI; float* WI; bf16_t *GC, *GA; const float *qn, *kn;
    static constexpr unsigned GUARD_LDS = 131072 + 320 + 44;
    static constexpr long GUARD_DELTA = (4096 + 6080) * 4 - 196608;
    __device__ __forceinline__ void operator()(const f32x4 (&acc)[2][2][4][2], const Unit& u, int wr, int wc, int fr, int fq) const {
        { volatile PG8_LAS unsigned* lflag = (volatile PG8_LAS unsigned*)GUARD_LDS;
          if (*lflag == 0u) {
              if (wr == 0 && wc == 0 && fr == 0 && fq == 0) { unsigned* gd = (unsigned*)((char*)ss + GUARD_DELTA); const unsigned need = lflag[-2]; unsigned sp = 0u;
                  while (__hip_atomic_load(gd, __ATOMIC_RELAXED, __HIP_MEMORY_SCOPE_AGENT) < need && ++sp < (1u << 22)) __builtin_amdgcn_s_sleep(1);
                  *lflag = 1u; }
              while (*lflag == 0u) __builtin_amdgcn_s_sleep(1); } }
        const int row0 = u.pm * BM + wr * 64 + fr, cw = wc * 32 + 8 * fq, pn = u.pn;
        float rsv[2][4];
#pragma unroll
        for (int ai = 0; ai < 2; ++ai)
#pragma unroll
            for (int m = 0; m < 4; ++m) rsv[ai][m] = row_rs(ss, row0 + ai * HALF + m * 16);
        if (pn < 4) {
#pragma unroll
            for (int ai = 0; ai < 2; ++ai)
#pragma unroll
                for (int m = 0; m < 4; ++m) { const int row = row0 + ai * HALF + m * 16; const float rs = rsv[ai][m]; f32x4 o[2];
                    const float kk = -1.4426950408889634f * rs;
#pragma unroll
                    for (int n = 0; n < 2; ++n) { const f32x4 a = acc[ai][0][m][n], g = acc[ai][1][m][n];
#pragma unroll
                        for (int e = 0; e < 4; ++e) o[n][e] = a[e] * (rs * sigm_k(g[e], kk)); }
                    *(u32x4*)(GLU + (size_t)row * 512 + pn * HALF + cw) = pack8(o[0], o[1]); }
        } else if (pn < 8) {
            const bool isq = pn < 6; const int head = 4 * ((pn - 4) & 1) + wc; const float* gn = isq ? qn : kn; bf16_t* dst = isq ? Q : K; const float post = isq ? Q_C2 : 1.0f;
            f32x4 g[2][2];
#pragma unroll
            for (int bj = 0; bj < 2; ++bj)
#pragma unroll
                for (int n = 0; n < 2; ++n) g[bj][n] = *(const f32x4*)(gn + 32 * bj + 8 * fq + 4 * n);
#pragma unroll
            for (int ai = 0; ai < 2; ++ai)
#pragma unroll
                for (int m = 0; m < 4; ++m) { const int row = row0 + ai * HALF + m * 16; const float rs = rsv[ai][m]; f32x4 v[2][2]; float s = 0.f;
#pragma unroll
                    for (int bj = 0; bj < 2; ++bj)
#pragma unroll
                        for (int n = 0; n < 2; ++n) { v[bj][n] = acc[ai][bj][m][n] * rs; const f32x4 t = v[bj][n]; s += (t[0] * t[0] + t[1] * t[1]) + (t[2] * t[2] + t[3] * t[3]); }
                    s += __shfl_xor(s, 16); s += __shfl_xor(s, 32);
                    const float rn = __builtin_amdgcn_rsqf(s * (1.0f / 64.0f) + NORM_EPS) * post;
#pragma unroll
                    for (int bj = 0; bj < 2; ++bj) *(u32x4*)(dst + (size_t)row * 512 + 64 * head + 32 * bj + 8 * fq) = pack8(v[bj][0] * rn * g[bj][0], v[bj][1] * rn * g[bj][1]); }
        } else if (pn < 10) {
#pragma unroll
            for (int ai = 0; ai < 2; ++ai)
#pragma unroll
                for (int m = 0; m < 4; ++m) { const int row = row0 + ai * HALF + m * 16; const float rs = rsv[ai][m];
#pragma unroll
                    for (int bj = 0; bj < 2; ++bj) *(u32x4*)(V + (size_t)row * 512 + (pn - 8) * BM + bj * HALF + cw) = pack8(acc[ai][bj][m][0] * rs, acc[ai][bj][m][1] * rs); }
        } else if (pn == 10) {
#pragma unroll
            for (int ai = 0; ai < 2; ++ai)
#pragma unroll
                for (int m = 0; m < 4; ++m) { const int row = row0 + ai * HALF + m * 16; const float rs = rsv[ai][m];
#pragma unroll
                    for (int bj = 0; bj < 2; ++bj) *(u32x4*)(QI + (size_t)row * 256 + bj * HALF + cw) = pack8h(acc[ai][bj][m][0] * rs, acc[ai][bj][m][1] * rs); }
        } else if (pn == 11) {
#pragma unroll
            for (int ai = 0; ai < 2; ++ai)
#pragma unroll
                for (int m = 0; m < 4; ++m) { const int row = row0 + ai * HALF + m * 16; const float rs = rsv[ai][m];
                    if (wc < 2) *(u32x4*)(KI + (size_t)row * 64 + cw) = pack8h(acc[ai][0][m][0] * rs, acc[ai][0][m][1] * rs);
                    else if (wc == 2 && fq == 0) *(f32x4*)(WI + (size_t)row * 4) = acc[ai][0][m][0] * (rs * 0.0625f); }
        } else {
            bf16_t* dst = pn < 16 ? GC : GA; const int ct = (pn < 16 ? pn - 12 : pn - 16) * BM;
#pragma unroll
            for (int ai = 0; ai < 2; ++ai)
#pragma unroll
                for (int m = 0; m < 4; ++m) { const int row = row0 + ai * HALF + m * 16; const float rs = rsv[ai][m];
#pragma unroll
                    for (int bj = 0; bj < 2; ++bj) { f32x4 o[2];
#pragma unroll
                        for (int n = 0; n < 2; ++n)
#pragma unroll
                            for (int e = 0; e < 4; ++e) o[n][e] = sigm_k(acc[ai][bj][m][n][e], -1.4426950408889634f * rs);
                        *(u32x4*)(dst + (size_t)row * 1024 + ct + bj * HALF + cw) = pack8(o[0], o[1]); } }
        }
    }
};
template <int MODE> struct EpiGate {
    static constexpr bool PERM = true, AFTER_DRAIN = false;
    bf16_t* T; const bf16_t* GA;
    __device__ __forceinline__ void operator()(const f32x4 (&acc)[2][2][4][2], const Unit& u, int wr, int wc, int fr, int fq) const {
        const int row0 = u.pm * BM + wr * 64 + fr, col0 = u.pn * BM + wc * 32 + 8 * fq;
#pragma unroll
        for (int ai = 0; ai < 2; ++ai) {
            u32x4 tb[4][2], gb[4][2];
#pragma unroll
            for (int m = 0; m < 4; ++m)
#pragma unroll
                for (int bj = 0; bj < 2; ++bj) { const size_t off = (size_t)(row0 + ai * HALF + m * 16) * 1024 + col0 + bj * HALF;
                    if (MODE == 0 || MODE == 1) tb[m][bj] = *(const u32x4*)(T + off);
                    if (MODE == 1) gb[m][bj] = *(const u32x4*)(GA + off); }
#pragma unroll
            for (int m = 0; m < 4; ++m) { const int row = row0 + ai * HALF + m * 16;
#pragma unroll
                for (int bj = 0; bj < 2; ++bj) { const size_t off = (size_t)row * 1024 + col0 + bj * HALF; f32x4 o0, o1;
                    if (MODE == 0) { const u32x4 g = tb[m][bj]; o0 = unpk_lo(g) * acc[ai][bj][m][0]; o1 = unpk_hi(g) * acc[ai][bj][m][1]; }
                    else if (MODE == 1) { const u32x4 t = tb[m][bj]; const u32x4 g = gb[m][bj]; o0 = unpk_lo(t) + unpk_lo(g) * acc[ai][bj][m][0]; o1 = unpk_hi(t) + unpk_hi(g) * acc[ai][bj][m][1]; }
                    else { o0 = acc[ai][bj][m][0]; o1 = acc[ai][bj][m][1]; }
                    *(u32x4*)(T + off) = pack8(o0, o1); } } }
    }
};
struct EpiPle {
    static constexpr bool PERM = true, AFTER_DRAIN = false;
    float* out; const bf16_t* H; const bf16_t* P; const float* ss;
    __device__ __forceinline__ void operator()(const f32x4 (&acc)[2][2][4][2], const Unit& u, int wr, int wc, int fr, int fq) const {
        const int row0 = u.pm * BM + wr * 64 + fr, col0 = u.pn * BM + wc * 32 + 8 * fq;
        float rsv[2][4];
#pragma unroll
        for (int ai = 0; ai < 2; ++ai)
#pragma unroll
            for (int m = 0; m < 4; ++m) rsv[ai][m] = row_rs(ss, row0 + ai * HALF + m * 16);
#pragma unroll
        for (int ai = 0; ai < 2; ++ai) {
            u32x4 pb[4][2], hq[4][2];
#pragma unroll
            for (int m = 0; m < 4; ++m)
#pragma unroll
                for (int bj = 0; bj < 2; ++bj) { const size_t off = (size_t)(row0 + ai * HALF + m * 16) * 1024 + col0 + bj * HALF; pb[m][bj] = *(const u32x4*)(P + off); hq[m][bj] = *(const u32x4*)(H + off); }
#pragma unroll
            for (int m = 0; m < 4; ++m) { const int row = row0 + ai * HALF + m * 16; const float rs = rsv[ai][m];
#pragma unroll
                for (int bj = 0; bj < 2; ++bj) { const size_t off = (size_t)row * 1024 + col0 + bj * HALF;
                    const u32x4 pr = pb[m][bj]; const f32x4 p0 = unpk_lo(pr), p1 = unpk_hi(pr);
                    const u32x4 hr = hq[m][bj]; f32x4 h0 = unpk_lo(hr), h1 = unpk_hi(hr);
#pragma unroll
                    for (int e = 0; e < 4; ++e) { h0[e] += sigm_k(acc[ai][bj][m][0][e], -1.4426950408889634f * rs) * p0[e]; h1[e] += sigm_k(acc[ai][bj][m][1][e], -1.4426950408889634f * rs) * p1[e]; }
                    *(f32x4*)(out + off) = h0; *(f32x4*)(out + off + 4) = h1; }
                asm volatile("" ::: "memory"); } }
    }
};

template <class Epi, class Sched, bool ALIGN_EPI = false, bool SP2 = false>
__device__ __forceinline__ void gemm_phase(PG8_LAS unsigned char* lds, const Gemm g, const Sched& S, const Epi& E, const int wid) {
    const int lane = lane_now(), tid = wid * 64 + lane, wr = wid >> 2, wc = wid & 3, fr = lane & 15, fq = lane >> 4;
    int K = g.K; asm volatile("" : "+s"(K));
    const int nt = K / BK;
    unsigned voffA[2], voffB[2];
#pragma unroll
    for (int i = 0; i < 2; ++i) { int R, C; stage_rc(tid * 16 + i * 8192, R, C); const int Rb = Epi::PERM ? ((R & ~31) + perm32(R & 31)) : R;
        voffA[i] = (unsigned)(R * K + C) * 2u; voffB[i] = (unsigned)(Rb * K + C) * 2u; }
    const size_t kstep = (size_t)(BK * 2);
    const size_t hstep = (size_t)HALF * K * 2;
    const size_t tstep = 2 * hstep;
    const unsigned ldsw = (unsigned)wid * 1024u;
    const int aoff = lds_byte(wr * 64 + fr, fq * 8), boff = lds_byte(wc * 32 + fr, fq * 8);
#define PG8_SA(b, h) (((b) * 2 + (h)) * HTB)
#define PG8_SB(b, h) ((4 + (b) * 2 + (h)) * HTB)
#define PG8_STAGE(bufoff, gbase, voff) do { _Pragma("unroll") for (int _i = 0; _i < 2; ++_i) \
        __builtin_amdgcn_global_load_lds((const unsigned*)((const char*)(gbase) + (voff)[_i]), (PG8_LAS unsigned*)(lds + (bufoff) + ldsw + _i * 8192), 16, 0, 0); } while (0)
#define PG8_LDA(dst, b, h) do { _Pragma("unroll") for (int m = 0; m < 4; ++m) _Pragma("unroll") for (int k = 0; k < 2; ++k) dst[m][k] = *(const PG8_LAS bf16x8*)(lds + PG8_SA(b, h) + aoff + m * 2048 + k * 1024); } while (0)
#define PG8_LDB(dst, b, h) do { _Pragma("unroll") for (int n = 0; n < 2; ++n) _Pragma("unroll") for (int k = 0; k < 2; ++k) dst[n][k] = *(const PG8_LAS bf16x8*)(lds + PG8_SB(b, h) + boff + n * 2048 + k * 1024); } while (0)
#define PG8_MMA(ai, bj, At, Bt) do { __builtin_amdgcn_s_setprio(1); _Pragma("unroll") for (int m = 0; m < 4; ++m) _Pragma("unroll") for (int n = 0; n < 2; ++n) _Pragma("unroll") for (int k = 0; k < 2; ++k) \
        acc[ai][bj][m][n] = __builtin_amdgcn_mfma_f32_16x16x32_bf16(Bt[n][k], At[m][k], acc[ai][bj][m][n], 0, 0, 0); __builtin_amdgcn_s_setprio(0); } while (0)
#define PG8_WAIT_V(n) asm volatile("s_waitcnt vmcnt(" #n ")" ::: "memory")
#define PG8_WAIT_L(n) asm volatile("s_waitcnt lgkmcnt(" #n ")" ::: "memory")
#define PG8_BAR __builtin_amdgcn_s_barrier()
#define PG8_SCHED __builtin_amdgcn_sched_barrier(0)
    Unit cur, nxt; int ui = 0;
    if (!S.next(0, cur)) return;
    f32x4 acc[2][2][4][2];
#pragma unroll
    for (int a = 0; a < 2; ++a)
#pragma unroll
        for (int b = 0; b < 2; ++b)
#pragma unroll
            for (int m = 0; m < 4; ++m)
#pragma unroll
                for (int n = 0; n < 2; ++n) acc[a][b][m][n] = (f32x4){0.f, 0.f, 0.f, 0.f};
    bf16x8 At[4][2], B0[2][2], B1[2][2];
    const char* cA = (const char*)g.A + (size_t)cur.pm * tstep; const char* cB = (const char*)g.Bt + (size_t)cur.pn * tstep;
    S.a_ready(cur);
    if constexpr (SP2) {
        PG8_STAGE(PG8_SB(0, 0), cB, voffB); PG8_STAGE(PG8_SB(0, 1), cB + hstep, voffB); PG8_STAGE(PG8_SA(0, 0), cA, voffA); PG8_STAGE(PG8_SA(0, 1), cA + hstep, voffA);
        if (wr == 1) PG8_BAR;
        PG8_WAIT_V(2); PG8_BAR;
        PG8_STAGE(PG8_SB(1, 0), cB + kstep, voffB); PG8_STAGE(PG8_SA(1, 0), cA + kstep, voffA); PG8_STAGE(PG8_SB(1, 1), cB + hstep + kstep, voffB);
        PG8_WAIT_V(6); PG8_BAR;
    } else {
        PG8_STAGE(PG8_SB(0, 0), cB, voffB); PG8_STAGE(PG8_SA(0, 0), cA, voffA); PG8_STAGE(PG8_SB(0, 1), cB + hstep, voffB); PG8_STAGE(PG8_SA(0, 1), cA + hstep, voffA);
        if (wr == 1) PG8_BAR;
        PG8_WAIT_V(4); PG8_BAR;
        PG8_STAGE(PG8_SB(1, 0), cB + kstep, voffB); PG8_STAGE(PG8_SA(1, 0), cA + kstep, voffA); PG8_STAGE(PG8_SB(1, 1), cB + hstep + kstep, voffB);
        PG8_WAIT_V(6); PG8_BAR;
    }
    for (;;) {
        const bool has_next = S.next(ui + 1, nxt);
        const char* nA = has_next ? (const char*)g.A + (size_t)nxt.pm * tstep : cA; const char* nB = has_next ? (const char*)g.Bt + (size_t)nxt.pn * tstep : cB;
        for (int t = 0; t < nt; t += 2) {
            const bool last = (t == nt - 2);
            const char* a1 = cA + (size_t)(t + 1) * kstep;
            const char* a2 = last ? nA : cA + (size_t)(t + 2) * kstep; const char* b2 = last ? nB : cB + (size_t)(t + 2) * kstep;
            const char* a3 = a2 + kstep; const char* b3 = b2 + kstep;
            if (last && has_next) S.a_ready(nxt);
            if constexpr (SP2) {
            PG8_LDB(B0, 0, 0); PG8_LDB(B1, 0, 1); PG8_SCHED; PG8_LDA(At, 0, 0); PG8_STAGE(PG8_SA(1, 1), a1 + hstep, voffA);
            PG8_WAIT_V(8); PG8_WAIT_L(0); PG8_BAR; PG8_MMA(0, 0, At, B0); PG8_MMA(0, 1, At, B1); PG8_BAR; PG8_SCHED;
            PG8_LDA(At, 0, 1); PG8_STAGE(PG8_SB(0, 0), b2, voffB); PG8_STAGE(PG8_SB(0, 1), b2 + hstep, voffB); PG8_STAGE(PG8_SA(0, 0), a2, voffA);
            PG8_WAIT_V(8); PG8_WAIT_L(0); PG8_BAR; PG8_MMA(1, 0, At, B0); PG8_MMA(1, 1, At, B1); PG8_BAR; PG8_SCHED;
            PG8_LDB(B0, 1, 0); PG8_LDB(B1, 1, 1); PG8_SCHED; PG8_LDA(At, 1, 0); PG8_STAGE(PG8_SA(0, 1), a2 + hstep, voffA);
            PG8_WAIT_V(8); PG8_WAIT_L(0); PG8_BAR; PG8_MMA(0, 0, At, B0); PG8_MMA(0, 1, At, B1); PG8_BAR; PG8_SCHED;
            PG8_LDA(At, 1, 1); PG8_STAGE(PG8_SB(1, 0), b3, voffB); PG8_STAGE(PG8_SB(1, 1), b3 + hstep, voffB); PG8_STAGE(PG8_SA(1, 0), a3, voffA);
            PG8_WAIT_V(8); PG8_WAIT_L(0); PG8_BAR; PG8_MMA(1, 0, At, B0); PG8_MMA(1, 1, At, B1); PG8_BAR; PG8_SCHED;
            } else {
            PG8_LDB(B0, 0, 0); PG8_SCHED; PG8_LDA(At, 0, 0); PG8_STAGE(PG8_SA(1, 1), a1 + hstep, voffA);
            PG8_WAIT_L(8); PG8_BAR; PG8_WAIT_L(0); PG8_MMA(0, 0, At, B0); PG8_BAR; PG8_SCHED;
            PG8_LDB(B1, 0, 1); PG8_STAGE(PG8_SB(0, 0), b2, voffB);
            PG8_BAR; PG8_WAIT_L(0); PG8_MMA(0, 1, At, B1); PG8_BAR;
            PG8_LDA(At, 0, 1); PG8_STAGE(PG8_SA(0, 0), a2, voffA);
            PG8_BAR; PG8_WAIT_L(0); PG8_MMA(1, 0, At, B0); PG8_BAR; PG8_SCHED;
            PG8_STAGE(PG8_SB(0, 1), b2 + hstep, voffB);
            PG8_WAIT_V(6); PG8_BAR; PG8_MMA(1, 1, At, B1); PG8_BAR;
            PG8_LDB(B0, 1, 0); PG8_SCHED; PG8_LDA(At, 1, 0); PG8_STAGE(PG8_SA(0, 1), a2 + hstep, voffA);
            PG8_WAIT_L(8); PG8_BAR; PG8_WAIT_L(0); PG8_MMA(0, 0, At, B0); PG8_BAR; PG8_SCHED;
            PG8_LDB(B1, 1, 1); PG8_STAGE(PG8_SB(1, 0), b3, voffB);
            PG8_BAR; PG8_WAIT_L(0); PG8_MMA(0, 1, At, B1); PG8_BAR;
            PG8_LDA(At, 1, 1); PG8_STAGE(PG8_SA(1, 0), a3, voffA);
            PG8_BAR; PG8_WAIT_L(0); PG8_MMA(1, 0, At, B0); PG8_BAR; PG8_SCHED;
            PG8_STAGE(PG8_SB(1, 1), b3 + hstep, voffB);
            PG8_WAIT_V(6); PG8_BAR; PG8_MMA(1, 1, At, B1); PG8_BAR;
            }
        }
        if constexpr (ALIGN_EPI) { if (wr == 0) PG8_BAR; }
        if constexpr (!Epi::AFTER_DRAIN) { E(acc, cur, wr, wc, fr, fq); S.done(cur); }
        if (!has_next) break;
#pragma unroll
        for (int a = 0; a < 2; ++a)
#pragma unroll
            for (int b = 0; b < 2; ++b)
#pragma unroll
                for (int m = 0; m < 4; ++m)
#pragma unroll
                    for (int n = 0; n < 2; ++n) acc[a][b][m][n] = (f32x4){0.f, 0.f, 0.f, 0.f};
        cur = nxt; cA = nA; cB = nB; ++ui;
        if constexpr (ALIGN_EPI) { if (wr == 1) PG8_BAR; }
    }
    PG8_WAIT_V(0);
    if constexpr (!ALIGN_EPI) { if (wr == 0) PG8_BAR; }
    PG8_BAR;
    if constexpr (Epi::AFTER_DRAIN) { E.fused(acc, cur, wr, wc, fr, fq, lds, wid, lane); S.done(cur); }
#undef PG8_SA
#undef PG8_SB
#undef PG8_STAGE
#undef PG8_LDA
#undef PG8_LDB
#undef PG8_MMA
#undef PG8_WAIT_V
#undef PG8_WAIT_L
#undef PG8_BAR
#undef PG8_SCHED
}
}
constexpr int NWAVES = 8;
constexpr int NPHASE = 11;
#ifndef MK_N_LAUNCHES
#define MK_N_LAUNCHES 1
#endif
constexpr int N_LAUNCHES = MK_N_LAUNCHES;

constexpr int M = 16384, D = 1024, DFF = 2816, NMIXP = 5120, CCH = 512, AW = 512, NH = 8, HD = 64, PLE = 256, CONVW = 31;
constexpr float EPS = 1e-6f;
constexpr float LOG2E = 1.4426950408889634f;

constexpr size_t MiB = 1u << 20;
constexpr size_t WS_CTL = 0, CTL_ZERO_BYTES = 1 * MiB;
constexpr size_t WS_W1IN = 1 * MiB;
constexpr size_t WS_W1OUT = 12 * MiB;
constexpr size_t WS_WMIX = 18 * MiB;
constexpr size_t WS_WCO = 28 * MiB;
constexpr size_t WS_WAO = 29 * MiB;
constexpr size_t WS_WMO = 30 * MiB;
constexpr size_t WS_W2IN = 32 * MiB;
constexpr size_t WS_W2OUT = 43 * MiB;
constexpr size_t WS_WPG = 49 * MiB;
constexpr size_t WS_WPP = 51 * MiB;
constexpr size_t WS_HB = 52 * MiB;
constexpr size_t OUT_MASK = 32 * MiB;
constexpr size_t WS_ACT = 84 * MiB;
constexpr size_t WS_GLU = WS_ACT;
constexpr size_t WS_ATT = WS_ACT;
constexpr size_t WS_Q = WS_ACT + 16 * MiB, WS_K = WS_ACT + 32 * MiB, WS_V = WS_ACT + 48 * MiB;
constexpr size_t WS_QI = WS_ACT + 64 * MiB;
constexpr size_t WS_KI = WS_ACT + 72 * MiB;
constexpr size_t WS_WI = WS_ACT + 74 * MiB;
constexpr size_t WS_GC = 172 * MiB;
constexpr size_t WS_GA = 204 * MiB;
constexpr size_t WS_PB = 236 * MiB;
constexpr size_t WS_PROJ = WS_GA;
constexpr size_t WS_ZC = 236 * MiB;
constexpr size_t WS_END = 252 * MiB;
constexpr int CW_TMO = 0, CW_CODE = 1;
constexpr int CW_BAR = 4096;
constexpr size_t CTL_SS1 = 64 * 1024, CTL_SS2 = 192 * 1024, CTL_SS3 = 320 * 1024, CTL_SS4 = 448 * 1024;

constexpr int RING_OFF = 0, RING_BYTES = 131072;
constexpr int LDSCTL_OFF = RING_BYTES, MISC_OFF = LDSCTL_OFF + 320;
constexpr int LDS_BYTES = 147456;

#define GAS __attribute__((address_space(1)))
#define LAS __attribute__((address_space(3)))
typedef unsigned short bf16;
typedef unsigned v4u __attribute__((ext_vector_type(4)));
typedef float f32x4 __attribute__((ext_vector_type(4)));
typedef short bf16x8 __attribute__((ext_vector_type(8)));
typedef GAS unsigned gu32;
typedef GAS unsigned long long gu64;
#define RLX_AGENT __ATOMIC_RELAXED, __HIP_MEMORY_SCOPE_AGENT
#define LDS_WAIT() asm volatile("s_waitcnt lgkmcnt(0)" ::: "memory")
#define VM_WAIT() asm volatile("s_waitcnt vmcnt(0)" ::: "memory")
__device__ __forceinline__ unsigned long long rt() { return __builtin_amdgcn_s_memrealtime(); }
__device__ __forceinline__ unsigned f2bf(float f) { unsigned u = __builtin_bit_cast(unsigned, f); return (u + 0x7fffu + ((u >> 16) & 1u)) >> 16; }
__device__ __forceinline__ unsigned pk2(float lo, float hi) { return f2bf(lo) | (f2bf(hi) << 16); }

#define XB_TMO      128
#define XB_XCNT(j)  (256  + 64 * (j))
#define XB_XSUB(j)  (1280 + 64 * (j))
#define XB_XGEN(j)  (2304 + 64 * (j))
#define XB_TOP      3328
#define XB_TOPGEN   3392
#define XCD_BAR_WORDS 3456
#define XB_LSUB(j)  (3520 + 64 * (j))
#define XB_LGEN(j)  (4544 + 64 * (j))
#define XB_TAB      5632
#define XB_DONE2    6080
#define XB_DONE7    6272
#define XB_DONE6    6016
#define XB_NONLOCAL 5952
#define XB_SPIN_CAP (1u << 18)

__device__ __forceinline__ unsigned xb_ld(unsigned* p)              { return __hip_atomic_load(p, __ATOMIC_RELAXED, __HIP_MEMORY_SCOPE_AGENT); }
__device__ __forceinline__ unsigned xb_add(unsigned* p, unsigned v) { return __hip_atomic_fetch_add(p, v, __ATOMIC_RELAXED, __HIP_MEMORY_SCOPE_AGENT); }
__device__ __forceinline__ unsigned xb_xcc_id() { return (unsigned)__builtin_amdgcn_s_getreg((3 << 11) | 20) & 0xFu; }
#define XB_SPIN(cond, bar) do { unsigned _sp = 0; while (cond) { __builtin_amdgcn_s_sleep(1); \
    if ((++_sp & 255u) == 0u) { if (xb_ld(&(bar)[XB_TMO])) break; if (_sp > XB_SPIN_CAP) { atomicAdd(&(bar)[XB_TMO], 1u); break; } } } } while (0)

struct XcdBarrier {
    unsigned* bar; unsigned x;
    volatile LAS unsigned* st;
};

__device__ __forceinline__ XcdBarrier xcd_barrier_post(unsigned* bar, volatile LAS unsigned* st, const int tid) {
    XcdBarrier b; b.bar = bar; b.x = xb_xcc_id(); b.st = st;
    if (tid == 0) (void)xb_add(&bar[XB_XCNT(b.x)], 1u);
    return b;
}
__device__ __forceinline__ void xcd_barrier_complete(unsigned* bar, unsigned x, unsigned& nloc, unsigned& nx) {
    const unsigned G = gridDim.x * gridDim.y * gridDim.z;
    unsigned sum, cnt, mine, sp = 0u;
    for (;;) {
        sum = 0u; cnt = 0u; mine = 0u;
#pragma unroll
        for (unsigned j = 0; j < 16; ++j) { const unsigned c = xb_ld(&bar[XB_XCNT(j)]); sum += c; cnt += (c > 0u) ? 1u : 0u; mine = (j == x) ? c : mine; }
        if (sum == G) break;
        __builtin_amdgcn_s_sleep(1);
        if ((++sp & 255u) == 0u) { if (xb_ld(&bar[XB_TMO])) break; if (sp > XB_SPIN_CAP) { atomicAdd(&bar[XB_TMO], 1u); break; } }
    }
    nloc = mine > 0u ? mine : 1u; nx = cnt > 0u ? cnt : 1u;
}

template <bool FLUSH = true>
__device__ __forceinline__ void xcd_barrier(const XcdBarrier& b, const int tid) {
    asm volatile("s_waitcnt vmcnt(0)" ::: "memory");
    __syncthreads();
    if (tid == 0) {
        unsigned* bar = b.bar;
        __builtin_amdgcn_s_waitcnt(0);
        unsigned nloc = b.st[0], nx = b.st[1];
        if (nloc == 0u) { xcd_barrier_complete(bar, b.x, nloc, nx); b.st[0] = nloc; b.st[1] = nx; }
        const unsigned old = xb_add(&bar[XB_XSUB(b.x)], 1u);
        const unsigned gen = old / nloc;
        if (old + 1u == (gen + 1u) * nloc) {
            if (FLUSH) __builtin_amdgcn_fence(__ATOMIC_RELEASE, "agent");
            asm volatile("s_waitcnt vmcnt(0)" ::: "memory");
            const unsigned og = xb_add(&bar[XB_TOP], 1u);
            const unsigned tg = og / nx;
            __builtin_amdgcn_fence(__ATOMIC_ACQUIRE, "agent");
            if (og + 1u == (tg + 1u) * nx) xb_add(&bar[XB_TOPGEN], 1u);
            else XB_SPIN(xb_ld(&bar[XB_TOPGEN]) == tg, bar);
            xb_add(&bar[XB_XGEN(b.x)], 1u);
            asm volatile("s_waitcnt vmcnt(0)" ::: "memory");
        } else {
            __builtin_amdgcn_fence(__ATOMIC_ACQUIRE, "agent");
            XB_SPIN(xb_ld(&bar[XB_XGEN(b.x)]) == gen, bar);
            asm volatile("s_waitcnt vmcnt(0)" ::: "memory");
        }
    }
    __syncthreads();
}

template <int POST = -1>
__device__ __forceinline__ void xcd_local_barrier(const XcdBarrier& b, const int tid) {
    asm volatile("s_waitcnt vmcnt(0)" ::: "memory");
    __syncthreads();
    if (tid == 0) {
        unsigned* bar = b.bar;
        __builtin_amdgcn_s_waitcnt(0);
        const unsigned nloc = b.st[0];
        const unsigned old = xb_add(&bar[XB_LSUB(b.x)], 1u);
        const unsigned gen = old / nloc;
        __builtin_amdgcn_fence(__ATOMIC_ACQUIRE, "agent");
        if (old + 1u == (gen + 1u) * nloc) { xb_add(&bar[XB_LGEN(b.x)], 1u); if (POST >= 0) xb_add(&bar[POST], 1u); }
        else XB_SPIN(xb_ld(&bar[XB_LGEN(b.x)]) == gen, bar);
        asm volatile("s_waitcnt vmcnt(0)" ::: "memory");
    }
    __syncthreads();
}

struct Frame {
    LAS unsigned char* lds;
    volatile LAS unsigned* MISC;
    gu32* ctl;
    int tid, lane, wave;
    int vcu, G;
};
__device__ __forceinline__ float wave_sum(float v) {
#define WS_DPP(x, ctrl) __builtin_bit_cast(float, __builtin_amdgcn_update_dpp(0, __builtin_bit_cast(int, (x)), (ctrl), 0xf, 0xf, true))
    v += WS_DPP(v, 0xB1);
    v += WS_DPP(v, 0x4E);
    v += WS_DPP(v, 0x141);
    v += WS_DPP(v, 0x140);
#undef WS_DPP
    const float s0 = __builtin_bit_cast(float, __builtin_amdgcn_readlane(__builtin_bit_cast(int, v), 0)), s1 = __builtin_bit_cast(float, __builtin_amdgcn_readlane(__builtin_bit_cast(int, v), 16));
    const float s2 = __builtin_bit_cast(float, __builtin_amdgcn_readlane(__builtin_bit_cast(int, v), 32)), s3 = __builtin_bit_cast(float, __builtin_amdgcn_readlane(__builtin_bit_cast(int, v), 48));
    return (s0 + s1) + (s2 + s3);
}
__device__ __forceinline__ float wave_max(float v) {
#pragma unroll
    for (int o = 1; o < 64; o <<= 1) v = fmaxf(v, __shfl_xor(v, o));
    return v;
}
__device__ __forceinline__ float bflo(unsigned w) { return __uint_as_float(w << 16); }
__device__ __forceinline__ float bfhi(unsigned w) { return __uint_as_float(w & 0xffff0000u); }
__device__ __forceinline__ float sigm_f(float x) { return __builtin_amdgcn_rcpf(1.f + __builtin_amdgcn_exp2f(-LOG2E * x)); }

__device__ __forceinline__ int wmap(int kind, int n0, int& nv) {
    nv = 32;
    if (kind == 0) return n0;
    const int T = n0 >> 8, rem = n0 & 255;
    if (kind == 1) return (rem >> 7) * DFF + 128 * T + (rem & 127);
    if (T < 4) return (rem >> 7) * 512 + 128 * T + (rem & 127);
    if (T < 8) { const int base = T < 6 ? 1024 : 1536, Tq = (T - 4) & 1, bj = rem >> 7, wc = (rem & 127) >> 5; return base + 64 * (4 * Tq + wc) + 32 * bj; }
    if (T < 10) return 2048 + 256 * (T - 8) + rem;
    if (T == 10) return 2560 + rem;
    if (T == 11) { if (rem < 64) return 2816 + rem; if (rem == 64) { nv = 4; return 2880; } nv = 0; return 0; }
    return 2884 + 256 * (T - 12) + rem;
}
__device__ __forceinline__ void p0_transpose_item(const float* W, int K, int Nsrc, bf16* WT, int ng, int kind, const float* gain, LAS float* scr, int item, int lane) {
    const int kb = item / ng, nb = item % ng, k0 = 64 * kb, n0 = 32 * nb;
    int nv; const int sc = wmap(kind, n0, nv);
    const int n4 = 4 * (lane & 7), kr = lane >> 3;
    const bool ok = n4 < nv;
#pragma unroll
    for (int i = 0; i < 8; ++i) { const int kk = 8 * i + kr;
        f32x4 v = ok ? *(const GAS f32x4*)(W + (size_t)(k0 + kk) * Nsrc + sc + n4) : (f32x4){0.f, 0.f, 0.f, 0.f};
        if (gain) v = v * gain[k0 + kk];
        *(LAS f32x4*)(scr + kk * 36 + n4) = v; }
    LDS_WAIT(); asm volatile("" ::: "memory");
    const int c = lane & 7;
#pragma unroll
    for (int j = 0; j < 4; ++j) { const int n = (lane >> 3) + 8 * j; const LAS float* s = scr + (8 * c) * 36 + n;
        v4u o; o.x = pk2(s[0 * 36], s[1 * 36]); o.y = pk2(s[2 * 36], s[3 * 36]); o.z = pk2(s[4 * 36], s[5 * 36]); o.w = pk2(s[6 * 36], s[7 * 36]);
        *(GAS v4u*)(WT + (size_t)(n0 + n) * K + k0 + 8 * c) = o; }
    LDS_WAIT(); asm volatile("" ::: "memory");
}
struct Args { const float* in[23]; float* out; unsigned char* ws; int ph_lo, ph_hi, li, pad; };
typedef const __attribute__((address_space(4))) Args* KArgs;
__device__ __forceinline__ KArgs kargs() { KArgs p = (KArgs)__builtin_amdgcn_kernarg_segment_ptr(); asm volatile("" : "+s"(p)); return p; }

constexpr int P0_I0 = 16 * 176, P0_LATE_END = P0_I0 + 44 * 32 + 16 * 160 + 8 * 32 + 8 * 32 + 16 * 32;
__device__ __forceinline__ void p0_weights(Frame& F, KArgs A, const int it_lo, const int it_hi, const int gw, const int NGW) {
    LAS float* scr = (LAS float*)(F.lds + RING_OFF + F.wave * 16384);
    unsigned char* ws = A->ws;
    constexpr int I0 = 16 * 176, I1 = 44 * 32, I2 = 16 * 160, I3 = 8 * 32, I4 = 8 * 32, I5 = 16 * 32, I6 = 16 * 176, I7 = 44 * 32, I8 = 16 * 32, I9 = 4 * 32;
    constexpr int NITEMS = I0 + I1 + I2 + I3 + I4 + I5 + I6 + I7 + I8 + I9;
    static_assert(I0 == P0_I0, "");
    const int hi_ = it_hi < 0 ? NITEMS : it_hi;
    for (int it = it_lo + gw; it < hi_; it += NGW) {
        int r = it;
        if (r < I0) { p0_transpose_item(A->in[3], 1024, 5632, (bf16*)(ws + WS_W1IN), 176, 1, A->in[2], scr, r, F.lane); continue; } r -= I0;
        if (r < I1) { p0_transpose_item(A->in[4], 2816, 1024, (bf16*)(ws + WS_W1OUT), 32, 0, nullptr, scr, r, F.lane); continue; } r -= I1;
        if (r < I2) { p0_transpose_item(A->in[6], 1024, 4932, (bf16*)(ws + WS_WMIX), 160, 2, A->in[5], scr, r, F.lane); continue; } r -= I2;
        if (r < I3) { p0_transpose_item(A->in[11], 512, 1024, (bf16*)(ws + WS_WCO), 32, 0, nullptr, scr, r, F.lane); continue; } r -= I3;
        if (r < I4) { p0_transpose_item(A->in[14], 512, 1024, (bf16*)(ws + WS_WAO), 32, 0, nullptr, scr, r, F.lane); continue; } r -= I4;
        if (r < I5) { p0_transpose_item(A->in[15], 1024, 1024, (bf16*)(ws + WS_WMO), 32, 0, nullptr, scr, r, F.lane); continue; } r -= I5;
        if (r < I6) { p0_transpose_item(A->in[17], 1024, 5632, (bf16*)(ws + WS_W2IN), 176, 1, A->in[16], scr, r, F.lane); continue; } r -= I6;
        if (r < I7) { p0_transpose_item(A->in[18], 2816, 1024, (bf16*)(ws + WS_W2OUT), 32, 0, nullptr, scr, r, F.lane); continue; } r -= I7;
        if (r < I8) { p0_transpose_item(A->in[20], 1024, 1024, (bf16*)(ws + WS_WPG), 32, 0, A->in[19], scr, r, F.lane); continue; } r -= I8;
        p0_transpose_item(A->in[21], 256, 1024, (bf16*)(ws + WS_WPP), 32, 0, nullptr, scr, r, F.lane);
    }
}
__device__ __forceinline__ void p0_prologue(Frame& F, KArgs A) {
    const int gw = F.vcu * NWAVES + F.wave, NGW = F.G * NWAVES;
    unsigned char* ws = A->ws;
    p0_weights(F, A, 0, P0_I0, gw, NGW);
    p0_weights(F, A, P0_LATE_END, -1, gw, NGW);
    const float* x = A->in[0]; bf16* xb = (bf16*)(ws + WS_HB); float* ss1 = (float*)(ws + WS_CTL + CTL_SS1);
    for (int m = gw; m < M; m += NGW) {
        const GAS f32x4* xr = (const GAS f32x4*)(x + (size_t)m * D) + F.lane;
        f32x4 v[4]; float s = 0.f;
#pragma unroll
        for (int j = 0; j < 4; ++j) { v[j] = xr[64 * j]; s += (v[j].x * v[j].x + v[j].y * v[j].y) + (v[j].z * v[j].z + v[j].w * v[j].w); }
        s = wave_sum(s);
        if (F.lane == 0) ((unsigned long long*)ss1)[m] = (unsigned long long)(s * 1048576.0f);
        GAS unsigned long long* o8 = (GAS unsigned long long*)(xb + (size_t)m * D) + F.lane;
#pragma unroll
        for (int j = 0; j < 4; ++j) o8[64 * j] = (unsigned long long)pk2(v[j].x, v[j].y) | ((unsigned long long)pk2(v[j].z, v[j].w) << 32);
    }
}
__device__ __forceinline__ void convert_p(Frame& F, KArgs A) {
    const float* p = A->in[1]; bf16* pb = (bf16*)(A->ws + WS_PB);
    const int g = F.vcu >> 5, gtl = (F.vcu & 31) * (NWAVES * 64) + F.tid;
    f32x4 pa[4], pq[4];
#pragma unroll
    for (int k = 0; k < 4; ++k) { const int i = 65536 * g + gtl + 16384 * k; pa[k] = *(const GAS f32x4*)(p + (size_t)i * 8); pq[k] = *(const GAS f32x4*)(p + (size_t)i * 8 + 4); }
#pragma unroll
    for (int k = 0; k < 4; ++k) { const int i = 65536 * g + gtl + 16384 * k; const f32x4 a = pa[k], b = pq[k];
        v4u o; o.x = pk2(a.x, a.y); o.y = pk2(a.z, a.w); o.z = pk2(b.x, b.y); o.w = pk2(b.z, b.w);
        *(GAS v4u*)(pb + (size_t)i * 8) = o;
    }
}

__device__ __forceinline__ void conv_phase(Frame& F, KArgs A) {
    const bf16* glu = (const bf16*)(A->ws + WS_GLU); bf16* zc = (bf16*)(A->ws + WS_ZC);
    const float* dw = A->in[7]; const float* db = A->in[8]; const float* lg = A->in[9]; const float* lb = A->in[10];
    typedef _Float16 h8 __attribute__((ext_vector_type(8)));
    LAS unsigned char* L = F.lds; constexpr int WT_OFF = 0, GL_OFF = 32768;
    const int tid = F.tid, lane = F.lane, wv = F.wave, c0 = 8 * lane;
    __syncthreads();
    for (int i = tid; i < CONVW * 64; i += NWAVES * 64) { const int w = i >> 6, l = i & 63;
        const f32x4 u0 = *(const GAS f32x4*)(dw + w * CCH + 8 * l), u1 = *(const GAS f32x4*)(dw + w * CCH + 8 * l + 4);
        h8 hv; hv[0] = (_Float16)u0.x; hv[1] = (_Float16)u0.y; hv[2] = (_Float16)u0.z; hv[3] = (_Float16)u0.w; hv[4] = (_Float16)u1.x; hv[5] = (_Float16)u1.y; hv[6] = (_Float16)u1.z; hv[7] = (_Float16)u1.w;
        *(LAS h8*)(L + WT_OFF + i * 16) = hv; }
    const f32x4 b0 = *(const GAS f32x4*)(db + c0), b1 = *(const GAS f32x4*)(db + c0 + 4);
    const f32x4 g0 = *(const GAS f32x4*)(lg + c0), g1 = *(const GAS f32x4*)(lg + c0 + 4);
    const f32x4 e0 = *(const GAS f32x4*)(lb + c0), e1 = *(const GAS f32x4*)(lb + c0 + 4);
    const int t00 = 64 * F.vcu;
    __syncthreads();
    {   for (int i = tid; i < 94 * 64; i += NWAVES * 64) { const int r = i >> 6, tt = t00 - 30 + r;
            h8 hv = (h8){};
            if (tt >= 0) { const v4u z = *(const GAS v4u*)(glu + (size_t)tt * CCH + 8 * (i & 63));
                hv[0] = (_Float16)bflo(z.x); hv[1] = (_Float16)bfhi(z.x); hv[2] = (_Float16)bflo(z.y); hv[3] = (_Float16)bfhi(z.y); hv[4] = (_Float16)bflo(z.z); hv[5] = (_Float16)bfhi(z.z); hv[6] = (_Float16)bflo(z.w); hv[7] = (_Float16)bfhi(z.w); }
            *(LAS h8*)(L + GL_OFF + i * 16) = hv; } }
    __syncthreads();
    for (int bt = 0; bt < 2; ++bt) {
        const int t0 = t00 + 32 * bt;
        h8 acc[4];
#pragma unroll
        for (int r = 0; r < 4; ++r) acc[r] = (h8){};
#pragma unroll 4
        for (int w = 0; w < CONVW; ++w) {
            const h8 tw = *(const LAS h8*)(L + WT_OFF + (w * 64 + lane) * 16);
#pragma unroll
            for (int r = 0; r < 4; ++r) { const h8 x = *(const LAS h8*)(L + GL_OFF + ((32 * bt + 4 * wv + r + w) * 64 + lane) * 16); acc[r] = __builtin_elementwise_fma(x, tw, acc[r]); } }
        f32x4 a0[4], a1[4];
#pragma unroll
        for (int r = 0; r < 4; ++r) { a0[r] = b0 + (f32x4){(float)acc[r][0], (float)acc[r][1], (float)acc[r][2], (float)acc[r][3]}; a1[r] = b1 + (f32x4){(float)acc[r][4], (float)acc[r][5], (float)acc[r][6], (float)acc[r][7]}; }
#pragma unroll
        for (int r = 0; r < 4; ++r) { const int t = t0 + 4 * wv + r; f32x4 x0 = a0[r], x1 = a1[r];
            const float mean = wave_sum((x0.x + x0.y) + (x0.z + x0.w) + (x1.x + x1.y) + (x1.z + x1.w)) * (1.0f / CCH);
            x0 = x0 - mean; x1 = x1 - mean;
            const float var = wave_sum((x0.x * x0.x + x0.y * x0.y) + (x0.z * x0.z + x0.w * x0.w) + (x1.x * x1.x + x1.y * x1.y) + (x1.z * x1.z + x1.w * x1.w)) * (1.0f / CCH);
            const float rstd = __builtin_amdgcn_rsqf(var + EPS);
            f32x4 y0 = x0 * rstd * g0 + e0, y1 = x1 * rstd * g1 + e1;
#pragma unroll
            for (int e = 0; e < 4; ++e) { y0[e] = y0[e] * sigm_f(y0[e]); y1[e] = y1[e] * sigm_f(y1[e]); }
            v4u o; o.x = pk2(y0.x, y0.y); o.y = pk2(y0.z, y0.w); o.z = pk2(y1.x, y1.y); o.w = pk2(y1.z, y1.w);
            *(GAS v4u*)(zc + (size_t)t * CCH + c0) = o; }
    }
    __syncthreads();
}

__device__ __forceinline__ unsigned ordkey(float s) { unsigned u = __float_as_uint(s); if (s == 0.f) u = 0u; return (u & 0x80000000u) ? ~u : (u | 0x80000000u); }
__device__ __forceinline__ float h2f(unsigned short h) { return (float)__builtin_bit_cast(_Float16, h); }

__device__ __forceinline__ void indexer_simple(Frame& F, KArgs A) {
    const unsigned short* QI = (const unsigned short*)(A->ws + WS_QI); const unsigned short* KI = (const unsigned short*)(A->ws + WS_KI); const float* WI = (const float*)(A->ws + WS_WI);
    unsigned* mask32 = (unsigned*)((unsigned char*)A->out + OUT_MASK);
    LAS unsigned* skey = (LAS unsigned*)(F.lds);
    LAS float* qif = (LAS float*)(F.lds + 65536);
    LAS unsigned* hist = (LAS unsigned*)(F.lds + 65536 + 1024);
    LAS unsigned* cnt = (LAS unsigned*)(F.lds + 65536 + 2048);
    LAS unsigned* wtot = (LAS unsigned*)(F.lds + 65536 + 4096);
    LAS unsigned* res = (LAS unsigned*)(F.lds + 65536 + 4160);
    const int tid = F.tid, lane = F.lane, wv = F.wave, w = (int)blockIdx.x;
    for (int jj = 0; jj < 64; ++jj) {
        const int j = jj >> 1; const int t = 512 * j + ((jj & 1) ? (511 - w) : w);
        const int n = t + 1;
        __syncthreads();
        if (tid < 256) qif[tid] = h2f(QI[(size_t)t * 256 + tid]);
        const f32x4 w4 = *(const GAS f32x4*)(WI + (size_t)t * 4);
        __syncthreads();
        for (int s = tid; s < n; s += 512) {
            float dot[4] = {0.f, 0.f, 0.f, 0.f};
#pragma unroll 1
            for (int c = 0; c < 8; ++c) { asm volatile("" ::: "memory"); const v4u kv = *(const GAS v4u*)(KI + (size_t)s * 64 + 8 * c);
                const unsigned kw[4] = {kv.x, kv.y, kv.z, kv.w};
#pragma unroll
                for (int e = 0; e < 4; ++e) { const float k0 = h2f((unsigned short)(kw[e] & 0xffffu)), k1 = h2f((unsigned short)(kw[e] >> 16));
#pragma unroll
                    for (int h = 0; h < 4; ++h) { dot[h] += k0 * qif[64 * h + 8 * c + 2 * e]; dot[h] += k1 * qif[64 * h + 8 * c + 2 * e + 1]; } } }
            float sc = w4.x * fmaxf(dot[0], 0.f); sc += w4.y * fmaxf(dot[1], 0.f); sc += w4.z * fmaxf(dot[2], 0.f); sc += w4.w * fmaxf(dot[3], 0.f);
            skey[s] = ordkey(sc);
        }
        __syncthreads();
        unsigned T = 0u, r = 0u;
        if (n > 256) {
            unsigned prefix = 0u, pmask = 0u, remaining = 256u;
            for (int pass = 0; pass < 4; ++pass) { const int shift = 24 - 8 * pass;
                if (tid < 256) hist[tid] = 0u;
                __syncthreads();
                for (int s = tid; s < n; s += 512) { const unsigned k = skey[s]; if ((k & pmask) == prefix) __hip_atomic_fetch_add(&hist[(k >> shift) & 255u], 1u, __ATOMIC_RELAXED, __HIP_MEMORY_SCOPE_WORKGROUP); }
                __syncthreads();
                if (wv == 0) {
                    const unsigned c0 = hist[4 * lane], c1 = hist[4 * lane + 1], c2 = hist[4 * lane + 2], c3 = hist[4 * lane + 3];
                    const unsigned tl = c0 + c1 + c2 + c3; unsigned suf = tl;
#pragma unroll
                    for (int o = 1; o < 64; o <<= 1) { const unsigned v = __shfl_down(suf, o); if (lane + o < 64) suf += v; }
                    const unsigned above = suf - tl;
                    if (above < remaining && remaining <= suf) {
                        unsigned a = above; int d;
                        if (a + c3 >= remaining) d = 3; else { a += c3; if (a + c2 >= remaining) d = 2; else { a += c2; if (a + c1 >= remaining) d = 1; else { a += c1; d = 0; } } }
                        res[0] = (unsigned)(4 * lane + d); res[1] = remaining - a; }
                }
                __syncthreads();
                prefix |= res[0] << shift; pmask |= 255u << shift; remaining = res[1];
                __syncthreads();
            }
            T = prefix; r = remaining;
        }
        const int s0 = 32 * tid; unsigned eqc = 0u;
        for (int i = 0; i < 32; ++i) { const int s = s0 + i; if (s < n && skey[s] == T) ++eqc; }
        unsigned inc = eqc;
#pragma unroll
        for (int o = 1; o < 64; o <<= 1) { const unsigned v = __shfl_up(inc, o); if (lane >= o) inc += v; }
        if (lane == 63) wtot[wv] = inc;
        __syncthreads();
        unsigned run = inc - eqc;
        for (int v = 0; v < wv; ++v) run += wtot[v];
        unsigned word = 0u;
        for (int i = 0; i < 32; ++i) { const int s = s0 + i; if (s < n) { const unsigned k = skey[s]; if (k > T) word |= 1u << i; else if (k == T) { if (run < r) word |= 1u << i; ++run; } } }
        const int nchunk = 8 * ((t >> 8) + 1);
        if (tid < nchunk) mask32[((size_t)(tid >> 1) * M + t) * 2 + (tid & 1)] = word;
    }
}

__device__ __forceinline__ int t5_bucket(int d) {
    if (d < 16) return d;
    int b = 16;
    b += d >= 19; b += d >= 21; b += d >= 24; b += d >= 27; b += d >= 31; b += d >= 35; b += d >= 40; b += d >= 46;
    b += d >= 52; b += d >= 59; b += d >= 67; b += d >= 77; b += d >= 87; b += d >= 99; b += d >= 113;
    return b;
}
__device__ __forceinline__ void attn_simple(Frame& F, KArgs A) {
    const bf16* Q = (const bf16*)(A->ws + WS_Q); const bf16* K = (const bf16*)(A->ws + WS_K); const bf16* V = (const bf16*)(A->ws + WS_V); bf16* O = (bf16*)(A->ws + WS_ATT);
    const unsigned long long* mask = (const unsigned long long*)((unsigned char*)A->out + OUT_MASK); const float* relb = A->in[22];
    LAS unsigned char* base = F.lds + F.wave * 4096;
    LAS unsigned short* list = (LAS unsigned short*)base;
    LAS float* pbuf = (LAS float*)(base + 512);
    LAS float* qf = (LAS float*)(base + 1536);
    const int lane = F.lane, gw = (int)blockIdx.x * NWAVES + F.wave;
    for (int j = 0; j < 8; ++j) {
        const int t = 2048 * j + ((j & 1) ? (2047 - gw) : gw);
        { const v4u qv = *(const GAS v4u*)(Q + (size_t)t * AW + 8 * lane);
          qf[8 * lane + 0] = bflo(qv.x); qf[8 * lane + 1] = bfhi(qv.x); qf[8 * lane + 2] = bflo(qv.y); qf[8 * lane + 3] = bfhi(qv.y);
          qf[8 * lane + 4] = bflo(qv.z); qf[8 * lane + 5] = bfhi(qv.z); qf[8 * lane + 6] = bflo(qv.w); qf[8 * lane + 7] = bfhi(qv.w); }
        const int qg = t >> 5, cq = t & 31;
        const unsigned long long* mw = mask + (size_t)qg * 512 * 16;
        unsigned pc = 0u;
        for (int i = 0; i < 8; ++i) { const int ks = lane + 64 * i; if (ks <= qg) {
            for (int r = 0; r < 16; ++r) { const unsigned long long w = mw[ks * 16 + r]; pc += (unsigned)((w >> cq) & 1ull) + (unsigned)((w >> (cq + 32)) & 1ull); } } }
        unsigned inc = pc;
#pragma unroll
        for (int o = 1; o < 64; o <<= 1) { const unsigned v = __shfl_up(inc, o); if (lane >= o) inc += v; }
        const int cnt = (int)__shfl(inc, 63);
        unsigned pos = inc - pc;
        for (int i = 0; i < 8; ++i) { const int ks = lane + 64 * i; if (ks <= qg) {
            for (int r = 0; r < 16; ++r) { const unsigned long long w = mw[ks * 16 + r];
                for (int h2 = 0; h2 < 2; ++h2) if ((w >> (cq + 32 * h2)) & 1ull) { if (pos < 256u) list[pos] = (unsigned short)(32 * ks + (r & 3) + 8 * (r >> 2) + 4 * h2); ++pos; } } } }
        LDS_WAIT(); asm volatile("" ::: "memory");
        const int ncl = cnt < 256 ? cnt : 256;
        for (int h = 0; h < NH; ++h) {
            float lg[4]; float mx = -INFINITY;
#pragma unroll
            for (int i = 0; i < 4; ++i) { const int e = lane + 64 * i; lg[i] = -INFINITY;
                if (e < ncl) { const int key = list[e]; const bf16* kr = K + (size_t)key * AW + 64 * h; float dot = 0.f;
#pragma unroll
                    for (int c = 0; c < 8; ++c) { const v4u kv = *(const GAS v4u*)(kr + 8 * c); const LAS float* qq = qf + 64 * h + 8 * c;
                        dot += bflo(kv.x) * qq[0]; dot += bfhi(kv.x) * qq[1]; dot += bflo(kv.y) * qq[2]; dot += bfhi(kv.y) * qq[3];
                        dot += bflo(kv.z) * qq[4]; dot += bfhi(kv.z) * qq[5]; dot += bflo(kv.w) * qq[6]; dot += bfhi(kv.w) * qq[7]; }
                    lg[i] = dot + relb[t5_bucket(t - key) * NH + h] * LOG2E; }
                mx = fmaxf(mx, lg[i]); }
            mx = wave_max(mx);
            float sm = 0.f;
#pragma unroll
            for (int i = 0; i < 4; ++i) { const int e = lane + 64 * i; const float p = (e < ncl) ? __builtin_amdgcn_exp2f(lg[i] - mx) : 0.f; sm += p; if (e < ncl) pbuf[e] = p; }
            sm = wave_sum(sm);
            LDS_WAIT(); asm volatile("" ::: "memory");
            float acc = 0.f;
            for (int e = 0; e < ncl; ++e) { const int key = list[e]; acc += pbuf[e] * __uint_as_float((unsigned)V[(size_t)key * AW + 64 * h + lane] << 16); }
            O[(size_t)t * AW + 64 * h + lane] = (bf16)f2bf(acc / sm);
            LDS_WAIT(); asm volatile("" ::: "memory");
        }
    }
}


typedef _Float16 half8 __attribute__((ext_vector_type(8)));
typedef float f32x16 __attribute__((ext_vector_type(16)));
constexpr int IX_NBW = 515, IX_CENTER = 515, IX_TOPBIN = 1029, IX_CAP = 256, IX_SH = 19, IX_E0 = (127 - 28) * 16;
constexpr int IX_CHUNK = 32;
constexpr int IX_ROW = 64 + 1030;
constexpr int IXL_HIST = 0, IXL_IMG = 0, IXL_ZH = 70144, IXL_CANDK = 74240, IXL_CANDI = 107008, IXL_CCNT = 123392, IXL_ST = 123520, IXL_CNT = 124544, IXL_ST2 = 124672, IXL_FLAG = 125184, IXL_END = 125248;
enum { IXF_USEKEY = 1, IXF_TIE = 2, IXF_OVF = 4, IXF_NEEDTIE = 8 };
enum { IXM_HIST0 = 0, IXM_COUNT = 1, IXM_TIES = 2, IXM_COLLECT = 3 };

__device__ __forceinline__ int ix_bin(float s) {
    const unsigned u = __float_as_uint(s), a = u & 0x7fffffffu;
    int mi = (int)(a >> IX_SH) - IX_E0;
    mi = min(max(mi, -1), 512) + 1;
    const int b = (u >> 31) ? (IX_CENTER - 1 - mi) : (IX_CENTER + 1 + mi);
    return a == 0u ? IX_CENTER : b;
}
__device__ __forceinline__ void ix_bin_range(int b, unsigned& klo, unsigned& khi) {
    const bool pos = b > IX_CENTER; const int mi = pos ? b - IX_CENTER - 1 : IX_CENTER - 1 - b;
    const unsigned alo = mi == 0 ? 1u : ((unsigned)(mi - 1 + IX_E0) << IX_SH);
    const unsigned ahi = mi == 0 ? (((unsigned)IX_E0 << IX_SH) - 1u) : (mi == 513 ? 0x7fffffffu : alo + (1u << IX_SH) - 1u);
    if (pos) { klo = alo | 0x80000000u; khi = ahi | 0x80000000u; } else { klo = 0x7fffffffu - ahi; khi = 0x7fffffffu - alo; }
}
__device__ __forceinline__ unsigned wave_incl_scan(unsigned v, int lane) {
#define WS_SHR(x, n) (unsigned)__builtin_amdgcn_update_dpp(0, (int)(x), 0x110 + (n), 0xf, 0xf, true)
    v += WS_SHR(v, 1); v += WS_SHR(v, 2); v += WS_SHR(v, 4); v += WS_SHR(v, 8);
#undef WS_SHR
    const unsigned t0 = (unsigned)__builtin_amdgcn_readlane((int)v, 15), t1 = (unsigned)__builtin_amdgcn_readlane((int)v, 31), t2 = (unsigned)__builtin_amdgcn_readlane((int)v, 47);
    return v + (lane >= 16 ? t0 : 0u) + (lane >= 32 ? t1 : 0u) + (lane >= 48 ? t2 : 0u);
}
__device__ __forceinline__ bool ix_scan_row(LAS unsigned char* L, int q, int lane, unsigned& B, unsigned& cB, unsigned& cab) {
    LAS unsigned* hq = (LAS unsigned*)(L + IXL_HIST) + (q & 15) * IX_ROW + (64 + IX_TOPBIN - 16) - 17 * lane; const int hsh = 16 * (q >> 4);
    unsigned cj[17]; unsigned tl = 0u;
#pragma unroll
    for (int j = 0; j < 17; ++j) { const unsigned v = (hq[16 - j] >> hsh) & 0xffffu; cj[j] = v; tl += v; }
    const unsigned inc = wave_incl_scan(tl, lane), above = inc - tl;
    const bool cross = above < 256u && 256u <= inc;
    unsigned b_ = 0u, c_ = 0u, a_ = 0u; { unsigned a = above; bool done = false;
#pragma unroll
        for (int j = 0; j < 17; ++j) { if (!done && a + cj[j] >= 256u) { b_ = (unsigned)(IX_TOPBIN - (17 * lane + j)); c_ = cj[j]; a_ = a; done = true; } a += cj[j]; } }
    const unsigned long long bal = __ballot(cross); const int src = bal ? (__ffsll((long long)bal) - 1) : 0;
    B = (unsigned)__builtin_amdgcn_readlane((int)b_, src); cB = (unsigned)__builtin_amdgcn_readlane((int)c_, src); cab = (unsigned)__builtin_amdgcn_readlane((int)a_, src);
    return bal != 0ull;
}
__device__ __forceinline__ void ix_group_scan(LAS unsigned* zhq, unsigned need, int lane, unsigned& gz, unsigned& before) {
    const unsigned w = zhq[lane >> 1]; const unsigned z0 = (w >> (16 * (lane & 1))) & 0xffu, z1 = (w >> (16 * (lane & 1) + 8)) & 0xffu;
    const unsigned tl = z0 + z1, inc = wave_incl_scan(tl, lane), bef = inc - tl;
    const bool cross = bef < need && need <= inc;
    const unsigned g = (bef + z0 >= need) ? (unsigned)(2 * lane) : (unsigned)(2 * lane + 1), b = (bef + z0 >= need) ? bef : bef + z0;
    const unsigned long long bal = __ballot(cross); const int src = bal ? (__ffsll((long long)bal) - 1) : 0;
    gz = (unsigned)__builtin_amdgcn_readlane((int)g, src); before = (unsigned)__builtin_amdgcn_readlane((int)b, src);
}

struct IxLane { unsigned thi, tlo, flags, gz, cmpkey; };
__device__ __forceinline__ float ix_relu(float x) { return __builtin_bit_cast(float, max(__builtin_bit_cast(int, x), 0)); }

template <int MODE, bool DIAG>
__device__ __forceinline__ void ix_tile(LAS unsigned char* L, f32x16 (&acc)[4], const f32x4 w4, int ks, int c, int hi, const IxLane st, bool act, unsigned& cnt) {
    LAS unsigned* hc = (LAS unsigned*)(L + IXL_HIST) + (c & 15) * IX_ROW + 64 + IX_CENTER;
    const unsigned hval = 1u << (16 * (c >> 4));
    LAS unsigned* zh = (LAS unsigned*)(L + IXL_ZH) + c * 32;
    const unsigned grp = (unsigned)ks >> 2;
    int cm = c - 4 * hi;
    if (DIAG) asm volatile("" : "+v"(cm));
    const bool tieLt = (st.flags & IXF_TIE) ? (grp < st.gz) : false, tieEq = (st.flags & IXF_TIE) ? (grp == st.gz) : true;

    float thif = __uint_as_float(st.thi), tlof = __uint_as_float(st.tlo);
    if (MODE == IXM_COLLECT) { thif = tieLt ? __uint_as_float(0x80000001u) : thif;
        tlof = (tieEq && !tieLt) ? tlof : __uint_as_float(0x7fc00000u); }
    unsigned mybits = 0u, nzs = 0u;
    typedef float f32x2i __attribute__((ext_vector_type(2)));
    const float INF_ = __builtin_inff(); const f32x4 hi4 = {w4.x == 0.f ? INF_ : 0.f, w4.y == 0.f ? INF_ : 0.f, w4.z == 0.f ? INF_ : 0.f, w4.w == 0.f ? INF_ : 0.f};
#pragma unroll
    for (int r = 0; r < 16; ++r) {
        const int ko = (r & 3) + 8 * (r >> 2);
        f32x2i t2_;
        if ((r & 1) == 0) {
            {
              float s0 = __builtin_amdgcn_fmed3f(acc[0][r], w4.x, hi4.x), s1 = __builtin_amdgcn_fmed3f(acc[0][r + 1], w4.x, hi4.x);
              s0 += __builtin_amdgcn_fmed3f(acc[1][r], w4.y, hi4.y); s1 += __builtin_amdgcn_fmed3f(acc[1][r + 1], w4.y, hi4.y);
              s0 += __builtin_amdgcn_fmed3f(acc[2][r], w4.z, hi4.z); s1 += __builtin_amdgcn_fmed3f(acc[2][r + 1], w4.z, hi4.z);
              s0 += __builtin_amdgcn_fmed3f(acc[3][r], w4.w, hi4.w); s1 += __builtin_amdgcn_fmed3f(acc[3][r + 1], w4.w, hi4.w);
              asm volatile("" : "+v"(s0), "+v"(s1));
              t2_ = (f32x2i){s0, s1}; }
            acc[0][r + 1] = t2_.y; }
        const float sc = (r & 1) ? acc[0][r] : t2_.x;
        const unsigned u = __float_as_uint(sc);
        const bool ok = (DIAG ? (ko <= cm) : true) && ((MODE == IXM_COLLECT || MODE == IXM_HIST0) ? true : act);
        if (MODE == IXM_HIST0) {
            const int t = (int)((u >> IX_SH) & 0xfffu);
            int m1; asm("v_med3_i32 %0, %1, 1, %2" : "=v"(m1) : "v"(t - (IX_E0 - 2)), "s"(514));
            const bool nzr = sc != 0.f;
            m1 = nzr ? m1 : 0;
            const int sm = (int)(((unsigned)((int)u >> 31) << 3) | 4u);
            unsigned hpa; asm("v_mad_i32_i24 %0, %1, %2, %3" : "=v"(hpa) : "v"(m1), "v"(sm), "v"((unsigned)(uintptr_t)hc));
            LAS unsigned* hp = (LAS unsigned*)(uintptr_t)hpa;
#define IX_ADDC(msk) do { unsigned long long cd_; asm("v_addc_co_u32 %0, %1, 0, %0, %2" : "+v"(nzs), "=&s"(cd_) : "s"(msk)); } while (0)
            if (DIAG) { if (ok) __hip_atomic_fetch_add(hp, hval, __ATOMIC_RELAXED, __HIP_MEMORY_SCOPE_WORKGROUP); IX_ADDC(__builtin_amdgcn_ballot_w64(nzr || !ok)); }
            else { __hip_atomic_fetch_add(hp, hval, __ATOMIC_RELAXED, __HIP_MEMORY_SCOPE_WORKGROUP); IX_ADDC(__builtin_amdgcn_ballot_w64(nzr)); }
#undef IX_ADDC
        } else if (MODE == IXM_COUNT) {
            cnt += (ok && ordkey(sc) > st.cmpkey) ? 1u : 0u;
        } else if (MODE == IXM_TIES) {
            if (ok && ordkey(sc) == st.cmpkey) __hip_atomic_fetch_add(&zh[grp >> 2], 1u << (8 * (grp & 3)), __ATOMIC_RELAXED, __HIP_MEMORY_SCOPE_WORKGROUP);
        } else {
            const unsigned long long Gm = __builtin_amdgcn_ballot_w64(sc > thif), Em = __builtin_amdgcn_ballot_w64(sc >= tlof);
            const bool gt = __builtin_amdgcn_inverse_ballot_w64(Gm); bool isc = __builtin_amdgcn_inverse_ballot_w64(Em & ~Gm);
            bool sel = gt;
            sel = sel && ok; isc = isc && ok;
            if (isc) { LAS unsigned* ccnt = (LAS unsigned*)(L + IXL_CCNT) + c; const unsigned pos = __hip_atomic_fetch_add(ccnt, 1u, __ATOMIC_RELAXED, __HIP_MEMORY_SCOPE_WORKGROUP);
                { const unsigned pos_ = pos; const unsigned pos = min(pos_, (unsigned)IX_CAP - 1u);
                  ((LAS unsigned*)(L + IXL_CANDK) + c * IX_CAP)[pos] = __float_as_uint(sc);     ((LAS unsigned short*)(L + IXL_CANDI) + c * IX_CAP)[pos] = (unsigned short)(32 * ks + ko + 4 * hi); } }
            mybits |= sel ? (1u << ko) : 0u;
        }
        if (r & 1) __builtin_amdgcn_sched_barrier(0);
    }
    if (MODE == IXM_HIST0) { const unsigned nz = act ? 16u - nzs : 0u; if (nz) __hip_atomic_fetch_add(&zh[grp >> 2], nz << (8 * (grp & 3)), __ATOMIC_RELAXED, __HIP_MEMORY_SCOPE_WORKGROUP); }
    if (MODE == IXM_COLLECT) { mybits <<= 4 * hi; const unsigned word = mybits | (unsigned)__shfl_xor((int)mybits, 32);
        if (hi == 0) ((LAS unsigned*)(L + IXL_IMG))[(((ks >> 1) * 32 + c) << 1) + (ks & 1)] = word; }
}

__device__ __forceinline__ void ix_preload(half8 (&a)[4], const unsigned short* KI, int qg, int wv, int lane) {
    const unsigned short* kp = KI + (size_t)(lane & 31) * 64 + 32 * (lane >> 5); const int k0 = min(wv, qg);
#pragma unroll
    for (int s = 0; s < 4; ++s) a[s] = *(const GAS half8*)(kp + (size_t)k0 * 2048 + 8 * s);
}
template <int MODE>
__device__ __forceinline__ void ix_pass(LAS unsigned char* L, const half8 (&qf)[4][4], const f32x4 w4, const unsigned short* KI, int qg, int wv, int lane, const IxLane st, half8 (&a)[4]) {
    const int c = lane & 31, hi = lane >> 5;
    unsigned cnt = 0u;
    const bool act = (MODE == IXM_COUNT) ? ((st.flags & IXF_OVF) != 0u) : (MODE == IXM_TIES) ? ((st.flags & IXF_NEEDTIE) != 0u) : true;
    const unsigned short* kp = KI + (size_t)c * 64 + 32 * hi;
    IxLane sv = st;
    for (int ks = wv; ks <= qg; ks += 8) {
        f32x16 acc[4];
#pragma unroll
        for (int h = 0; h < 4; ++h) { acc[h] = (f32x16){};
#pragma unroll
            for (int s = 0; s < 4; ++s) acc[h] = __builtin_amdgcn_mfma_f32_32x32x16_f16(a[s], qf[h][s], acc[h], 0, 0, 0); }
        { const int kn = min(ks + 8, qg);
#pragma unroll
          for (int s = 0; s < 4; ++s) a[s] = *(const GAS half8*)(kp + (size_t)kn * 2048 + 8 * s); }
        __builtin_amdgcn_sched_barrier(0);
        if (ks == qg) ix_tile<MODE, true>(L, acc, w4, ks, c, hi, sv, act, cnt);
        else ix_tile<MODE, false>(L, acc, w4, ks, c, hi, sv, act, cnt);
    }
    if (MODE == IXM_COUNT) { if (act && cnt) __hip_atomic_fetch_add((LAS unsigned*)(L + IXL_CNT) + c, cnt, __ATOMIC_RELAXED, __HIP_MEMORY_SCOPE_WORKGROUP); }
}

__device__ __forceinline__ void indexer_fast(Frame& F, KArgs A) {
    unsigned char* ws = A->ws;
    const unsigned short* QI = (const unsigned short*)(ws + WS_QI); const unsigned short* KI = (const unsigned short*)(ws + WS_KI); const float* WI = (const float*)(ws + WS_WI);
    unsigned char* maskW = (unsigned char*)A->out + OUT_MASK;
    LAS unsigned char* L = F.lds;
    const int tid = F.tid, lane = F.lane, wv = F.wave, c = lane & 31, hi = lane >> 5;
    LAS unsigned* ST = (LAS unsigned*)(L + IXL_ST); LAS unsigned* ST2 = (LAS unsigned*)(L + IXL_ST2); LAS unsigned* CNT = (LAS unsigned*)(L + IXL_CNT);
    LAS unsigned* CCNT = (LAS unsigned*)(L + IXL_CCNT); LAS unsigned* FLAG = (LAS unsigned*)(L + IXL_FLAG);
#pragma unroll 1
    for (int it = 0; it < 2; ++it) {
        const int qg = it ? (int)blockIdx.x : 511 - (int)blockIdx.x;
        const int t = 32 * qg + c;
        half8 qf[4][4];
#pragma unroll
        for (int h = 0; h < 4; ++h)
#pragma unroll
            for (int s = 0; s < 4; ++s) qf[h][s] = *(const GAS half8*)(QI + (size_t)t * 256 + 64 * h + 32 * hi + 8 * s);
        f32x4 w4; { const f32x4 wraw = *(const GAS f32x4*)(WI + (size_t)t * 4);
#pragma unroll
            for (int h = 0; h < 4; ++h) { const _Float16 wh = (_Float16)wraw[h];
#pragma unroll
                for (int s = 0; s < 4; ++s) qf[h][s] = qf[h][s] * wh;
                w4[h] = (float)wh > 0.f ? 0.f : ((float)wh < 0.f ? -__builtin_inff() : 0.f); } }
        half8 ka[4]; ix_preload(ka, KI, qg, wv, lane);
        __syncthreads();
        static_assert(IXL_END % 16 == 0, "");
        for (int u = tid; u < IXL_END / 16; u += NWAVES * 64) ((LAS v4u*)L)[u] = (v4u){0u, 0u, 0u, 0u};
        __syncthreads();
        IxLane st{0u, 0u, 0u, 0u, (unsigned)(-1024)};
#ifdef DIAG_TIME
#define TSTAMP(k) do { if (blockIdx.x == 0 && it == 0 && tid == 0) ((unsigned long long*)(ws + WS_CTL + 16384))[k] = __builtin_amdgcn_s_memrealtime(); } while (0)
#else
#define TSTAMP(k) do {} while (0)
#endif
        TSTAMP(0);
#ifndef REP_HIST
#define REP_HIST 1
#endif
#ifndef REP_COLL
#define REP_COLL 1
#endif
#pragma unroll 1
        for (int rep = 0; rep < REP_HIST; ++rep) {
            if (rep) { __syncthreads(); for (int u = tid; u < IXL_CANDK / 4; u += NWAVES * 64) ((LAS unsigned*)L)[u] = 0u; __syncthreads(); }
            if (rep) ix_preload(ka, KI, qg, wv, lane);
            ix_pass<IXM_HIST0>(L, qf, w4, KI, qg, wv, lane, st, ka); }
        ix_preload(ka, KI, qg, wv, lane);
        __syncthreads();
        TSTAMP(1);
#pragma unroll 1
        for (int qi = 0; qi < 4; ++qi) {
            const int q = 4 * wv + qi, n = 32 * qg + q + 1;
            if (n <= 256) { if (lane == 0) { ST[q * 8 + 0] = 0x007fffffu; ST[q * 8 + 1] = 0xff800000u; } continue; }
            unsigned B, cB, cab; (void)ix_scan_row(L, q, lane, B, cB, cab);
            const unsigned r = 256u - cab;
            unsigned flags = 0u, gz = 0u, rn = r, klo, khi;
            if (B == (unsigned)IX_CENTER) { klo = 0x7fffffffu; khi = 0x80000000u; } else ix_bin_range((int)B, klo, khi);
            if (cB > (unsigned)IX_CAP) {
                if (B == (unsigned)IX_CENTER) { unsigned before; ix_group_scan((LAS unsigned*)(L + IXL_ZH) + q * 32, r, lane, gz, before); rn = r - before; flags = IXF_TIE; }
                else { flags = IXF_OVF;
                    if (lane == 0) { ST2[q * 4 + 0] = klo - 1u; ST2[q * 4 + 1] = khi; ST2[q * 4 + 2] = cab + cB; ST2[q * 4 + 3] = cab; FLAG[0] = 1u; }
#ifdef DIAG_OVF
                    if (lane == 0) { unsigned* dg = (unsigned*)(ws + WS_CTL) + 2048; atomicAdd(dg + 0, 1u); atomicMax(dg + 1, cB); atomicMax(dg + 2, (cB << 16) | B); atomicMax(dg + 3, (cB << 16) | (unsigned)n); }
#endif
                    }
            }
            if (lane == 0) { ST[q * 8 + 0] = khi; ST[q * 8 + 1] = klo; ST[q * 8 + 2] = flags; ST[q * 8 + 3] = rn; ST[q * 8 + 4] = gz; }
        }
        __syncthreads();
        if (FLAG[0] != 0u) {
#pragma unroll 1
            for (int iter = 0; iter < 40; ++iter) {
                const unsigned fl = ST[c * 8 + 2], lo = ST2[c * 4 + 0], hh = ST2[c * 4 + 1];
                const bool actv = (fl & IXF_OVF) && (hh - lo > 1u);
                if (!__any(actv)) break;
                const unsigned mid = lo + ((hh - lo) >> 1);
                if (tid < 32) CNT[tid] = 0u;
                __syncthreads();
                IxLane sc{0u, 0u, actv ? (unsigned)IXF_OVF : 0u, 0u, mid};
                ix_pass<IXM_COUNT>(L, qf, w4, KI, qg, wv, lane, sc, ka); ix_preload(ka, KI, qg, wv, lane);
                __syncthreads();
                if (tid < 32 && actv) { const unsigned g = CNT[tid]; if (g >= 256u) { ST2[tid * 4 + 0] = mid; ST2[tid * 4 + 2] = g; } else { ST2[tid * 4 + 1] = mid; ST2[tid * 4 + 3] = g; } }
                __syncthreads();
            }
            if (tid < 32 && (ST[tid * 8 + 2] & IXF_OVF)) { const unsigned T = ST2[tid * 4 + 1], glo = ST2[tid * 4 + 2], ghi = ST2[tid * 4 + 3];
                ST[tid * 8 + 0] = T; ST[tid * 8 + 1] = T; ST[tid * 8 + 3] = 256u - ghi;
                const bool nt = (glo - ghi) > (unsigned)IX_CAP; ST[tid * 8 + 2] = (nt ? (unsigned)IXF_NEEDTIE : 0u);
                if (nt) { FLAG[1] = 1u; for (int k = 0; k < 32; ++k) ((LAS unsigned*)(L + IXL_ZH))[tid * 32 + k] = 0u; } }
            __syncthreads();
            if (FLAG[1] != 0u) {
                IxLane sc{0u, 0u, ST[c * 8 + 2], 0u, ST[c * 8 + 0]};
                ix_pass<IXM_TIES>(L, qf, w4, KI, qg, wv, lane, sc, ka); ix_preload(ka, KI, qg, wv, lane);
                __syncthreads();
#pragma unroll 1
                for (int qi = 0; qi < 4; ++qi) { const int q = 4 * wv + qi; const unsigned fl = ST[q * 8 + 2];
                    if (fl & IXF_NEEDTIE) { unsigned gz, before; ix_group_scan((LAS unsigned*)(L + IXL_ZH) + q * 32, ST[q * 8 + 3], lane, gz, before);
                        if (lane == 0) { ST[q * 8 + 3] -= before; ST[q * 8 + 4] = gz; ST[q * 8 + 2] = IXF_TIE; } } }
                __syncthreads();
            }
        }
        TSTAMP(2);
        const unsigned khi_ = ST[c * 8 + 0], klo_ = ST[c * 8 + 1];
        const IxLane sl{(khi_ & 0x80000000u) ? (khi_ & 0x7fffffffu) : ~khi_, (klo_ & 0x80000000u) ? (klo_ & 0x7fffffffu) : ~klo_, ST[c * 8 + 2], ST[c * 8 + 4], 0u};
#pragma unroll 1
        for (int rep = 0; rep < REP_COLL; ++rep) {
            __syncthreads();
            for (int u = tid; u < 65536 / 16; u += NWAVES * 64) ((LAS v4u*)(L + IXL_IMG))[u] = (v4u){0u, 0u, 0u, 0u};
            if (tid < 32) CCNT[tid] = 0u;
            __syncthreads();
            if (rep) ix_preload(ka, KI, qg, wv, lane);
            ix_pass<IXM_COLLECT>(L, qf, w4, KI, qg, wv, lane, sl, ka); }
        __syncthreads();
        TSTAMP(3);
#pragma unroll 1
        for (int qi = 0; qi < 4; ++qi) { const int q = 4 * wv + qi; const int nc = (int)min(CCNT[q], (unsigned)IX_CAP); const unsigned rn = ST[q * 8 + 3];
            if (nc == 0 || rn == 0u) continue;
            const LAS unsigned* ckq = (const LAS unsigned*)(L + IXL_CANDK) + q * IX_CAP; const LAS unsigned short* ciq = (const LAS unsigned short*)(L + IXL_CANDI) + q * IX_CAP;
            unsigned kk[4], ii[4], rk[4];
#pragma unroll
            for (int m = 0; m < 4; ++m) { const int id = lane + 64 * m; const bool v = id < nc; kk[m] = v ? ordkey(__uint_as_float(ckq[id])) : 0u; ii[m] = v ? (unsigned)ciq[id] : 0xffffu; rk[m] = 0u; }
            if (nc <= 64) {
                const unsigned long long me0 = ((unsigned long long)kk[0] << 32) | (0xffffu - ii[0]);
#pragma unroll 2
                for (int jj = 0; jj < nc; ++jj) { const unsigned kj = (unsigned)__builtin_amdgcn_readlane((int)kk[0], jj), ij = (unsigned)__builtin_amdgcn_readlane((int)ii[0], jj);
                    rk[0] += ((((unsigned long long)kj << 32) | (0xffffu - ij)) > me0) ? 1u : 0u; }
            } else if (nc <= 128) {
#pragma unroll
                for (int ch = 0; ch < 2; ++ch) { const int cntc = min(64, nc - 64 * ch);
#pragma unroll 2
                    for (int jj = 0; jj < cntc; ++jj) { const unsigned kj = (unsigned)__builtin_amdgcn_readlane((int)kk[ch], jj), ij = (unsigned)__builtin_amdgcn_readlane((int)ii[ch], jj);
#pragma unroll
                        for (int m = 0; m < 2; ++m) rk[m] += ((((unsigned long long)kj << 32) | (0xffffu - ij)) > ((((unsigned long long)kk[m]) << 32) | (0xffffu - ii[m]))) ? 1u : 0u; } }
            } else {
#pragma unroll
            for (int ch = 0; ch < 4; ++ch) { const int cntc = min(64, nc - 64 * ch);
                if (cntc > 0) {
#pragma unroll 2
                    for (int jj = 0; jj < cntc; ++jj) { const unsigned kj = (unsigned)__builtin_amdgcn_readlane((int)kk[ch], jj), ij = (unsigned)__builtin_amdgcn_readlane((int)ii[ch], jj);
#pragma unroll
                        for (int m = 0; m < 4; ++m) rk[m] += ((((unsigned long long)kj << 32) | (0xffffu - ij)) > ((((unsigned long long)kk[m]) << 32) | (0xffffu - ii[m]))) ? 1u : 0u; } } }
            }
#pragma unroll
            for (int m = 0; m < 4; ++m) { const int id = lane + 64 * m; const unsigned mi = ii[m];
                if (id < nc && rk[m] < rn) __hip_atomic_fetch_or((LAS unsigned*)(L + IXL_IMG) + ((((mi >> 6) * 32 + (unsigned)q) << 1) + ((mi >> 5) & 1u)), 1u << (mi & 31u), __ATOMIC_RELAXED, __HIP_MEMORY_SCOPE_WORKGROUP); } }
        __syncthreads();
        TSTAMP(4);
        { const int ntile = 4 * (qg / 8 + 1);
          unsigned char* const mw_ = (unsigned char*)kargs()->out + OUT_MASK;
          int tq = tid; asm volatile("" : "+v"(tq));
          for (int tt = tq >> 4; tt < ntile; tt += NWAVES * 4) *(GAS v4u*)(mw_ + ((size_t)tt * M + 32 * qg) * 8 + (tq & 15) * 16) = *(const LAS v4u*)(L + IXL_IMG + tt * 256 + (tq & 15) * 16); }
        TSTAMP(5);
    }
    __syncthreads();
}

#include <hip/hip_bf16.h>
#include <cmath>
namespace attn_body {
using bf16=__hip_bfloat16;
using bf16x8=__attribute__((ext_vector_type(8)))short;
using s16x4=__attribute__((ext_vector_type(4)))short;
using f32x16=__attribute__((ext_vector_type(16)))float;
using u32x4=__attribute__((ext_vector_type(4)))unsigned;
constexpr int BATCH=1,NHEAD=8,SEQ=16384,D=64,DM=NHEAD*D;
constexpr int NW=8,QBLK=32,QB=QBLK*NW,KVBLK=64,NQB=SEQ/QB;
constexpr int ATTN_PITCH=DM, ATTN_UNIT_ROWS=QB;
__device__ __forceinline__ int crow(int r,int hi){return (r&3)+8*(r>>2)+4*hi;}
#define SBAR() __builtin_amdgcn_sched_barrier(0)
constexpr int NSLOT=3, SLOTB=8192;
constexpr int LDS_K=0, LDS_V=NSLOT*SLOTB, LDS_WS=2*NSLOT*SLOTB, LDS_OST=LDS_WS+NW*64*4, LDS_MK=LDS_OST+NW*4096, LDS_BT=LDS_MK+NW*768, LDS_BYTES=LDS_BT+512;
constexpr float C2=0.125f*1.4426950408889634f;
__device__ __forceinline__ void glds4(const void*gsrc,unsigned lds_dst){unsigned keep;
  asm volatile("s_mov_b32 %0, m0\n\ts_mov_b32 m0, %2\n\ts_nop 0\n\tglobal_load_lds_dword %1, off\n\ts_mov_b32 m0, %0":"=&s"(keep):"v"(gsrc),"s"(lds_dst):"memory");}
__device__ __forceinline__ void glds16(const void*gsrc,unsigned lds_dst){unsigned keep;
  asm volatile("s_mov_b32 %0, m0\n\ts_mov_b32 m0, %2\n\ts_nop 0\n\tglobal_load_lds_dwordx4 %1, off\n\ts_mov_b32 m0, %0":"=&s"(keep):"v"(gsrc),"s"(lds_dst):"memory");}
__device__ __forceinline__ float max3f(float a,float b,float c){float r;asm("v_max3_f32 %0, %1, %2, %3":"=v"(r):"v"(a),"v"(b),"v"(c));return r;}
__device__ __forceinline__ float max2f(float a,float b){float r;asm("v_max_f32_e32 %0, %1, %2":"=v"(r):"v"(a),"v"(b));return r;}
__device__ __forceinline__ float fadd_s(float a,float b){float r;asm("v_add_f32_e32 %0, %1, %2":"=v"(r):"v"(a),"v"(b));return r;}
__device__ __forceinline__ float fsub_s(float a,float b){float r;asm("v_sub_f32_e32 %0, %1, %2":"=v"(r):"v"(a),"v"(b));return r;}
typedef float f32x2_t __attribute__((ext_vector_type(2))); typedef __bf16 bf16x2_t __attribute__((ext_vector_type(2)));
__device__ __forceinline__ unsigned cvtpk_s(float lo,float hi){f32x2_t v={lo,hi};bf16x2_t b=__builtin_convertvector(v,bf16x2_t);return __builtin_bit_cast(unsigned,b);}
#define WAIT_BAR(N) asm volatile("s_waitcnt vmcnt(" #N ") lgkmcnt(0)\n\ts_barrier":::"memory")

__device__ __forceinline__ void qkt(f32x16&p0,f32x16&p1,const char*Kslot,const bf16x8*qr,const f32x16&negm,int r32,int hi){
  const char*kb=Kslot+hi*1024+r32*16;
  #pragma unroll
  for(int d0=0;d0<4;++d0){
    const bf16x8 b0=*reinterpret_cast<const bf16x8*>(kb+d0*2048);
    const bf16x8 b1=*reinterpret_cast<const bf16x8*>(kb+d0*2048+512);
    if(d0==0){p0=__builtin_amdgcn_mfma_f32_32x32x16_bf16(b0,qr[0],negm,0,0,0);p1=__builtin_amdgcn_mfma_f32_32x32x16_bf16(b1,qr[0],negm,0,0,0);}
    else{p0=__builtin_amdgcn_mfma_f32_32x32x16_bf16(b0,qr[d0],p0,0,0,0);p1=__builtin_amdgcn_mfma_f32_32x32x16_bf16(b1,qr[d0],p1,0,0,0);}}
}
typedef __attribute__((address_space(3))) const char* lds_cptr;
typedef short v4i16_t __attribute__((ext_vector_type(4)));
__device__ __forceinline__ void kload8(bf16x8*kf,lds_cptr kp){
  kf[0]=*(const __attribute__((address_space(3))) bf16x8*)(kp);      kf[1]=*(const __attribute__((address_space(3))) bf16x8*)(kp+512);
  kf[2]=*(const __attribute__((address_space(3))) bf16x8*)(kp+2048); kf[3]=*(const __attribute__((address_space(3))) bf16x8*)(kp+2560);
  kf[4]=*(const __attribute__((address_space(3))) bf16x8*)(kp+4096); kf[5]=*(const __attribute__((address_space(3))) bf16x8*)(kp+4608);
  kf[6]=*(const __attribute__((address_space(3))) bf16x8*)(kp+6144); kf[7]=*(const __attribute__((address_space(3))) bf16x8*)(kp+6656);
}
__device__ __forceinline__ void kload2(bf16x8*kf,lds_cptr kp,int j){ kf[2*j]=*(const __attribute__((address_space(3))) bf16x8*)(kp+j*2048); kf[2*j+1]=*(const __attribute__((address_space(3))) bf16x8*)(kp+j*2048+512); }
__device__ __forceinline__ s16x4 vtr(lds_cptr p){ return __builtin_bit_cast(s16x4,__builtin_amdgcn_ds_read_tr16_b64_v4i16((__attribute__((address_space(3))) v4i16_t*)p)); }
__device__ __forceinline__ float rowmax(const f32x16&p0,const f32x16&p1){
  float a=max3f(p0[0],p0[1],p1[0]),b=max3f(p0[2],p0[3],p1[1]);a=max3f(a,p1[2],p1[3]);
  #pragma unroll
  for(int r=4;r<16;r+=4){a=max3f(a,p0[r],p0[r+1]);b=max3f(b,p0[r+2],p0[r+3]);a=max3f(a,p1[r],p1[r+1]);b=max3f(b,p1[r+2],p1[r+3]);}
  const float m=max2f(a,b);
  auto rr=__builtin_amdgcn_permlane32_swap(__float_as_uint(m),__float_as_uint(m),false,false);
  return max2f(__uint_as_float(rr[0]),__uint_as_float(rr[1]));
}
__device__ __forceinline__ void pv(f32x16*o,int vb,bf16x8 pa0,bf16x8 pa1,bf16x8 pa2,bf16x8 pa3){
  #pragma unroll
  for(int d0=0;d0<2;++d0){s16x4 lo[4],hi[4];
    #pragma unroll
    for(int ks=0;ks<4;++ks){
      asm volatile("ds_read_b64_tr_b16 %0,%1 offset:%c2":"=&v"(lo[ks]):"v"(vb),"i"(d0*4096+ks*1024):"memory");
      asm volatile("ds_read_b64_tr_b16 %0,%1 offset:%c2":"=&v"(hi[ks]):"v"(vb),"i"(d0*4096+ks*1024+512):"memory");}
    asm volatile("s_waitcnt lgkmcnt(0)":::"memory");SBAR();
    #define PK(k) (bf16x8){lo[k][0],lo[k][1],lo[k][2],lo[k][3],hi[k][0],hi[k][1],hi[k][2],hi[k][3]}
    o[d0]=__builtin_amdgcn_mfma_f32_32x32x16_bf16(pa0,PK(0),o[d0],0,0,0);
    o[d0]=__builtin_amdgcn_mfma_f32_32x32x16_bf16(pa1,PK(1),o[d0],0,0,0);
    o[d0]=__builtin_amdgcn_mfma_f32_32x32x16_bf16(pa2,PK(2),o[d0],0,0,0);
    o[d0]=__builtin_amdgcn_mfma_f32_32x32x16_bf16(pa3,PK(3),o[d0],0,0,0);
    #undef PK
  }
}

#ifndef ATTN_STORE16
#define ATTN_STORE16(p,v) (*(u32x4*)(p)=(v))
#endif
__device__ __forceinline__ void attn_unit(int h,int qb,const bf16*Q,const bf16*__restrict__ K,const bf16*__restrict__ V,bf16*O,const unsigned char*maskT,char*shm,const int wid){
  const int lane=lane_now(),tid=wid*64+lane,r32=lane&31,hi=lane>>5;
  const long rowbase=0; const int q0=qb*QB;
  const bf16*Qw=Q+(rowbase+q0+wid*QBLK)*DM+h*D;
  const bf16*Kh=K+rowbase*DM+h*D,*Vh=V+rowbase*DM+h*D;
  const unsigned lds0=(unsigned)(uintptr_t)shm;
  float*wsf=(float*)(shm+LDS_WS)+wid*64;
  const bf16*ksrc=Kh+(long)lane*DM+wid*8;
  const bf16*vsrc=Vh+(long)(16*(wid&3)+(lane>>2))*DM+(wid>>2)*32+(lane&3)*8;
  const unsigned kdst=lds0+LDS_K+wid*1024, vdst=lds0+LDS_V+wid*1024;
  #define DMA_K(t,slot) glds16(ksrc+(long)(t)*KVBLK*DM,(unsigned)__builtin_amdgcn_readfirstlane(kdst+(slot)))
  #define DMA_V(t,slot) glds16(vsrc+(long)(t)*KVBLK*DM,(unsigned)__builtin_amdgcn_readfirstlane(vdst+(slot)))
  const int vb0=(int)(lds0+LDS_V)+((lane>>4)&1)*32+(lane&3)*8+(4*hi+((lane&15)>>2))*64;
  const char*Kbase=shm+LDS_K; bf16x8 kf[8];
  const lds_cptr shm3=(lds_cptr)shm; const lds_cptr kp0=shm3+LDS_K+hi*1024+r32*16; const lds_cptr vp0=shm3+LDS_V+((lane>>4)&1)*32+(lane&3)*8+(4*hi+((lane&15)>>2))*64;
  const int NT=(q0+QB)/KVBLK;
  const unsigned char*msrc=maskT+((size_t)(q0+wid*QBLK))*8+lane*4;
  const unsigned mdst=lds0+LDS_MK+wid*768;
  #define DMA_M(t,slot) glds4(msrc+(size_t)(t)*((size_t)SEQ*8),(unsigned)__builtin_amdgcn_readfirstlane(mdst+((slot)>>5)))
  const lds_cptr mp0=shm3+LDS_MK+wid*768+r32*8;
  const __attribute__((address_space(3))) float* bt3=(const __attribute__((address_space(3))) float*)(shm3+LDS_BT);
  const int qpos=q0+wid*QBLK+r32;
  unsigned m0=0u,m1=0u;
  #define MASKLD(slot) do{ const unsigned long long mw_=*(const __attribute__((address_space(3))) unsigned long long*)(mp0+((slot)>>5)); m0=((unsigned)mw_)>>(4*hi); m1=((unsigned)(mw_>>32))>>(4*hi); }while(0)
  #define MBIT(r) (((r)&3)+8*((r)>>2))
  #define MAND(x,mw,r) x=__uint_as_float(__float_as_uint(x)&(unsigned)(((int)((mw)<<(31-MBIT(r))))>>31))
  #define MANDA(x,mw,r) do{ int t_; float x_=(x); asm("v_bfe_i32 %1, %2, %3, 1\n\tv_and_b32 %0, %0, %1":"+v"(x_),"=&v"(t_):"v"(mw),"i"(MBIT(r))); (x)=x_; }while(0)
  #define BAND(P0,P1,t) do{ const int kb_=qpos-64*(t)-4*hi; \
      _Pragma("unroll") for(int r=0;r<16;++r){ const int d0_=kb_-MBIT(r); P0[r]+=bt3[min(max(d0_,0),127)]; P1[r]+=bt3[min(max(d0_-32,0),127)]; } }while(0)
  DMA_M(0,0);DMA_M(1,SLOTB);DMA_K(0,0);DMA_V(0,0);DMA_K(1,SLOTB);
  bf16x8 qr[4];
  #pragma unroll
  for(int d0=0;d0<4;++d0)qr[d0]=*reinterpret_cast<const bf16x8*>(&Qw[(long)r32*DM+d0*16+hi*8]);
  float l_reg=0.f;f32x16 o[2];o[0]=f32x16{};o[1]=f32x16{};const f32x16 negm=f32x16{};
  f32x16 pA0,pA1,pB0,pB1;
  int sl_prev=0,sl_cur=0,sl_next=SLOTB;
  #define ROT() do{sl_prev=sl_cur;sl_cur=sl_next;sl_next=(sl_next==(NSLOT-1)*SLOTB)?0:sl_next+SLOTB;}while(0)
  DMA_K(2,2*SLOTB);
  WAIT_BAR(3);
  qkt(pA0,pA1,Kbase,qr,negm,r32,hi);asm volatile("s_nop 15\n\ts_nop 7":"+v"(pA0),"+v"(pA1));
  if(NT<=6)BAND(pA0,pA1,0);
  MASKLD(0);
  _Pragma("unroll") for(int r=0;r<16;++r){pA0[r]=__builtin_amdgcn_exp2f(pA0[r]);MAND(pA0[r],m0,r);pA1[r]=__builtin_amdgcn_exp2f(pA1[r]);MAND(pA1[r],m1,r);}
  WAIT_BAR(0);
  DMA_M(2,2*SLOTB);DMA_K(3,0);DMA_V(1,SLOTB);
  ROT();
  kload8(kf,kp0+sl_cur);
  WAIT_BAR(3);
  s16x4 vlo[8],vhi[8]; u32x4 pw0,pw1,pw2,pw3;
  #define PKW(P,B) cvtpk_s(P[B],P[B+1])
  #define PAF(k) __builtin_bit_cast(bf16x8,pw##k)
  #define VFR(i) (bf16x8){vlo[i][0],vlo[i][1],vlo[i][2],vlo[i][3],vhi[i][0],vhi[i][1],vhi[i][2],vhi[i][3]}
  #define PIN(x) asm volatile("":"+v"(x))
  #define MX3(a,b,c) __builtin_fmaxf(__builtin_fmaxf((a),(b)),(c))
  #define GAPA(MF,A0,A1,A2,A3,W0,W1,PW) do{ MF; sacc+=A0; sacc+=A1; sacc+=A2; sacc+=A3; PIN(sacc); W0; W1; PIN(PW); SBAR(); }while(0)
  #define EX(v) __builtin_amdgcn_exp2f(v)
  #define GAPB(MF,X,B,MW) do{ MF; X[B]=EX(X[B]); X[B+1]=EX(X[B+1]); X[B+2]=EX(X[B+2]); X[B+3]=EX(X[B+3]); MANDA(X[B],MW,B); MANDA(X[B+1],MW,B+1); MANDA(X[B+2],MW,B+2); MANDA(X[B+3],MW,B+3); PIN(X); SBAR(); }while(0)
  #define VRD(i) do{ vlo[i]=vtr(vp_+(((i)>>2)*4096+((i)&3)*1024)); vhi[i]=vtr(vp_+(((i)>>2)*4096+((i)&3)*1024+512)); }while(0)
  #define KRD(G,j) do{ if(G){ kload2(kf,kp0+sl_next,j); SBAR(); } }while(0)
  #define STEP(C0,C1,P0,P1,t,GK,GV,GL,GM,BND) do{ SBAR(); \
    const lds_cptr vp_=vp0+sl_prev; \
    VRD(0); SBAR(); float sacc=(P0[0]+P0[1]); \
    GAPA(C0=__builtin_amdgcn_mfma_f32_32x32x16_bf16(kf[0],qr[0],negm,0,0,0), P0[2],P0[3],P0[4],P0[5],     pw0[0]=PKW(P0,0), pw0[1]=PKW(P0,2), pw0); \
    VRD(4); SBAR(); GAPA(C1=__builtin_amdgcn_mfma_f32_32x32x16_bf16(kf[1],qr[0],negm,0,0,0), P0[6],P0[7],P0[8],P0[9],     pw0[2]=PKW(P0,4), pw0[3]=PKW(P0,6), pw0); \
    VRD(1); SBAR(); GAPA(C0=__builtin_amdgcn_mfma_f32_32x32x16_bf16(kf[2],qr[1],C0,0,0,0),   P0[10],P0[11],P0[12],P0[13], pw1[0]=PKW(P0,8), pw1[1]=PKW(P0,10), pw1); \
    VRD(5); SBAR(); GAPA(C1=__builtin_amdgcn_mfma_f32_32x32x16_bf16(kf[3],qr[1],C1,0,0,0),   P0[14],P0[15],P1[0],P1[1],   pw1[2]=PKW(P0,12),pw1[3]=PKW(P0,14), pw1); \
    VRD(2); SBAR(); GAPA(C0=__builtin_amdgcn_mfma_f32_32x32x16_bf16(kf[4],qr[2],C0,0,0,0),   P1[2],P1[3],P1[4],P1[5],     pw2[0]=PKW(P1,0), pw2[1]=PKW(P1,2), pw2); \
    VRD(6); SBAR(); GAPA(C1=__builtin_amdgcn_mfma_f32_32x32x16_bf16(kf[5],qr[2],C1,0,0,0),   P1[6],P1[7],P1[8],P1[9],     pw2[2]=PKW(P1,4), pw2[3]=PKW(P1,6), pw2); \
    VRD(3); SBAR(); GAPA(C0=__builtin_amdgcn_mfma_f32_32x32x16_bf16(kf[6],qr[3],C0,0,0,0),   P1[10],P1[11],P1[12],P1[13], pw3[0]=PKW(P1,8), pw3[1]=PKW(P1,10), pw3); \
    VRD(7); SBAR(); GAPA(C1=__builtin_amdgcn_mfma_f32_32x32x16_bf16(kf[7],qr[3],C1,0,0,0),   P1[14],P1[15],0.f,0.f,       pw3[2]=PKW(P1,12),pw3[3]=PKW(P1,14), pw3); \
    l_reg+=sacc; \
    if(GM){DMA_M((t)+2,sl_prev);} if(GK){DMA_K((t)+3,sl_cur);} if(GV){DMA_V((t)+1,sl_next);} \
    if(BND){ if((t)>=NT-6) BAND(C0,C1,t); } \
    MASKLD(sl_cur); \
    SBAR(); \
    GAPB(o[0]=__builtin_amdgcn_mfma_f32_32x32x16_bf16(PAF(0),VFR(0),o[0],0,0,0), C0,0,m0); \
    GAPB(o[1]=__builtin_amdgcn_mfma_f32_32x32x16_bf16(PAF(0),VFR(4),o[1],0,0,0), C0,4,m0); \
    KRD(GL,0); GAPB(o[0]=__builtin_amdgcn_mfma_f32_32x32x16_bf16(PAF(1),VFR(1),o[0],0,0,0), C0,8,m0); \
    KRD(GL,1); GAPB(o[1]=__builtin_amdgcn_mfma_f32_32x32x16_bf16(PAF(1),VFR(5),o[1],0,0,0), C0,12,m0); \
    KRD(GL,2); GAPB(o[0]=__builtin_amdgcn_mfma_f32_32x32x16_bf16(PAF(2),VFR(2),o[0],0,0,0), C1,0,m1); \
    KRD(GL,3); GAPB(o[1]=__builtin_amdgcn_mfma_f32_32x32x16_bf16(PAF(2),VFR(6),o[1],0,0,0), C1,4,m1); \
    GAPB(o[0]=__builtin_amdgcn_mfma_f32_32x32x16_bf16(PAF(3),VFR(3),o[0],0,0,0), C1,8,m1); \
    GAPB(o[1]=__builtin_amdgcn_mfma_f32_32x32x16_bf16(PAF(3),VFR(7),o[1],0,0,0), C1,12,m1); \
    }while(0)
  int t=1;
  for(;t+7<NT;t+=2){
    STEP(pB0,pB1,pA0,pA1,t,true,true,true,true,false);     WAIT_BAR(3); ROT();
    STEP(pA0,pA1,pB0,pB1,t+1,true,true,true,true,false);   WAIT_BAR(3); ROT();
  }
  #define ENDW(tt) do{ if((tt)+3<NT){WAIT_BAR(3);} else if((tt)+2<NT){WAIT_BAR(2);} else {WAIT_BAR(0);} }while(0)
  for(;t+1<NT;t+=2){
    STEP(pB0,pB1,pA0,pA1,t,(t+3<NT),(t+1<NT),(t+1<NT),(t+2<NT),true);       ENDW(t);   ROT();
    STEP(pA0,pA1,pB0,pB1,t+1,(t+4<NT),(t+2<NT),(t+2<NT),(t+3<NT),true);     ENDW(t+1); ROT();
  }
  STEP(pB0,pB1,pA0,pA1,NT-1,false,false,false,false,true);
  { float sacc=pB0[0]+pB0[1]; _Pragma("unroll") for(int r=2;r<16;++r)sacc+=pB0[r]; _Pragma("unroll") for(int r=0;r<16;++r)sacc+=pB1[r]; l_reg+=sacc;
    pw0=(u32x4){PKW(pB0,0),PKW(pB0,2),PKW(pB0,4),PKW(pB0,6)};pw1=(u32x4){PKW(pB0,8),PKW(pB0,10),PKW(pB0,12),PKW(pB0,14)};pw2=(u32x4){PKW(pB1,0),PKW(pB1,2),PKW(pB1,4),PKW(pB1,6)};pw3=(u32x4){PKW(pB1,8),PKW(pB1,10),PKW(pB1,12),PKW(pB1,14)};
    SBAR(); pv(o,vb0+sl_cur,PAF(0),PAF(1),PAF(2),PAF(3)); }
  #undef PKW
  #undef PAF
  #undef VFR
  #undef PIN
  #undef MX3
  #undef GAPA
  #undef GAPB
  #undef EX
  #undef VRD
  #undef KRD
  #undef STEP
  #undef ENDW
  {auto rr=__builtin_amdgcn_permlane32_swap(__float_as_uint(l_reg),__float_as_uint(l_reg),false,false);l_reg=__uint_as_float(rr[0])+__uint_as_float(rr[1]);}
  if(hi==0)wsf[32+r32]=l_reg;asm volatile("s_waitcnt lgkmcnt(0)":::"memory");
  float rli[16];
  #pragma unroll
  for(int r=0;r<16;++r)rli[r]=__builtin_amdgcn_rcpf(wsf[32+crow(r,hi)]);
  bf16*Ow=O+(rowbase+q0+wid*QBLK)*DM+h*D;
  { bf16*stg=(bf16*)(shm+LDS_OST)+wid*2048;
    #pragma unroll
    for(int r=0;r<16;++r){const int orow=crow(r,hi);
      #pragma unroll
      for(int d0=0;d0<2;++d0)stg[orow*64+d0*32+r32]=__float2bfloat16(o[d0][r]*rli[r]);}
    asm volatile("s_waitcnt lgkmcnt(0)":::"memory");
    #pragma unroll
    for(int i=0;i<4;++i){const int row=i*8+(lane>>3),ch=lane&7; const u32x4 v=*(const u32x4*)(stg+row*64+ch*8); ATTN_STORE16(Ow+(long)row*DM+ch*8,v);} }
  asm volatile("s_waitcnt lgkmcnt(0)\n\ts_barrier":::"memory");
  #undef DMA_K
  #undef DMA_V
  #undef DMA_M
  #undef MASKLD
  #undef MBIT
  #undef MAND
  #undef MANDA
  #undef BAND
  #undef ROT
}
constexpr int ATTN_LDS_BYTES=LDS_BYTES;
__device__ __forceinline__ int t5b(int d){ if(d<16)return d; int b=16; b+=d>=19;b+=d>=21;b+=d>=24;b+=d>=27;b+=d>=31;b+=d>=35;b+=d>=40;b+=d>=46;b+=d>=52;b+=d>=59;b+=d>=67;b+=d>=77;b+=d>=87;b+=d>=99;b+=d>=113; return b; }
__device__ __forceinline__ void attn_phase(char*lds,const bf16*Q,const bf16*K,const bf16*V,bf16*O,const unsigned char*maskT,const float*relb,int vcu,const int wid){
  const int h=vcu>>5, s_=vcu&31;
  const int tid_=wid*64+lane_now();
  if(tid_<128){ const int d=tid_; ((float*)(lds+LDS_BT))[d]=(relb[t5b(d)*NHEAD+h]-relb[31*NHEAD+h])*1.4426950408889634f; }
  asm volatile("s_waitcnt vmcnt(0) lgkmcnt(0)\n\ts_barrier":::"memory");
  if(wid>=4)__builtin_amdgcn_s_setprio(1);
  _Pragma("unroll 1") for(int i=0;i<2;++i) attn_unit(h,i?s_:63-s_,Q,K,V,O,maskT,lds,wid);
  __builtin_amdgcn_s_setprio(0);
}
#undef SBAR
#undef WAIT_BAR
}

static_assert(pg8::EpiMix::GUARD_LDS == (unsigned)(MISC_OFF + 44) && pg8::EpiMix::GUARD_DELTA == (long)(CW_BAR + XB_DONE2) * 4 - (long)CTL_SS2, "EpiMix guard constants");
__global__ void __launch_bounds__(NWAVES * 64, 2) __attribute__((target("no-packed-fp32-ops"))) mega_fwd(Args args) {
    extern __shared__ __attribute__((aligned(16))) unsigned char lds[];
    Frame F;
    F.lds = (LAS unsigned char*)lds;
    F.MISC = (volatile LAS unsigned*)(F.lds + MISC_OFF);
    F.wave = __builtin_amdgcn_readfirstlane((int)threadIdx.x >> 6);
#define RETID() do { F.lane = lane_now(); F.tid = F.wave * 64 + F.lane; } while (0)
    RETID();
    F.G = gridDim.x; { const int bx = blockIdx.x; F.vcu = (F.G % 8 == 0) ? (bx % 8) * (F.G / 8) + bx / 8 : bx; }
    F.ctl = (gu32*)(kargs()->ws + WS_CTL);
    for (int u = F.tid; u < (LDS_BYTES - LDSCTL_OFF) / 4; u += NWAVES * 64) ((LAS unsigned*)(F.lds + LDSCTL_OFF))[u] = 0u;
    __syncthreads();
    const int lo = kargs()->ph_lo, hi = kargs()->ph_hi;
    const bool multi = (hi - lo) > 1;
    XcdBarrier bar; bar.bar = (unsigned*)(F.ctl + CW_BAR); bar.x = 0; bar.st = nullptr;
    if (multi) bar = xcd_barrier_post((unsigned*)(F.ctl + CW_BAR), F.MISC + 8, F.tid);
#ifndef PHMASK
#define PHMASK 0x7ff
#endif
#define IN(k) (((PHMASK >> (k)) & 1) && lo <= (k) && (k) < hi)
#define SEAM(k) do { if (IN(k) && IN((k) + 1)) { RETID(); xcd_barrier(bar, F.tid); } RETID(); } while (0)
#define SEAMS(k) do { if (IN(k) && IN((k) + 1)) { RETID(); if (F.MISC[10] != 0u) xcd_barrier<false>(bar, F.tid); else xcd_barrier(bar, F.tid); } RETID(); } while (0)
#define SEAML(k) do { if (IN(k) && IN((k) + 1)) { RETID(); if (F.MISC[10] != 0u) xcd_local_barrier<((k) == 6 ? XB_DONE6 : (k) == 2 ? XB_DONE2 : (k) == 7 ? XB_DONE7 : -1)>(bar, F.tid); else xcd_barrier(bar, F.tid); } RETID(); } while (0)
#define WSP unsigned char* ws = kargs()->ws
#define BFP(off) ((pg8::bf16_t*)(ws + (off)))
#define CBFP(off) ((const pg8::bf16_t*)(ws + (off)))
#define SSP(off) ((float*)(ws + WS_CTL + (off)))
    const int cidx = (int)blockIdx.x;

#ifndef REP_P0
#define REP_P0 1
#endif
#ifndef REP_G1
#define REP_G1 1
#endif
    if (IN(0)) { for (int rep = 0; rep < REP_P0; ++rep) p0_prologue(F, kargs()); }
    if (multi && F.tid == 0) F.ctl[CW_BAR + XB_TAB + cidx] = 1u + xb_xcc_id();
    SEAM(0);
    if (multi && F.tid < 32) { const unsigned t_ = F.ctl[CW_BAR + XB_TAB + 8 * F.tid + (cidx & 7)]; if (t_ != 1u + xb_xcc_id() || gridDim.x != 256u) atomicOr((unsigned*)&F.ctl[CW_BAR + XB_NONLOCAL], 1u); }
    if (IN(1)) for (int rep = 0; rep < REP_G1; ++rep) { WSP; pg8::Gemm g{CBFP(WS_HB), CBFP(WS_W1IN), M, 2 * DFF, D}; pg8::StaticOrder S; S.init(M, 2 * DFF, F.G, cidx);
        pg8::EpiSwiglu E{BFP(WS_ACT), SSP(CTL_SS1)}; pg8::gemm_phase<pg8::EpiSwiglu, pg8::StaticOrder, true, true>(F.lds + RING_OFF, g, S, E, F.wave); }
    if (IN(1)) { if (cidx >= 128 && F.G == 256) { RETID(); p0_weights(F, kargs(), P0_I0, P0_LATE_END, (cidx - 128) * NWAVES + F.wave, 128 * NWAVES); }
                 else if (F.G != 256) { RETID(); p0_weights(F, kargs(), P0_I0, P0_LATE_END, F.vcu * NWAVES + F.wave, F.G * NWAVES); } } SEAM(1);
    if (multi) { if (F.tid == 0) { const unsigned lok_ = (xb_ld((unsigned*)&F.ctl[CW_BAR + XB_NONLOCAL]) == 0u) ? 1u : 0u; F.MISC[10] = lok_; F.MISC[11] = 1u - lok_; } __syncthreads(); }
    else { if (F.tid == 0) F.MISC[11] = 1u; __syncthreads(); }
    if (IN(2)) { WSP; pg8::Gemm g{CBFP(WS_ACT), CBFP(WS_W1OUT), M, D, DFF}; pg8::StaticOrder S; S.init(M, D, F.G, cidx);
        pg8::EpiRes<1> E{nullptr, CBFP(WS_HB), BFP(WS_HB), nullptr, SSP(CTL_SS2), 0.5f}; pg8::gemm_phase<pg8::EpiRes<1>, pg8::StaticOrder, true, true>(F.lds + RING_OFF, g, S, E, F.wave); } SEAML(2);
    if (IN(3)) { WSP; pg8::Gemm g{CBFP(WS_HB), CBFP(WS_WMIX), M, NMIXP, D}; pg8::StaticOrder S; S.init(M, NMIXP, F.G, cidx);
        pg8::EpiMix E{SSP(CTL_SS2), (pg8::bf16_t*)(ws + WS_GLU), (pg8::bf16_t*)(ws + WS_Q), (pg8::bf16_t*)(ws + WS_K), (pg8::bf16_t*)(ws + WS_V), (pg8::bf16_t*)(ws + WS_QI), (pg8::bf16_t*)(ws + WS_KI),
                      (float*)(ws + WS_WI), (pg8::bf16_t*)(ws + WS_GC), (pg8::bf16_t*)(ws + WS_GA), kargs()->in[12], kargs()->in[13]};
        pg8::gemm_phase<pg8::EpiMix, pg8::StaticOrder, true, true>(F.lds + RING_OFF, g, S, E, F.wave); } SEAM(3);
#ifndef REP_CONV
#define REP_CONV 1
#endif
#ifndef REP_IDX
#define REP_IDX 1
#endif
#ifndef REP_ATT
#define REP_ATT 1
#endif
    if (IN(4)) { for (int rep = 0; rep < REP_CONV; ++rep) conv_phase(F, kargs()); for (int rep = 0; rep < REP_IDX; ++rep) indexer_fast(F, kargs()); } SEAM(4);
    if (IN(5)) { for (int rep = 0; rep < REP_ATT; ++rep) { unsigned char* ws = kargs()->ws; attn_body::attn_phase((char*)lds + RING_OFF, (const attn_body::bf16*)(ws + WS_Q), (const attn_body::bf16*)(ws + WS_K), (const attn_body::bf16*)(ws + WS_V), (attn_body::bf16*)(ws + WS_ATT), (const unsigned char*)kargs()->out + OUT_MASK, kargs()->in[22], F.vcu, F.wave); } __syncthreads();
        WSP; pg8::Gemm g{CBFP(WS_ZC), CBFP(WS_WCO), M, D, CCH}; pg8::StaticOrder S; S.init(M, D, F.G, cidx);
        pg8::EpiGate<0> E{(pg8::bf16_t*)(ws + WS_GC), nullptr}; pg8::gemm_phase<pg8::EpiGate<0>, pg8::StaticOrder, true, true>(F.lds + RING_OFF, g, S, E, F.wave); } SEAM(5);
    if (IN(6)) { WSP; pg8::Gemm g{CBFP(WS_ATT), CBFP(WS_WAO), M, D, AW}; pg8::StaticOrder S; S.init(M, D, F.G, cidx);
        pg8::EpiGate<1> E{(pg8::bf16_t*)(ws + WS_GC), (const pg8::bf16_t*)(ws + WS_GA)}; pg8::gemm_phase<pg8::EpiGate<1>, pg8::StaticOrder, true, true>(F.lds + RING_OFF, g, S, E, F.wave); } SEAML(6);
    if (IN(7)) { convert_p(F, kargs()); WSP; pg8::Gemm g{CBFP(WS_GC), CBFP(WS_WMO), M, D, D}; pg8::StaticOrder S; S.init(M, D, F.G, cidx);
        pg8::EpiRes<1> E{nullptr, CBFP(WS_HB), BFP(WS_HB), nullptr, SSP(CTL_SS3), 1.0f}; pg8::gemm_phase<pg8::EpiRes<1>, pg8::StaticOrder, true, true>(F.lds + RING_OFF, g, S, E, F.wave); } SEAML(7);
    if (IN(8) && multi && F.MISC[10] != 0u) { if (F.tid == 0) { unsigned* bar_ = (unsigned*)(F.ctl + CW_BAR); XB_SPIN(xb_ld(&bar_[XB_DONE6]) < F.MISC[9], bar_); } __syncthreads(); }
    if (IN(8)) {
        WSP; pg8::Gemm g{CBFP(WS_HB), CBFP(WS_W2IN), M, 2 * DFF, D}; pg8::StaticOrder S; S.init(M, 2 * DFF, F.G, cidx);
        pg8::EpiSwiglu E{BFP(WS_ACT), SSP(CTL_SS3)}; pg8::gemm_phase<pg8::EpiSwiglu, pg8::StaticOrder, true, true>(F.lds + RING_OFF, g, S, E, F.wave); }
    if (IN(8) && cidx >= 128) {
        WSP; pg8::Gemm g{CBFP(WS_PB), CBFP(WS_WPP), M, D, PLE}; pg8::StaticOrder S; S.init(M, D, 128, cidx - 128);
        pg8::EpiGate<2> E{(pg8::bf16_t*)(ws + WS_PROJ), nullptr}; pg8::gemm_phase<pg8::EpiGate<2>, pg8::StaticOrder, true, true>(F.lds + RING_OFF, g, S, E, F.wave);
    } SEAML(8);
    if (IN(9)) { WSP; pg8::Gemm g{CBFP(WS_ACT), CBFP(WS_W2OUT), M, D, DFF}; pg8::StaticOrder S; S.init(M, D, F.G, cidx);
        pg8::EpiRes<1> E{nullptr, CBFP(WS_HB), BFP(WS_HB), nullptr, SSP(CTL_SS4), 0.5f}; pg8::gemm_phase<pg8::EpiRes<1>, pg8::StaticOrder, true, true>(F.lds + RING_OFF, g, S, E, F.wave); }
    SEAML(9);
    if (IN(10)) {
        { WSP; pg8::Gemm g{CBFP(WS_HB), CBFP(WS_WPG), M, D, D}; pg8::StaticOrder S; S.init(M, D, F.G, cidx);
          pg8::EpiPle E{kargs()->out, CBFP(WS_HB), CBFP(WS_PROJ), SSP(CTL_SS4)}; pg8::gemm_phase<pg8::EpiPle, pg8::StaticOrder, true, true>(F.lds + RING_OFF, g, S, E, F.wave); }
    }
#ifdef DIAG_TIME
    if (IN(10) && blockIdx.x == 0 && F.tid == 0) { const unsigned long long* ts = (const unsigned long long*)(kargs()->ws + WS_CTL + 16384);
        kargs()->out[0] += 25.0f * floorf((float)(ts[DIAG_TIME + 1] - ts[DIAG_TIME]) * 0.01f / 25.0f + 0.5f); }
#endif
#ifdef DIAG_OVF
    if (IN(10) && blockIdx.x == 0 && F.tid == 0) { const unsigned* dg = (const unsigned*)(kargs()->ws + WS_CTL) + 2048; const unsigned v = __hip_atomic_load(dg + (DIAG_OVF & 3), __ATOMIC_RELAXED, __HIP_MEMORY_SCOPE_AGENT);
        kargs()->out[0] += (float)((DIAG_OVF & 4) ? (v & 0xffffu) : ((DIAG_OVF & 8) ? (v >> 16) : v)); }
#endif
#undef IN
#undef SEAM
#undef SEAML
#undef SEAMS
}

extern "C" void kernel_launch(void* const* d_in, const int* in_sizes, int n_in, void* d_out, int out_size, void* d_ws, size_t ws_size, hipStream_t stream) {
    static int grid = 0;
    if (grid == 0) {
        if (n_in != 23 || out_size != M * D || ws_size < WS_END) { fprintf(stderr, "kernel_launch: unexpected shapes n_in %d out %d ws %zu\n", n_in, out_size, ws_size); grid = -1; return; }
        int dev = 0, cus = 0;
        if (hipGetDevice(&dev) != hipSuccess || hipDeviceGetAttribute(&cus, hipDeviceAttributeMultiprocessorCount, dev) != hipSuccess) { grid = -1; return; }
        if (hipFuncSetAttribute((const void*)mega_fwd, hipFuncAttributeMaxDynamicSharedMemorySize, LDS_BYTES) != hipSuccess) { fprintf(stderr, "kernel_launch: hipFuncSetAttribute failed\n"); grid = -1; return; }
        int per_cu = 0;
        if (hipOccupancyMaxActiveBlocksPerMultiprocessor(&per_cu, (const void*)mega_fwd, NWAVES * 64, LDS_BYTES) != hipSuccess || per_cu < 1) fprintf(stderr, "kernel_launch: occupancy query says %d\n", per_cu);
        (void)hipGetLastError();
        grid = cus;
        if (grid != 256) fprintf(stderr, "kernel_launch: %d CUs (built for 256)\n", grid);
    }
    if (grid < 0) return;
    (void)hipMemsetAsync((char*)d_ws + WS_CTL, 0, CTL_ZERO_BYTES, stream);
    Args a{};
    for (int i = 0; i < 23; ++i) a.in[i] = (const float*)d_in[i];
    a.out = (float*)d_out; a.ws = (unsigned char*)d_ws;
    if (N_LAUNCHES == 1) {
        a.ph_lo = 0; a.ph_hi = NPHASE; a.li = 0;
        hipLaunchKernelGGL(mega_fwd, dim3(grid), dim3(NWAVES * 64), LDS_BYTES, stream, a);
    } else {
        for (int li = 0; li < NPHASE; ++li) { a.ph_lo = li; a.ph_hi = li + 1; a.li = li;
            hipLaunchKernelGGL(mega_fwd, dim3(grid), dim3(NWAVES * 64), LDS_BYTES, stream, a); }
    }
}
```
